# Optimizing an MI355X kernel written in HIP

```python
import jax, jax.numpy as jnp
from jax import lax
import numpy as np

D_MODEL = 1024
BATCH = 8
SEQ = 2048
DEPTH = 1

RWKV_HEAD_DIM = 64
RWKV_HEADS = 8
RWKV_WIDTH = RWKV_HEADS * RWKV_HEAD_DIM
DECAY_LORA = 32
ICLR_LORA = 32
GATE_LORA = 96
N_DIR = 2
RWKV_COLS = 3 * RWKV_WIDTH + N_DIR * DECAY_LORA + N_DIR * ICLR_LORA + GATE_LORA
LN_X_EPS = 64e-5

MLA_HEADS = 8
QK_NOPE_DIM = 64
QK_ROPE_DIM = 32
V_HEAD_DIM = 64
MLA_WIDTH = MLA_HEADS * V_HEAD_DIM
Q_LORA_RANK = 256
KV_LORA_RANK = 128
MLA_COLS = Q_LORA_RANK + KV_LORA_RANK + QK_ROPE_DIM
ROPE_THETA = 10000.0
Q_BLOCK = 128

D_IN = RWKV_COLS + MLA_COLS
D_MIX = RWKV_WIDTH + MLA_WIDTH

MEM_TOKENS = 256
MEM_HEADS = 4
MEM_HEAD_DIM = D_MODEL // MEM_HEADS

D_FF = 4 * D_MODEL
NORM_EPS = 1e-6

kernel_name = "hymba_rwkv7_mla_memxattn_encoder"


def rms_norm(x, g):
    xf = x.astype(jnp.float32)
    y = xf * lax.rsqrt(jnp.mean(xf * xf, axis=-1, keepdims=True) + NORM_EPS)
    return (y * g.astype(jnp.float32)).astype(x.dtype)


def short_conv(z, c):
    prev = jnp.pad(z[:, :-1], ((0, 0), (1, 0), (0, 0)))
    nxt = jnp.pad(z[:, 1:], ((0, 0), (0, 1), (0, 0)))
    return c[0] * prev + c[1] * z + c[2] * nxt


def rope_tables(positions):
    inv_freq = ROPE_THETA ** (-jnp.arange(0, QK_ROPE_DIM, 2, dtype=jnp.float32) / QK_ROPE_DIM)
    ang = positions.astype(jnp.float32)[..., None] * inv_freq
    return jnp.cos(ang), jnp.sin(ang)


def apply_rope(x, cos, sin):
    xf = x.astype(jnp.float32)
    x1, x2 = jnp.split(xf, 2, axis=-1)
    return jnp.concatenate([x1 * cos - x2 * sin, x2 * cos + x1 * sin], axis=-1).astype(x.dtype)


def _dirs_time_major(t):
    B, S = t.shape[0], t.shape[1]
    t = t.reshape(B, S, N_DIR, RWKV_HEADS, RWKV_HEAD_DIM).transpose(1, 2, 0, 3, 4)
    return jnp.stack([t[:, 0], t[::-1, 1]], axis=1)


def _wkv7_step(state, inp):
    r, w, k, v, a, b = inp
    sa = jnp.einsum('dbhvk,dbhk->dbhv', state, a)
    state = state * w[..., None, :] + sa[..., :, None] * b[..., None, :] + v[..., :, None] * k[..., None, :]
    out = jnp.einsum('dbhvk,dbhk->dbhv', state, r)
    return state, out


def rwkv7_bidirectional(z, w0, w2, a0, a2, g2, k_k, k_a, r_k, lnx_w, lnx_b):
    B, S, _ = z.shape
    C, H, N = RWKV_WIDTH, RWKV_HEADS, RWKV_HEAD_DIM
    f32 = jnp.float32
    cuts = [C, 2 * C, 3 * C, 3 * C + N_DIR * DECAY_LORA, 3 * C + N_DIR * (DECAY_LORA + ICLR_LORA)]
    r, k, v, xw, xa, xg = jnp.split(z.astype(f32), cuts, axis=-1)
    xw = xw.reshape(B, S, N_DIR, DECAY_LORA)
    xa = xa.reshape(B, S, N_DIR, ICLR_LORA)
    w_log = -jax.nn.softplus(-(w0.astype(f32) + jnp.einsum('bsdr,drc->bsdc', jnp.tanh(xw), w2.astype(f32)))) - 0.5
    decay = jnp.exp(-jnp.exp(w_log))
    a = jax.nn.sigmoid(a0.astype(f32) + jnp.einsum('bsdr,drc->bsdc', xa, a2.astype(f32)))
    g = jax.nn.sigmoid(xg) @ g2.astype(f32)
    kk = (k * k_k.astype(f32)).reshape(B, S, H, N)
    kk = (kk * lax.rsqrt(jnp.maximum(jnp.sum(kk * kk, axis=-1, keepdims=True), 1e-24))).reshape(B, S, C)
    k_dir = k[:, :, None, :] * (1.0 + (a - 1.0) * k_a.astype(f32))
    shared = lambda t: jnp.broadcast_to(t[:, :, None, :], (B, S, N_DIR, C))
    inputs = tuple(_dirs_time_major(t) for t in
                   (shared(r), decay, k_dir, shared(v), shared(-kk), kk[:, :, None, :] * a))
    state0 = jnp.zeros((N_DIR, B, H, N, N), f32)
    _, o = lax.scan(_wkv7_step, state0, inputs)
    o = (o[:, 0] + o[::-1, 1]).transpose(1, 0, 2, 3)
    mu = jnp.mean(o, axis=-1, keepdims=True)
    var = jnp.mean(jnp.square(o - mu), axis=-1, keepdims=True)
    o = ((o - mu) * lax.rsqrt(var + LN_X_EPS)).reshape(B, S, C) * lnx_w.astype(f32) + lnx_b.astype(f32)
    bonus = jnp.sum((r * jnp.sum(k_dir, axis=2)).reshape(B, S, H, N) * r_k.astype(f32), axis=-1, keepdims=True)
    bonus = (bonus * v.reshape(B, S, H, N)).reshape(B, S, C)
    return ((o + bonus) * g).astype(z.dtype)


def mla_bidirectional(z, positions, q_norm, w_uq, kv_norm, w_ukv):
    B, S, _ = z.shape
    c_q, c_kv, k_rope = jnp.split(z, [Q_LORA_RANK, Q_LORA_RANK + KV_LORA_RANK], axis=-1)
    q = (rms_norm(c_q, q_norm) @ w_uq).reshape(B, S, MLA_HEADS, QK_NOPE_DIM + QK_ROPE_DIM)
    q_nope, q_rope = jnp.split(q, [QK_NOPE_DIM], axis=-1)
    kv = (rms_norm(c_kv, kv_norm) @ w_ukv).reshape(B, S, MLA_HEADS, QK_NOPE_DIM + V_HEAD_DIM)
    k_nope, v = jnp.split(kv, [QK_NOPE_DIM], axis=-1)
    cos, sin = rope_tables(positions)
    q_rope = apply_rope(q_rope, cos[:, :, None, :], sin[:, :, None, :])
    k_rope = apply_rope(k_rope, cos, sin)
    n_blocks = S // Q_BLOCK
    scale = (QK_NOPE_DIM + QK_ROPE_DIM) ** -0.5

    def to_blocks(t):
        return t.reshape(B, n_blocks, Q_BLOCK, t.shape[2], t.shape[3]).swapaxes(0, 1)

    def attend_block(qb):
        qn, qr = qb
        s = jnp.einsum('bqhd,bkhd->bhqk', qn, k_nope) + jnp.einsum('bqhr,bkr->bhqk', qr, k_rope)
        p = jax.nn.softmax(s.astype(jnp.float32) * scale, axis=-1).astype(v.dtype)
        return jnp.einsum('bhqk,bkhd->bqhd', p, v)

    o = lax.map(attend_block, (to_blocks(q_nope), to_blocks(q_rope)))
    return o.swapaxes(0, 1).reshape(B, S, MLA_WIDTH)


def memory_cross_attention(h, mem, g_mem, wq, wkv, wo):
    B, S, _ = h.shape
    m = rms_norm(mem, g_mem)
    q = (h @ wq).reshape(B, S, MEM_HEADS, MEM_HEAD_DIM)
    k, v = jnp.split(m @ wkv, 2, axis=-1)
    k = k.reshape(B, MEM_TOKENS, MEM_HEADS, MEM_HEAD_DIM)
    v = v.reshape(B, MEM_TOKENS, MEM_HEADS, MEM_HEAD_DIM)
    s = jnp.einsum('bqhd,bkhd->bhqk', q, k).astype(jnp.float32) * (MEM_HEAD_DIM ** -0.5)
    p = jax.nn.softmax(s, axis=-1).astype(v.dtype)
    o = jnp.einsum('bhqk,bkhd->bqhd', p, v).reshape(B, S, MEM_HEADS * MEM_HEAD_DIM)
    return o @ wo


def setup_inputs(seed: int = 0) -> dict:
    key = jax.random.key(seed)
    keys = iter(jax.random.split(key, 40))
    L, D, C = DEPTH, D_MODEL, RWKV_WIDTH

    def nrm(shape, scale):
        return scale * jax.random.normal(next(keys), shape, jnp.float32)

    def gain(n):
        return 1.0 + nrm((L, n), 0.05)

    x = nrm((BATCH, SEQ, D), 1.0)
    mem = nrm((BATCH, MEM_TOKENS, D), 1.0)
    positions = (jnp.cumsum(jax.random.randint(next(keys), (BATCH, SEQ), 1, 3, dtype=jnp.int32), axis=1) - 1).astype(jnp.int32)
    return {
        'x': x,
        'mem': mem,
        'positions': positions,
        'norm_mix_pre': gain(D),
        'w_in': nrm((L, D, D_IN), D ** -0.5),
        'conv_rwkv': jnp.array([0.25, 0.5, 0.25], jnp.float32)[None, :, None] + nrm((L, 3, RWKV_COLS), 0.05),
        'rwkv_w0': jax.random.uniform(next(keys), (L, N_DIR, C), jnp.float32, -6.0, 2.0),
        'rwkv_w2': nrm((L, N_DIR, DECAY_LORA, C), 0.1 * DECAY_LORA ** -0.5),
        'rwkv_a0': nrm((L, N_DIR, C), 0.5),
        'rwkv_a2': nrm((L, N_DIR, ICLR_LORA, C), ICLR_LORA ** -0.5),
        'rwkv_g2': nrm((L, GATE_LORA, C), GATE_LORA ** -0.5),
        'rwkv_k_k': 0.85 + nrm((L, C), 0.05),
        'rwkv_k_a': 1.0 + nrm((L, C), 0.05),
        'rwkv_r_k': nrm((L, RWKV_HEADS, RWKV_HEAD_DIM), 0.1),
        'rwkv_lnx_w': gain(C),
        'rwkv_lnx_b': nrm((L, C), 0.02),
        'mla_q_norm': gain(Q_LORA_RANK),
        'mla_w_uq': nrm((L, Q_LORA_RANK, MLA_HEADS * (QK_NOPE_DIM + QK_ROPE_DIM)), Q_LORA_RANK ** -0.5),
        'mla_kv_norm': gain(KV_LORA_RANK),
        'mla_w_ukv': nrm((L, KV_LORA_RANK, MLA_HEADS * (QK_NOPE_DIM + V_HEAD_DIM)), KV_LORA_RANK ** -0.5),
        'w_out': nrm((L, D_MIX, D), D_MIX ** -0.5),
        'norm_mix_post': gain(D),
        'norm_mem_pre': gain(D),
        'norm_memtok': gain(D),
        'mem_wq': nrm((L, D, MEM_HEADS * MEM_HEAD_DIM), D ** -0.5),
        'mem_wkv': nrm((L, D, 2 * MEM_HEADS * MEM_HEAD_DIM), D ** -0.5),
        'mem_wo': nrm((L, MEM_HEADS * MEM_HEAD_DIM, D), (MEM_HEADS * MEM_HEAD_DIM) ** -0.5),
        'norm_mem_post': gain(D),
        'norm_mlp_pre': gain(D),
        'mlp_w1': nrm((L, D, D_FF), D ** -0.5),
        'mlp_w2': nrm((L, D_FF, D), D_FF ** -0.5),
        'norm_mlp_post': gain(D),
    }


def reference(x, mem, positions, norm_mix_pre, w_in, conv_rwkv, rwkv_w0, rwkv_w2, rwkv_a0, rwkv_a2,
              rwkv_g2, rwkv_k_k, rwkv_k_a, rwkv_r_k, rwkv_lnx_w, rwkv_lnx_b, mla_q_norm, mla_w_uq,
              mla_kv_norm, mla_w_ukv, w_out, norm_mix_post, norm_mem_pre, norm_memtok, mem_wq, mem_wkv,
              mem_wo, norm_mem_post, norm_mlp_pre, mlp_w1, mlp_w2, norm_mlp_post):
    for l in range(DEPTH):
        h = rms_norm(x, norm_mix_pre[l])
        z = h @ w_in[l]
        z_rwkv, z_mla = z[..., :RWKV_COLS], z[..., RWKV_COLS:]
        y_rwkv = rwkv7_bidirectional(short_conv(z_rwkv, conv_rwkv[l]), rwkv_w0[l], rwkv_w2[l], rwkv_a0[l],
                                     rwkv_a2[l], rwkv_g2[l], rwkv_k_k[l], rwkv_k_a[l], rwkv_r_k[l],
                                     rwkv_lnx_w[l], rwkv_lnx_b[l])
        y_mla = mla_bidirectional(z_mla, positions, mla_q_norm[l], mla_w_uq[l], mla_kv_norm[l], mla_w_ukv[l])
        y = jnp.concatenate([y_rwkv, y_mla], axis=-1) @ w_out[l]
        x = x + rms_norm(y, norm_mix_post[l])
        h = rms_norm(x, norm_mem_pre[l])
        y = memory_cross_attention(h, mem, norm_memtok[l], mem_wq[l], mem_wkv[l], mem_wo[l])
        x = x + rms_norm(y, norm_mem_post[l])
        h = rms_norm(x, norm_mlp_pre[l])
        y = jnp.square(jax.nn.relu(h @ mlp_w1[l])) @ mlp_w2[l]
        x = x + rms_norm(y, norm_mlp_post[l])
    return x
```

```cpp
#include <hip/hip_runtime.h>
#include <cstdio>
#include <cstdint>

typedef unsigned short bf16_t;
typedef short bf16x8 __attribute__((ext_vector_type(8)));
typedef float f32x4 __attribute__((ext_vector_type(4)));
typedef unsigned u32x4 __attribute__((ext_vector_type(4)));

constexpr int BATCH = 8, SEQ = 2048, DM = 1024, M = BATCH * SEQ;
constexpr int RH = 8, RN = 64, RC = 512;
constexpr int RWKV_COLS = 1760, MLA_COLS = 416, D_IN = 2176;
constexpr int ZC_XW = 1536, ZC_XA = 1600, ZC_XG = 1664;
constexpr int ZC_CQ = 1760, ZC_CKV = 2016, ZC_KR = 2144;
constexpr int MH = 8, NOPE = 64, ROPE = 32, VD = 64, QKD = 96;
constexpr int MEMT = 256, MEMH = 4, MEMD = 256;
constexpr int DFF = 4096;
constexpr float NORM_EPS = 1e-6f, LNX_EPS = 64e-5f;

constexpr size_t MiB = 1u << 20;
constexpr size_t WS_XN   = 0;
constexpr size_t WS_Z    = 32 * MiB;
constexpr size_t WS_YCAT = 100 * MiB;
constexpr size_t WS_CQ   = 132 * MiB;
constexpr size_t WS_CKV  = 140 * MiB;
constexpr size_t WS_KR   = 144 * MiB;
constexpr size_t WS_Q    = 146 * MiB;
constexpr size_t WS_KV   = 170 * MiB;
constexpr size_t WS_LIN  = 132 * MiB;
constexpr size_t WS_LW   = 140 * MiB;
constexpr size_t WS_AA   = 172 * MiB;
constexpr size_t WS_G    = 204 * MiB;
constexpr size_t WS_O01  = 32 * MiB;
constexpr size_t WS_Y    = 32 * MiB;
constexpr size_t WS_QM   = 100 * MiB;
constexpr size_t WS_MN   = 132 * MiB;
constexpr size_t WS_KVM  = 136 * MiB;
constexpr size_t WS_SC   = 144 * MiB;
constexpr size_t WS_P    = 208 * MiB;
constexpr size_t WS_OM   = 100 * MiB;
constexpr size_t WS_HID  = 96 * MiB;

struct Params {
    const float* x; const float* mem; const int* pos;
    const float *norm_mix_pre, *w_in, *conv_rwkv, *rwkv_w0, *rwkv_w2, *rwkv_a0, *rwkv_a2, *rwkv_g2, *rwkv_k_k, *rwkv_k_a, *rwkv_r_k,
                *rwkv_lnx_w, *rwkv_lnx_b, *mla_q_norm, *mla_w_uq, *mla_kv_norm, *mla_w_ukv, *w_out, *norm_mix_post, *norm_mem_pre,
                *norm_memtok, *mem_wq, *mem_wkv, *mem_wo, *norm_mem_post, *norm_mlp_pre, *mlp_w1, *mlp_w2, *norm_mlp_post;
    float* out; unsigned char* ws;
};

__device__ __forceinline__ float bf2f(bf16_t v) { return __uint_as_float((unsigned)v << 16); }
__device__ __forceinline__ bf16_t f2bf(float f) { unsigned u = __float_as_uint(f); return (bf16_t)((u + 0x7fffu + ((u >> 16) & 1u)) >> 16); }
__device__ __forceinline__ unsigned pk2(float lo, float hi) { return (unsigned)f2bf(lo) | ((unsigned)f2bf(hi) << 16); }
__device__ __forceinline__ float wave_sum(float v) {
#pragma unroll
    for (int o = 1; o < 64; o <<= 1) v += __shfl_xor(v, o);
    return v;
}
__device__ __forceinline__ float sigmoidf_(float x) { return 1.f / (1.f + __expf(-x)); }
__device__ __forceinline__ float rdlane(float v, int k) { return __uint_as_float((unsigned)__builtin_amdgcn_readlane((int)__float_as_uint(v), k)); }

struct GemmDesc {
    const bf16_t* A; int lda; long sAb, sAh;
    const void* B; int ldb; long sBb, sBh;
    int Mm, Nn, Kk, nbatch, nh;
};
template <int BMODE  , class EP>
__device__ void gemm_simple(const GemmDesc g, EP epi, unsigned char* smem, int bid, int nblk) {
    bf16_t* sA = (bf16_t*)smem;
    bf16_t* sB = sA + 128 * 40;
    const int tid = threadIdx.x, lane = tid & 63, wid = tid >> 6, wr = wid >> 2, wc = wid & 3, fr = lane & 15, fq = lane >> 4;
    const int tM = g.Mm / 128, tN = g.Nn / 128, ntile = tM * tN * g.nbatch;
    for (int t = bid; t < ntile; t += nblk) {
        const int bi = t / (tM * tN), tt = t % (tM * tN), tm = tt / tN, tn = tt % tN;
        const bf16_t* A = g.A + (long)(bi / g.nh) * g.sAb + (long)(bi % g.nh) * g.sAh + (long)tm * 128 * g.lda;
        const long boff = (long)(bi / g.nh) * g.sBb + (long)(bi % g.nh) * g.sBh;
        f32x4 acc[4][2];
#pragma unroll
        for (int i = 0; i < 4; ++i)
#pragma unroll
            for (int j = 0; j < 2; ++j) acc[i][j] = (f32x4){0.f, 0.f, 0.f, 0.f};
        for (int k0 = 0; k0 < g.Kk; k0 += 32) {
            __syncthreads();
            {
                const int r = tid >> 2, c = (tid & 3) * 8;
                const u32x4 v = *(const u32x4*)(A + (long)r * g.lda + k0 + c);
                *(u32x4*)(sA + r * 40 + c) = v;
            }
            if (BMODE == 2) {
                const bf16_t* B = (const bf16_t*)g.B + boff + (long)tn * 128 * g.ldb;
                const int r = tid >> 2, c = (tid & 3) * 8;
                const u32x4 v = *(const u32x4*)(B + (long)r * g.ldb + k0 + c);
                *(u32x4*)(sB + r * 40 + c) = v;
            } else if (BMODE == 0) {
                const float* B = (const float*)g.B + boff + (long)tn * 128;
                const int k = tid >> 4, n = (tid & 15) * 8;
                const f32x4 v0 = *(const f32x4*)(B + (long)(k0 + k) * g.ldb + n), v1 = *(const f32x4*)(B + (long)(k0 + k) * g.ldb + n + 4);
#pragma unroll
                for (int j = 0; j < 4; ++j) { sB[(n + j) * 40 + k] = f2bf(v0[j]); sB[(n + 4 + j) * 40 + k] = f2bf(v1[j]); }
            } else {
                const bf16_t* B = (const bf16_t*)g.B + boff + (long)tn * 128;
                const int k = tid >> 4, n = (tid & 15) * 8;
                const u32x4 v = *(const u32x4*)(B + (long)(k0 + k) * g.ldb + n);
                const bf16_t* e = (const bf16_t*)&v;
#pragma unroll
                for (int j = 0; j < 8; ++j) sB[(n + j) * 40 + k] = e[j];
            }
            __syncthreads();
            bf16x8 af[4], bfr[2];
#pragma unroll
            for (int i = 0; i < 4; ++i) af[i] = *(const bf16x8*)(sA + (wr * 64 + i * 16 + fr) * 40 + fq * 8);
#pragma unroll
            for (int j = 0; j < 2; ++j) bfr[j] = *(const bf16x8*)(sB + (wc * 32 + j * 16 + fr) * 40 + fq * 8);
#pragma unroll
            for (int i = 0; i < 4; ++i)
#pragma unroll
                for (int j = 0; j < 2; ++j) acc[i][j] = __builtin_amdgcn_mfma_f32_16x16x32_bf16(af[i], bfr[j], acc[i][j], 0, 0, 0);
        }
#pragma unroll
        for (int i = 0; i < 4; ++i)
#pragma unroll
            for (int j = 0; j < 2; ++j)
#pragma unroll
                for (int e = 0; e < 4; ++e) epi(bi, tm * 128 + wr * 64 + i * 16 + fq * 4 + e, tn * 128 + wc * 32 + j * 16 + fr, acc[i][j][e]);
    }
}

__device__ void norm_rows_bf16(const float* in, const float* gain, bf16_t* outb, int nrows, int gw, int ngw, int lane) {
    for (int r = gw; r < nrows; r += ngw) {
        const f32x4* xr = (const f32x4*)(in + (long)r * DM) + lane;
        f32x4 v[4]; float s = 0.f;
#pragma unroll
        for (int j = 0; j < 4; ++j) { v[j] = xr[64 * j]; s += v[j].x * v[j].x + v[j].y * v[j].y + v[j].z * v[j].z + v[j].w * v[j].w; }
        const float rstd = rsqrtf(wave_sum(s) * (1.f / DM) + NORM_EPS);
        unsigned long long* o8 = (unsigned long long*)(outb + (long)r * DM) + lane;
#pragma unroll
        for (int j = 0; j < 4; ++j) { const f32x4 gg = ((const f32x4*)gain)[lane + 64 * j];
            o8[64 * j] = (unsigned long long)pk2(v[j].x * rstd * gg.x, v[j].y * rstd * gg.y) | ((unsigned long long)pk2(v[j].z * rstd * gg.z, v[j].w * rstd * gg.w) << 32); }
    }
}
__device__ void resid_norm_rows(const float* base, const float* y, const float* g_post, float* xo, const float* g_next, bf16_t* xn, int gw, int ngw, int lane) {
    for (int r = gw; r < M; r += ngw) {
        const f32x4* yr = (const f32x4*)(y + (long)r * DM) + lane; const f32x4* br = (const f32x4*)(base + (long)r * DM) + lane;
        f32x4 v[4], b[4]; float s = 0.f;
#pragma unroll
        for (int j = 0; j < 4; ++j) { v[j] = yr[64 * j]; b[j] = br[64 * j]; s += v[j].x * v[j].x + v[j].y * v[j].y + v[j].z * v[j].z + v[j].w * v[j].w; }
        const float rstd = rsqrtf(wave_sum(s) * (1.f / DM) + NORM_EPS);
        float s2 = 0.f;
#pragma unroll
        for (int j = 0; j < 4; ++j) { const f32x4 gg = ((const f32x4*)g_post)[lane + 64 * j];
            v[j].x = b[j].x + v[j].x * rstd * gg.x; v[j].y = b[j].y + v[j].y * rstd * gg.y; v[j].z = b[j].z + v[j].z * rstd * gg.z; v[j].w = b[j].w + v[j].w * rstd * gg.w;
            s2 += v[j].x * v[j].x + v[j].y * v[j].y + v[j].z * v[j].z + v[j].w * v[j].w; }
        f32x4* orow = (f32x4*)(xo + (long)r * DM) + lane;
#pragma unroll
        for (int j = 0; j < 4; ++j) orow[64 * j] = v[j];
        if (xn) {
            const float rstd2 = rsqrtf(wave_sum(s2) * (1.f / DM) + NORM_EPS);
            unsigned long long* o8 = (unsigned long long*)(xn + (long)r * DM) + lane;
#pragma unroll
            for (int j = 0; j < 4; ++j) { const f32x4 gg = ((const f32x4*)g_next)[lane + 64 * j];
                o8[64 * j] = (unsigned long long)pk2(v[j].x * rstd2 * gg.x, v[j].y * rstd2 * gg.y) | ((unsigned long long)pk2(v[j].z * rstd2 * gg.z, v[j].w * rstd2 * gg.w) << 32); }
        }
    }
}

__device__ void mla_prep_rows(const Params& p, int gw, int ngw, int lane) {
    const bf16_t* Z = (const bf16_t*)(p.ws + WS_Z);
    bf16_t* CQ = (bf16_t*)(p.ws + WS_CQ); bf16_t* CKV = (bf16_t*)(p.ws + WS_CKV); float* KR = (float*)(p.ws + WS_KR);
    for (int r = gw; r < M; r += ngw) {
        const bf16_t* zr = Z + (long)r * D_IN;
        float q[4]; float s = 0.f;
#pragma unroll
        for (int j = 0; j < 4; ++j) { q[j] = bf2f(zr[ZC_CQ + 4 * lane + j]); s += q[j] * q[j]; }
        const float rq = rsqrtf(wave_sum(s) * (1.f / 256.f) + NORM_EPS);
#pragma unroll
        for (int j = 0; j < 4; ++j) CQ[(long)r * 256 + 4 * lane + j] = f2bf(q[j] * rq * p.mla_q_norm[4 * lane + j]);
        float c[2]; s = 0.f;
#pragma unroll
        for (int j = 0; j < 2; ++j) { c[j] = bf2f(zr[ZC_CKV + 2 * lane + j]); s += c[j] * c[j]; }
        const float rk = rsqrtf(wave_sum(s) * (1.f / 128.f) + NORM_EPS);
#pragma unroll
        for (int j = 0; j < 2; ++j) CKV[(long)r * 128 + 2 * lane + j] = f2bf(c[j] * rk * p.mla_kv_norm[2 * lane + j]);
        if (lane < 16) {
            const float x1 = bf2f(zr[ZC_KR + lane]), x2 = bf2f(zr[ZC_KR + 16 + lane]);
            const float inv_freq = powf(10000.f, -(float)(2 * lane) / 32.f);
            const float ang = (float)p.pos[r] * inv_freq; float sn, cs; sincosf(ang, &sn, &cs);
            KR[(long)r * 32 + lane] = x1 * cs - x2 * sn; KR[(long)r * 32 + 16 + lane] = x2 * cs + x1 * sn;
        }
    }
}

__device__ void rwkv_prep_rows(const Params& p, int gw, int ngw, int lane) {
    const bf16_t* Z = (const bf16_t*)(p.ws + WS_Z);
    bf16_t* RK = (bf16_t*)p.out;
    bf16_t* LIN = (bf16_t*)(p.ws + WS_LIN);
    for (int r = gw; r < M; r += ngw) {
        const int s = r % SEQ; const bool hp = s > 0, hn = s < SEQ - 1;
        const bf16_t* zc = Z + (long)r * D_IN;
        float val[3][8];
#pragma unroll
        for (int sec = 0; sec < 3; ++sec) {
            const int c0 = sec * 512 + 8 * lane;
#pragma unroll
            for (int j = 0; j < 8; ++j) {
                const int c = c0 + j;
                float a = p.conv_rwkv[RWKV_COLS + c] * bf2f(zc[c]);
                if (hp) a += p.conv_rwkv[c] * bf2f(zc[c - D_IN]);
                if (hn) a += p.conv_rwkv[2 * RWKV_COLS + c] * bf2f(zc[c + D_IN]);
                val[sec][j] = a;
            }
        }
        float kk[8]; float ss = 0.f;
#pragma unroll
        for (int j = 0; j < 8; ++j) { kk[j] = val[1][j] * p.rwkv_k_k[8 * lane + j]; ss += kk[j] * kk[j]; }
        ss += __shfl_xor(ss, 1); ss += __shfl_xor(ss, 2); ss += __shfl_xor(ss, 4);
        const float rn = rsqrtf(fmaxf(ss, 1e-24f));
#pragma unroll
        for (int j = 0; j < 8; ++j) {
            RK[(long)0 * M * RC + (long)r * RC + 8 * lane + j] = f2bf(val[0][j]);
            RK[(long)1 * M * RC + (long)r * RC + 8 * lane + j] = f2bf(val[1][j]);
            RK[(long)2 * M * RC + (long)r * RC + 8 * lane + j] = f2bf(val[2][j]);
            RK[(long)3 * M * RC + (long)r * RC + 8 * lane + j] = f2bf(kk[j] * rn);
        }
        if (lane < 56) {
#pragma unroll
            for (int j = 0; j < 4; ++j) {
                const int c = 1536 + 4 * lane + j;
                float a = p.conv_rwkv[RWKV_COLS + c] * bf2f(zc[c]);
                if (hp) a += p.conv_rwkv[c] * bf2f(zc[c - D_IN]);
                if (hn) a += p.conv_rwkv[2 * RWKV_COLS + c] * bf2f(zc[c + D_IN]);
                float o;
                if (c < ZC_XA) o = tanhf(a); else if (c < ZC_XG) o = a; else o = sigmoidf_(a);
                LIN[(long)r * 256 + 4 * lane + j] = f2bf(o);
            }
        } else {
#pragma unroll
            for (int j = 0; j < 4; ++j) LIN[(long)r * 256 + 4 * lane + j] = 0;
        }
    }
}

__device__ void rwkv_scan_naive(const Params& p, int chain, int lane) {
    const int d = chain / (BATCH * RH), b = (chain / RH) % BATCH, h = chain % RH;
    const bf16_t* RK = (const bf16_t*)p.out;
    const bf16_t* Rr = RK, *Kk = RK + (long)M * RC, *Vv = RK + 2L * M * RC, *KK = RK + 3L * M * RC;
    const bf16_t* LW = (const bf16_t*)(p.ws + WS_LW) + (long)d * M * RC;
    const bf16_t* AA = (const bf16_t*)(p.ws + WS_AA) + (long)d * M * RC;
    float* O = (float*)(p.ws + WS_O01) + (long)d * M * RC;
    const float ka = p.rwkv_k_a[h * RN + lane];
    float S[64];
#pragma unroll
    for (int k = 0; k < 64; ++k) S[k] = 0.f;
    for (int t = 0; t < SEQ; ++t) {
        const int s = d ? (SEQ - 1 - t) : t;
        const long off = ((long)(b * SEQ + s)) * RC + h * RN + lane;
        const float r_ = bf2f(Rr[off]), k_ = bf2f(Kk[off]), v_ = bf2f(Vv[off]), kk_ = bf2f(KK[off]);
        const float w_ = __expf(bf2f(LW[off])), a_ = bf2f(AA[off]);
        const float an = -kk_, bn = kk_ * a_, kn = k_ * (1.f + (a_ - 1.f) * ka);
        float sa = 0.f;
#pragma unroll
        for (int k = 0; k < 64; ++k) sa += S[k] * rdlane(an, k);
        float o = 0.f;
#pragma unroll
        for (int k = 0; k < 64; ++k) {
            S[k] = S[k] * rdlane(w_, k) + sa * rdlane(bn, k) + v_ * rdlane(kn, k);
            o += S[k] * rdlane(r_, k);
        }
        O[off] = o;
    }
}

__device__ void rwkv_combine_rows(const Params& p, int gw, int ngw, int lane) {
    const bf16_t* RK = (const bf16_t*)p.out;
    const bf16_t* Rr = RK, *Kk = RK + (long)M * RC, *Vv = RK + 2L * M * RC;
    const bf16_t* AA = (const bf16_t*)(p.ws + WS_AA); const bf16_t* G = (const bf16_t*)(p.ws + WS_G);
    const float* O = (const float*)(p.ws + WS_O01);
    bf16_t* YC = (bf16_t*)(p.ws + WS_YCAT);
    for (int r = gw; r < M; r += ngw) {
        const long off = (long)r * RC + 8 * lane;
        float o[8]; float s = 0.f;
#pragma unroll
        for (int j = 0; j < 8; ++j) { o[j] = O[off + j] + O[(long)M * RC + off + j]; s += o[j]; }
        s += __shfl_xor(s, 1); s += __shfl_xor(s, 2); s += __shfl_xor(s, 4);
        const float mu = s * (1.f / 64.f); float q = 0.f;
#pragma unroll
        for (int j = 0; j < 8; ++j) { o[j] -= mu; q += o[j] * o[j]; }
        q += __shfl_xor(q, 1); q += __shfl_xor(q, 2); q += __shfl_xor(q, 4);
        const float rstd = rsqrtf(q * (1.f / 64.f) + LNX_EPS);
        float bon = 0.f; float vv[8];
#pragma unroll
        for (int j = 0; j < 8; ++j) {
            const int c = 8 * lane + j;
            const float r_ = bf2f(Rr[off + j]), k_ = bf2f(Kk[off + j]); vv[j] = bf2f(Vv[off + j]);
            const float a0 = bf2f(AA[off + j]), a1 = bf2f(AA[(long)M * RC + off + j]); const float ka = p.rwkv_k_a[c];
            const float kd = k_ * (1.f + (a0 - 1.f) * ka) + k_ * (1.f + (a1 - 1.f) * ka);
            bon += r_ * kd * p.rwkv_r_k[c];
        }
        bon += __shfl_xor(bon, 1); bon += __shfl_xor(bon, 2); bon += __shfl_xor(bon, 4);
#pragma unroll
        for (int j = 0; j < 8; ++j) {
            const int c = 8 * lane + j;
            const float y = (o[j] * rstd * p.rwkv_lnx_w[c] + p.rwkv_lnx_b[c] + bon * vv[j]) * bf2f(G[off + j]);
            YC[(long)r * DM + c] = f2bf(y);
        }
    }
}

__device__ void mla_attn_naive(const Params& p, int unit  , int tid) {
    const int b = unit / 64, h = (unit / 8) % 8, q = (unit % 8) * 256 + tid;
    const bf16_t* Q = (const bf16_t*)(p.ws + WS_Q); const bf16_t* KV = (const bf16_t*)(p.ws + WS_KV); const float* KR = (const float*)(p.ws + WS_KR);
    bf16_t* YC = (bf16_t*)(p.ws + WS_YCAT);
    const long row = (long)b * SEQ + q;
    float qv[96];
#pragma unroll
    for (int j = 0; j < 96; ++j) qv[j] = bf2f(Q[row * 768 + h * 96 + j]);
    {
        const float pos = (float)p.pos[row];
#pragma unroll
        for (int i = 0; i < 16; ++i) {
            const float inv_freq = powf(10000.f, -(float)(2 * i) / 32.f); float sn, cs; sincosf(pos * inv_freq, &sn, &cs);
            const float x1 = qv[64 + i], x2 = qv[80 + i]; qv[64 + i] = x1 * cs - x2 * sn; qv[80 + i] = x2 * cs + x1 * sn;
        }
    }
    const float scale = 0.10206207261596575f;
#pragma unroll
    for (int j = 0; j < 96; ++j) qv[j] *= scale;
    float o[64]; float m = -1e30f, l = 0.f;
#pragma unroll
    for (int j = 0; j < 64; ++j) o[j] = 0.f;
    for (int kv = 0; kv < SEQ; ++kv) {
        const long krow = (long)b * SEQ + kv;
        const u32x4* kp = (const u32x4*)(KV + krow * 1024 + h * 128); const f32x4* kr = (const f32x4*)(KR + krow * 32);
        float s = 0.f;
#pragma unroll
        for (int j = 0; j < 8; ++j) { const u32x4 w = kp[j];
#pragma unroll
            for (int e = 0; e < 4; ++e) { s += qv[8 * j + 2 * e] * __uint_as_float(w[e] << 16); s += qv[8 * j + 2 * e + 1] * __uint_as_float(w[e] & 0xffff0000u); } }
#pragma unroll
        for (int j = 0; j < 8; ++j) { const f32x4 w = kr[j]; s += qv[64 + 4 * j] * w.x + qv[64 + 4 * j + 1] * w.y + qv[64 + 4 * j + 2] * w.z + qv[64 + 4 * j + 3] * w.w; }
        const float mn = fmaxf(m, s), f = __expf(m - mn), pe = __expf(s - mn);
        l = l * f + pe; m = mn;
#pragma unroll
        for (int j = 0; j < 8; ++j) { const u32x4 w = kp[8 + j];
#pragma unroll
            for (int e = 0; e < 4; ++e) { o[8 * j + 2 * e] = o[8 * j + 2 * e] * f + pe * __uint_as_float(w[e] << 16); o[8 * j + 2 * e + 1] = o[8 * j + 2 * e + 1] * f + pe * __uint_as_float(w[e] & 0xffff0000u); } }
    }
    const float il = 1.f / l;
#pragma unroll
    for (int j = 0; j < 64; ++j) YC[row * DM + 512 + h * 64 + j] = f2bf(o[j] * il);
}

__device__ void softmax_rows(const Params& p, int gw, int ngw, int lane) {
    const float* SC = (const float*)(p.ws + WS_SC); bf16_t* P = (bf16_t*)(p.ws + WS_P);
    for (int r = gw; r < 32 * SEQ; r += ngw) {
        const f32x4 v = ((const f32x4*)(SC + (long)r * 256))[lane];
        float mx = fmaxf(fmaxf(v.x, v.y), fmaxf(v.z, v.w));
#pragma unroll
        for (int o = 1; o < 64; o <<= 1) mx = fmaxf(mx, __shfl_xor(mx, o));
        const float e0 = __expf(v.x - mx), e1 = __expf(v.y - mx), e2 = __expf(v.z - mx), e3 = __expf(v.w - mx);
        const float inv = 1.f / wave_sum(e0 + e1 + e2 + e3);
        ((unsigned long long*)(P + (long)r * 256))[lane] = (unsigned long long)pk2(e0 * inv, e1 * inv) | ((unsigned long long)pk2(e2 * inv, e3 * inv) << 32);
    }
}

constexpr int NTHREADS = 512;
constexpr int LDS_BYTES = 2 * 128 * 40 * 2;

template <int PH>
__device__ void run_phase(const Params& p, unsigned char* smem, int bid, int nblk) {
    const int tid = threadIdx.x, lane = tid & 63, wid = tid >> 6;
    const int gw = bid * (NTHREADS / 64) + wid, ngw = nblk * (NTHREADS / 64);
    unsigned char* ws = p.ws;
    if constexpr (PH == 0) {
        norm_rows_bf16(p.x, p.norm_mix_pre, (bf16_t*)(ws + WS_XN), M, gw, ngw, lane);
    } else if constexpr (PH == 1) {
        GemmDesc g{(const bf16_t*)(ws + WS_XN), DM, 0, 0, p.w_in, D_IN, 0, 0, M, D_IN, DM, 1, 1};
        bf16_t* Z = (bf16_t*)(ws + WS_Z);
        gemm_simple<0>(g, [=](int, int r, int c, float v) { Z[(long)r * D_IN + c] = f2bf(v); }, smem, bid, nblk);
    } else if constexpr (PH == 2) {
        mla_prep_rows(p, gw, ngw, lane);
    } else if constexpr (PH == 3) {
        { GemmDesc g{(const bf16_t*)(ws + WS_CQ), 256, 0, 0, p.mla_w_uq, 768, 0, 0, M, 768, 256, 1, 1};
          bf16_t* Q = (bf16_t*)(ws + WS_Q);
          gemm_simple<0>(g, [=](int, int r, int c, float v) { Q[(long)r * 768 + c] = f2bf(v); }, smem, bid, nblk); }
        { GemmDesc g{(const bf16_t*)(ws + WS_CKV), 128, 0, 0, p.mla_w_ukv, 1024, 0, 0, M, 1024, 128, 1, 1};
          bf16_t* KV = (bf16_t*)(ws + WS_KV);
          gemm_simple<0>(g, [=](int, int r, int c, float v) { KV[(long)r * 1024 + c] = f2bf(v); }, smem, bid, nblk); }
    } else if constexpr (PH == 4) {
        for (int u = __builtin_amdgcn_readfirstlane(bid * 2 + (tid >> 8)); u < 512; u += nblk * 2) mla_attn_naive(p, u, tid & 255);
    } else if constexpr (PH == 5) {
        rwkv_prep_rows(p, gw, ngw, lane);
    } else if constexpr (PH == 6) {
        const bf16_t* LIN = (const bf16_t*)(ws + WS_LIN);
        for (int d = 0; d < 2; ++d) {
            { GemmDesc g{LIN + 32 * d, 256, 0, 0, p.rwkv_w2 + (long)d * 32 * RC, RC, 0, 0, M, RC, 32, 1, 1};
              bf16_t* LW = (bf16_t*)(ws + WS_LW) + (long)d * M * RC; const float* w0 = p.rwkv_w0 + d * RC;
              gemm_simple<0>(g, [=](int, int r, int c, float v) {
                  const float xx = -(w0[c] + v);
                  const float sp = fmaxf(xx, 0.f) + log1pf(__expf(-fabsf(xx)));
                  LW[(long)r * RC + c] = f2bf(-__expf(-sp - 0.5f)); }, smem, bid, nblk); }
            { GemmDesc g{LIN + 64 + 32 * d, 256, 0, 0, p.rwkv_a2 + (long)d * 32 * RC, RC, 0, 0, M, RC, 32, 1, 1};
              bf16_t* AA = (bf16_t*)(ws + WS_AA) + (long)d * M * RC; const float* a0 = p.rwkv_a0 + d * RC;
              gemm_simple<0>(g, [=](int, int r, int c, float v) { AA[(long)r * RC + c] = f2bf(sigmoidf_(a0[c] + v)); }, smem, bid, nblk); }
        }
        { GemmDesc g{LIN + 128, 256, 0, 0, p.rwkv_g2, RC, 0, 0, M, RC, 96, 1, 1};
          bf16_t* G = (bf16_t*)(ws + WS_G);
          gemm_simple<0>(g, [=](int, int r, int c, float v) { G[(long)r * RC + c] = f2bf(v); }, smem, bid, nblk); }
    } else if constexpr (PH == 7) {
        for (int c = gw; c < 2 * BATCH * RH; c += ngw) rwkv_scan_naive(p, c, lane);
    } else if constexpr (PH == 8) {
        rwkv_combine_rows(p, gw, ngw, lane);
    } else if constexpr (PH == 9) {
        GemmDesc g{(const bf16_t*)(ws + WS_YCAT), DM, 0, 0, p.w_out, DM, 0, 0, M, DM, DM, 1, 1};
        float* Y = (float*)(ws + WS_Y);
        gemm_simple<0>(g, [=](int, int r, int c, float v) { Y[(long)r * DM + c] = v; }, smem, bid, nblk);
    } else if constexpr (PH == 10) {
        resid_norm_rows(p.x, (const float*)(ws + WS_Y), p.norm_mix_post, p.out, p.norm_mem_pre, (bf16_t*)(ws + WS_XN), gw, ngw, lane);
        norm_rows_bf16(p.mem, p.norm_memtok, (bf16_t*)(ws + WS_MN), BATCH * MEMT, gw, ngw, lane);
    } else if constexpr (PH == 11) {
        { GemmDesc g{(const bf16_t*)(ws + WS_XN), DM, 0, 0, p.mem_wq, DM, 0, 0, M, DM, DM, 1, 1};
          bf16_t* QM = (bf16_t*)(ws + WS_QM);
          gemm_simple<0>(g, [=](int, int r, int c, float v) { QM[(long)r * DM + c] = f2bf(v); }, smem, bid, nblk); }
        { GemmDesc g{(const bf16_t*)(ws + WS_MN), DM, 0, 0, p.mem_wkv, 2048, 0, 0, BATCH * MEMT, 2048, DM, 1, 1};
          bf16_t* KVM = (bf16_t*)(ws + WS_KVM);
          gemm_simple<0>(g, [=](int, int r, int c, float v) { KVM[(long)r * 2048 + c] = f2bf(v); }, smem, bid, nblk); }
    } else if constexpr (PH == 12) {
        GemmDesc g{(const bf16_t*)(ws + WS_QM), DM, (long)SEQ * DM, MEMD, (const bf16_t*)(ws + WS_KVM), 2048, (long)MEMT * 2048, MEMD, SEQ, MEMT, MEMD, BATCH * MEMH, MEMH};
        float* SC = (float*)(ws + WS_SC);
        gemm_simple<2>(g, [=](int bi, int r, int c, float v) { SC[((long)bi * SEQ + r) * MEMT + c] = v * 0.0625f; }, smem, bid, nblk);
    } else if constexpr (PH == 13) {
        softmax_rows(p, gw, ngw, lane);
    } else if constexpr (PH == 14) {
        GemmDesc g{(const bf16_t*)(ws + WS_P), MEMT, (long)MEMH * SEQ * MEMT, (long)SEQ * MEMT, (const bf16_t*)(ws + WS_KVM) + 1024, 2048, (long)MEMT * 2048, MEMD, SEQ, MEMD, MEMT, BATCH * MEMH, MEMH};
        bf16_t* OM = (bf16_t*)(ws + WS_OM);
        gemm_simple<1>(g, [=](int bi, int r, int c, float v) { OM[((long)(bi / MEMH) * SEQ + r) * DM + (bi % MEMH) * MEMD + c] = f2bf(v); }, smem, bid, nblk);
    } else if constexpr (PH == 15) {
        GemmDesc g{(const bf16_t*)(ws + WS_OM), DM, 0, 0, p.mem_wo, DM, 0, 0, M, DM, DM, 1, 1};
        float* Y = (float*)(ws + WS_Y);
        gemm_simple<0>(g, [=](int, int r, int c, float v) { Y[(long)r * DM + c] = v; }, smem, bid, nblk);
    } else if constexpr (PH == 16) {
        resid_norm_rows(p.out, (const float*)(ws + WS_Y), p.norm_mem_post, p.out, p.norm_mlp_pre, (bf16_t*)(ws + WS_XN), gw, ngw, lane);
    } else if constexpr (PH == 17) {
        GemmDesc g{(const bf16_t*)(ws + WS_XN), DM, 0, 0, p.mlp_w1, DFF, 0, 0, M, DFF, DM, 1, 1};
        bf16_t* H = (bf16_t*)(ws + WS_HID);
        gemm_simple<0>(g, [=](int, int r, int c, float v) { const float t = fmaxf(v, 0.f); H[(long)r * DFF + c] = f2bf(t * t); }, smem, bid, nblk);
    } else if constexpr (PH == 18) {
        GemmDesc g{(const bf16_t*)(ws + WS_HID), DFF, 0, 0, p.mlp_w2, DM, 0, 0, M, DM, DFF, 1, 1};
        float* Y = (float*)(ws + WS_Y);
        gemm_simple<0>(g, [=](int, int r, int c, float v) { Y[(long)r * DM + c] = v; }, smem, bid, nblk);
    } else if constexpr (PH == 19) {
        resid_norm_rows(p.out, (const float*)(ws + WS_Y), p.norm_mlp_post, p.out, nullptr, nullptr, gw, ngw, lane);
    }
}

template <int PH>
__global__ void __launch_bounds__(NTHREADS, 2) phase_kernel(Params p) {
    __shared__ __attribute__((aligned(16))) unsigned char smem[LDS_BYTES];
    run_phase<PH>(p, smem, blockIdx.x, gridDim.x);
}

template <int PH> static void launch_phase(const Params& p, int grid, hipStream_t s) {
    hipLaunchKernelGGL(phase_kernel<PH>, dim3(grid), dim3(NTHREADS), 0, s, p);
}

extern "C" void kernel_launch(void* const* d_in, const int* in_sizes, int n_in, void* d_out, int out_size, void* d_ws, size_t ws_size, hipStream_t stream) {
    Params p{};
    p.x = (const float*)d_in[0]; p.mem = (const float*)d_in[1]; p.pos = (const int*)d_in[2];
    const float** f = &p.norm_mix_pre;
    for (int i = 0; i < 29; ++i) f[i] = (const float*)d_in[3 + i];
    p.out = (float*)d_out; p.ws = (unsigned char*)d_ws;
    const int G = 512;
    launch_phase<0>(p, G, stream);  launch_phase<1>(p, G, stream);  launch_phase<2>(p, G, stream);  launch_phase<3>(p, G, stream);
    launch_phase<4>(p, 256, stream); launch_phase<5>(p, G, stream);  launch_phase<6>(p, G, stream);  launch_phase<7>(p, 128, stream);
    launch_phase<8>(p, G, stream);  launch_phase<9>(p, G, stream);  launch_phase<10>(p, G, stream); launch_phase<11>(p, G, stream);
    launch_phase<12>(p, G, stream); launch_phase<13>(p, G, stream); launch_phase<14>(p, G, stream); launch_phase<15>(p, G, stream);
    launch_phase<16>(p, G, stream); launch_phase<17>(p, G, stream); launch_phase<18>(p, G, stream); launch_phase<19>(p, G, stream);
}
```

```cpp
#include <hip/hip_runtime.h>
#include <hip/hip_cooperative_groups.h>
namespace cg = cooperative_groups;
#include <cstdio>
#include <cstdint>

typedef unsigned short bf16_t;
typedef short bf16x8 __attribute__((ext_vector_type(8)));
typedef float f32x4 __attribute__((ext_vector_type(4)));
typedef unsigned u32x4 __attribute__((ext_vector_type(4)));

constexpr int BATCH = 8, SEQ = 2048, DM = 1024, M = BATCH * SEQ;
constexpr int RH = 8, RN = 64, RC = 512;
constexpr int RWKV_COLS = 1760, MLA_COLS = 416, D_IN = 2176;
constexpr int ZC_XW = 1536, ZC_XA = 1600, ZC_XG = 1664;
constexpr int ZC_CQ = 1760, ZC_CKV = 2016, ZC_KR = 2144;
constexpr int MH = 8, NOPE = 64, ROPE = 32, VD = 64, QKD = 96;
constexpr int MEMT = 256, MEMH = 4, MEMD = 256;
constexpr int DFF = 4096;
constexpr float NORM_EPS = 1e-6f, LNX_EPS = 64e-5f;

constexpr size_t MiB = 1u << 20;
constexpr size_t WS_XN   = 0;
constexpr size_t WS_Z    = 32 * MiB;
constexpr size_t WS_YCAT = 100 * MiB;
constexpr size_t WS_CQ   = 132 * MiB;
constexpr size_t WS_CKV  = 140 * MiB;
constexpr size_t WS_KR   = 144 * MiB;
constexpr size_t WS_Q    = 146 * MiB;
constexpr size_t WS_KV   = 170 * MiB;
constexpr size_t WS_LIN  = 132 * MiB;
constexpr size_t WS_LW   = 140 * MiB;
constexpr size_t WS_AA   = 172 * MiB;
constexpr size_t WS_G    = 204 * MiB;
constexpr size_t WS_O01  = 32 * MiB;
constexpr size_t WS_Y    = 32 * MiB;
constexpr size_t WS_QM   = 100 * MiB;
constexpr size_t WS_MN   = 132 * MiB;
constexpr size_t WS_KVM  = 136 * MiB;
constexpr size_t WS_SC   = 144 * MiB;
constexpr size_t WS_P    = 208 * MiB;
constexpr size_t WS_OM   = 100 * MiB;
constexpr size_t WS_HID  = 96 * MiB;

struct Params {
    const float* x; const float* mem; const int* pos;
    const float *norm_mix_pre, *w_in, *conv_rwkv, *rwkv_w0, *rwkv_w2, *rwkv_a0, *rwkv_a2, *rwkv_g2, *rwkv_k_k, *rwkv_k_a, *rwkv_r_k,
                *rwkv_lnx_w, *rwkv_lnx_b, *mla_q_norm, *mla_w_uq, *mla_kv_norm, *mla_w_ukv, *w_out, *norm_mix_post, *norm_mem_pre,
                *norm_memtok, *mem_wq, *mem_wkv, *mem_wo, *norm_mem_post, *norm_mlp_pre, *mlp_w1, *mlp_w2, *norm_mlp_post;
    float* out; unsigned char* ws;
};

__device__ __forceinline__ float bf2f(bf16_t v) { return __uint_as_float((unsigned)v << 16); }
__device__ __forceinline__ bf16_t f2bf(float f) { unsigned u = __float_as_uint(f); return (bf16_t)((u + 0x7fffu + ((u >> 16) & 1u)) >> 16); }
__device__ __forceinline__ unsigned pk2(float lo, float hi) { return (unsigned)f2bf(lo) | ((unsigned)f2bf(hi) << 16); }
__device__ __forceinline__ float wave_sum(float v) {
#pragma unroll
    for (int o = 1; o < 64; o <<= 1) v += __shfl_xor(v, o);
    return v;
}
__device__ __forceinline__ float sigmoidf_(float x) { return 1.f / (1.f + __expf(-x)); }
__device__ __forceinline__ float rdlane(float v, int k) { return __uint_as_float((unsigned)__builtin_amdgcn_readlane((int)__float_as_uint(v), k)); }

struct GemmDesc {
    const bf16_t* A; int lda; long sAb, sAh;
    const void* B; int ldb; long sBb, sBh;
    int Mm, Nn, Kk, nbatch, nh;
};
template <int BMODE  , class EP>
__device__ void gemm_simple(const GemmDesc g, EP epi, unsigned char* smem, int bid, int nblk) {
    bf16_t* sA = (bf16_t*)smem;
    bf16_t* sB = sA + 128 * 40;
    const int tid = threadIdx.x, lane = tid & 63, wid = tid >> 6, wr = wid >> 2, wc = wid & 3, fr = lane & 15, fq = lane >> 4;
    const int tM = g.Mm / 128, tN = g.Nn / 128, ntile = tM * tN * g.nbatch;
    for (int t = bid; t < ntile; t += nblk) {
        const int bi = t / (tM * tN), tt = t % (tM * tN), tm = tt / tN, tn = tt % tN;
        const bf16_t* A = g.A + (long)(bi / g.nh) * g.sAb + (long)(bi % g.nh) * g.sAh + (long)tm * 128 * g.lda;
        const long boff = (long)(bi / g.nh) * g.sBb + (long)(bi % g.nh) * g.sBh;
        f32x4 acc[4][2];
#pragma unroll
        for (int i = 0; i < 4; ++i)
#pragma unroll
            for (int j = 0; j < 2; ++j) acc[i][j] = (f32x4){0.f, 0.f, 0.f, 0.f};
        for (int k0 = 0; k0 < g.Kk; k0 += 32) {
            __syncthreads();
            {
                const int r = tid >> 2, c = (tid & 3) * 8;
                const u32x4 v = *(const u32x4*)(A + (long)r * g.lda + k0 + c);
                *(u32x4*)(sA + r * 40 + c) = v;
            }
            if (BMODE == 2) {
                const bf16_t* B = (const bf16_t*)g.B + boff + (long)tn * 128 * g.ldb;
                const int r = tid >> 2, c = (tid & 3) * 8;
                const u32x4 v = *(const u32x4*)(B + (long)r * g.ldb + k0 + c);
                *(u32x4*)(sB + r * 40 + c) = v;
            } else if (BMODE == 0) {
                const float* B = (const float*)g.B + boff + (long)tn * 128;
                const int k = tid >> 4, n = (tid & 15) * 8;
                const f32x4 v0 = *(const f32x4*)(B + (long)(k0 + k) * g.ldb + n), v1 = *(const f32x4*)(B + (long)(k0 + k) * g.ldb + n + 4);
#pragma unroll
                for (int j = 0; j < 4; ++j) { sB[(n + j) * 40 + k] = f2bf(v0[j]); sB[(n + 4 + j) * 40 + k] = f2bf(v1[j]); }
            } else {
                const bf16_t* B = (const bf16_t*)g.B + boff + (long)tn * 128;
                const int k = tid >> 4, n = (tid & 15) * 8;
                const u32x4 v = *(const u32x4*)(B + (long)(k0 + k) * g.ldb + n);
                const bf16_t* e = (const bf16_t*)&v;
#pragma unroll
                for (int j = 0; j < 8; ++j) sB[(n + j) * 40 + k] = e[j];
            }
            __syncthreads();
            bf16x8 af[4], bfr[2];
#pragma unroll
            for (int i = 0; i < 4; ++i) af[i] = *(const bf16x8*)(sA + (wr * 64 + i * 16 + fr) * 40 + fq * 8);
#pragma unroll
            for (int j = 0; j < 2; ++j) bfr[j] = *(const bf16x8*)(sB + (wc * 32 + j * 16 + fr) * 40 + fq * 8);
#pragma unroll
            for (int i = 0; i < 4; ++i)
#pragma unroll
                for (int j = 0; j < 2; ++j) acc[i][j] = __builtin_amdgcn_mfma_f32_16x16x32_bf16(af[i], bfr[j], acc[i][j], 0, 0, 0);
        }
#pragma unroll
        for (int i = 0; i < 4; ++i)
#pragma unroll
            for (int j = 0; j < 2; ++j)
#pragma unroll
                for (int e = 0; e < 4; ++e) epi(bi, tm * 128 + wr * 64 + i * 16 + fq * 4 + e, tn * 128 + wc * 32 + j * 16 + fr, acc[i][j][e]);
    }
}

__device__ void norm_rows_bf16(const float* in, const float* gain, bf16_t* outb, int nrows, int gw, int ngw, int lane) {
    for (int r = gw; r < nrows; r += ngw) {
        const f32x4* xr = (const f32x4*)(in + (long)r * DM) + lane;
        f32x4 v[4]; float s = 0.f;
#pragma unroll
        for (int j = 0; j < 4; ++j) { v[j] = xr[64 * j]; s += v[j].x * v[j].x + v[j].y * v[j].y + v[j].z * v[j].z + v[j].w * v[j].w; }
        const float rstd = rsqrtf(wave_sum(s) * (1.f / DM) + NORM_EPS);
        unsigned long long* o8 = (unsigned long long*)(outb + (long)r * DM) + lane;
#pragma unroll
        for (int j = 0; j < 4; ++j) { const f32x4 gg = ((const f32x4*)gain)[lane + 64 * j];
            o8[64 * j] = (unsigned long long)pk2(v[j].x * rstd * gg.x, v[j].y * rstd * gg.y) | ((unsigned long long)pk2(v[j].z * rstd * gg.z, v[j].w * rstd * gg.w) << 32); }
    }
}
__device__ void resid_norm_rows(const float* base, const float* y, const float* g_post, float* xo, const float* g_next, bf16_t* xn, int gw, int ngw, int lane) {
    for (int r = gw; r < M; r += ngw) {
        const f32x4* yr = (const f32x4*)(y + (long)r * DM) + lane; const f32x4* br = (const f32x4*)(base + (long)r * DM) + lane;
        f32x4 v[4], b[4]; float s = 0.f;
#pragma unroll
        for (int j = 0; j < 4; ++j) { v[j] = yr[64 * j]; b[j] = br[64 * j]; s += v[j].x * v[j].x + v[j].y * v[j].y + v[j].z * v[j].z + v[j].w * v[j].w; }
        const float rstd = rsqrtf(wave_sum(s) * (1.f / DM) + NORM_EPS);
        float s2 = 0.f;
#pragma unroll
        for (int j = 0; j < 4; ++j) { const f32x4 gg = ((const f32x4*)g_post)[lane + 64 * j];
            v[j].x = b[j].x + v[j].x * rstd * gg.x; v[j].y = b[j].y + v[j].y * rstd * gg.y; v[j].z = b[j].z + v[j].z * rstd * gg.z; v[j].w = b[j].w + v[j].w * rstd * gg.w;
            s2 += v[j].x * v[j].x + v[j].y * v[j].y + v[j].z * v[j].z + v[j].w * v[j].w; }
        f32x4* orow = (f32x4*)(xo + (long)r * DM) + lane;
#pragma unroll
        for (int j = 0; j < 4; ++j) orow[64 * j] = v[j];
        if (xn) {
            const float rstd2 = rsqrtf(wave_sum(s2) * (1.f / DM) + NORM_EPS);
            unsigned long long* o8 = (unsigned long long*)(xn + (long)r * DM) + lane;
#pragma unroll
            for (int j = 0; j < 4; ++j) { const f32x4 gg = ((const f32x4*)g_next)[lane + 64 * j];
                o8[64 * j] = (unsigned long long)pk2(v[j].x * rstd2 * gg.x, v[j].y * rstd2 * gg.y) | ((unsigned long long)pk2(v[j].z * rstd2 * gg.z, v[j].w * rstd2 * gg.w) << 32); }
        }
    }
}

__device__ void mla_prep_rows(const Params& p, int gw, int ngw, int lane) {
    const bf16_t* Z = (const bf16_t*)(p.ws + WS_Z);
    bf16_t* CQ = (bf16_t*)(p.ws + WS_CQ); bf16_t* CKV = (bf16_t*)(p.ws + WS_CKV); float* KR = (float*)(p.ws + WS_KR);
    for (int r = gw; r < M; r += ngw) {
        const bf16_t* zr = Z + (long)r * D_IN;
        float q[4]; float s = 0.f;
#pragma unroll
        for (int j = 0; j < 4; ++j) { q[j] = bf2f(zr[ZC_CQ + 4 * lane + j]); s += q[j] * q[j]; }
        const float rq = rsqrtf(wave_sum(s) * (1.f / 256.f) + NORM_EPS);
#pragma unroll
        for (int j = 0; j < 4; ++j) CQ[(long)r * 256 + 4 * lane + j] = f2bf(q[j] * rq * p.mla_q_norm[4 * lane + j]);
        float c[2]; s = 0.f;
#pragma unroll
        for (int j = 0; j < 2; ++j) { c[j] = bf2f(zr[ZC_CKV + 2 * lane + j]); s += c[j] * c[j]; }
        const float rk = rsqrtf(wave_sum(s) * (1.f / 128.f) + NORM_EPS);
#pragma unroll
        for (int j = 0; j < 2; ++j) CKV[(long)r * 128 + 2 * lane + j] = f2bf(c[j] * rk * p.mla_kv_norm[2 * lane + j]);
        if (lane < 16) {
            const float x1 = bf2f(zr[ZC_KR + lane]), x2 = bf2f(zr[ZC_KR + 16 + lane]);
            const float inv_freq = powf(10000.f, -(float)(2 * lane) / 32.f);
            const float ang = (float)p.pos[r] * inv_freq; float sn, cs; sincosf(ang, &sn, &cs);
            KR[(long)r * 32 + lane] = x1 * cs - x2 * sn; KR[(long)r * 32 + 16 + lane] = x2 * cs + x1 * sn;
        }
    }
}

__device__ void rwkv_prep_rows(const Params& p, int gw, int ngw, int lane) {
    const bf16_t* Z = (const bf16_t*)(p.ws + WS_Z);
    bf16_t* RK = (bf16_t*)p.out;
    bf16_t* LIN = (bf16_t*)(p.ws + WS_LIN);
    for (int r = gw; r < M; r += ngw) {
        const int s = r % SEQ; const bool hp = s > 0, hn = s < SEQ - 1;
        const bf16_t* zc = Z + (long)r * D_IN;
        float val[3][8];
#pragma unroll
        for (int sec = 0; sec < 3; ++sec) {
            const int c0 = sec * 512 + 8 * lane;
#pragma unroll
            for (int j = 0; j < 8; ++j) {
                const int c = c0 + j;
                float a = p.conv_rwkv[RWKV_COLS + c] * bf2f(zc[c]);
                if (hp) a += p.conv_rwkv[c] * bf2f(zc[c - D_IN]);
                if (hn) a += p.conv_rwkv[2 * RWKV_COLS + c] * bf2f(zc[c + D_IN]);
                val[sec][j] = a;
            }
        }
        float kk[8]; float ss = 0.f;
#pragma unroll
        for (int j = 0; j < 8; ++j) { kk[j] = val[1][j] * p.rwkv_k_k[8 * lane + j]; ss += kk[j] * kk[j]; }
        ss += __shfl_xor(ss, 1); ss += __shfl_xor(ss, 2); ss += __shfl_xor(ss, 4);
        const float rn = rsqrtf(fmaxf(ss, 1e-24f));
#pragma unroll
        for (int j = 0; j < 8; ++j) {
            RK[(long)0 * M * RC + (long)r * RC + 8 * lane + j] = f2bf(val[0][j]);
            RK[(long)1 * M * RC + (long)r * RC + 8 * lane + j] = f2bf(val[1][j]);
            RK[(long)2 * M * RC + (long)r * RC + 8 * lane + j] = f2bf(val[2][j]);
            RK[(long)3 * M * RC + (long)r * RC + 8 * lane + j] = f2bf(kk[j] * rn);
        }
        if (lane < 56) {
#pragma unroll
            for (int j = 0; j < 4; ++j) {
                const int c = 1536 + 4 * lane + j;
                float a = p.conv_rwkv[RWKV_COLS + c] * bf2f(zc[c]);
                if (hp) a += p.conv_rwkv[c] * bf2f(zc[c - D_IN]);
                if (hn) a += p.conv_rwkv[2 * RWKV_COLS + c] * bf2f(zc[c + D_IN]);
                float o;
                if (c < ZC_XA) o = tanhf(a); else if (c < ZC_XG) o = a; else o = sigmoidf_(a);
                LIN[(long)r * 256 + 4 * lane + j] = f2bf(o);
            }
        } else {
#pragma unroll
            for (int j = 0; j < 4; ++j) LIN[(long)r * 256 + 4 * lane + j] = 0;
        }
    }
}

__device__ void rwkv_scan_naive(const Params& p, int chain, int lane) {
    const int d = chain / (BATCH * RH), b = (chain / RH) % BATCH, h = chain % RH;
    const bf16_t* RK = (const bf16_t*)p.out;
    const bf16_t* Rr = RK, *Kk = RK + (long)M * RC, *Vv = RK + 2L * M * RC, *KK = RK + 3L * M * RC;
    const bf16_t* LW = (const bf16_t*)(p.ws + WS_LW) + (long)d * M * RC;
    const bf16_t* AA = (const bf16_t*)(p.ws + WS_AA) + (long)d * M * RC;
    float* O = (float*)(p.ws + WS_O01) + (long)d * M * RC;
    const float ka = p.rwkv_k_a[h * RN + lane];
    float S[64];
#pragma unroll
    for (int k = 0; k < 64; ++k) S[k] = 0.f;
    for (int t = 0; t < SEQ; ++t) {
        const int s = d ? (SEQ - 1 - t) : t;
        const long off = ((long)(b * SEQ + s)) * RC + h * RN + lane;
        const float r_ = bf2f(Rr[off]), k_ = bf2f(Kk[off]), v_ = bf2f(Vv[off]), kk_ = bf2f(KK[off]);
        const float w_ = __expf(bf2f(LW[off])), a_ = bf2f(AA[off]);
        const float an = -kk_, bn = kk_ * a_, kn = k_ * (1.f + (a_ - 1.f) * ka);
        float sa = 0.f;
#pragma unroll
        for (int k = 0; k < 64; ++k) sa += S[k] * rdlane(an, k);
        float o = 0.f;
#pragma unroll
        for (int k = 0; k < 64; ++k) {
            S[k] = S[k] * rdlane(w_, k) + sa * rdlane(bn, k) + v_ * rdlane(kn, k);
            o += S[k] * rdlane(r_, k);
        }
        O[off] = o;
    }
}

__device__ void rwkv_combine_rows(const Params& p, int gw, int ngw, int lane) {
    const bf16_t* RK = (const bf16_t*)p.out;
    const bf16_t* Rr = RK, *Kk = RK + (long)M * RC, *Vv = RK + 2L * M * RC;
    const bf16_t* AA = (const bf16_t*)(p.ws + WS_AA); const bf16_t* G = (const bf16_t*)(p.ws + WS_G);
    const float* O = (const float*)(p.ws + WS_O01);
    bf16_t* YC = (bf16_t*)(p.ws + WS_YCAT);
    for (int r = gw; r < M; r += ngw) {
        const long off = (long)r * RC + 8 * lane;
        float o[8]; float s = 0.f;
#pragma unroll
        for (int j = 0; j < 8; ++j) { o[j] = O[off + j] + O[(long)M * RC + off + j]; s += o[j]; }
        s += __shfl_xor(s, 1); s += __shfl_xor(s, 2); s += __shfl_xor(s, 4);
        const float mu = s * (1.f / 64.f); float q = 0.f;
#pragma unroll
        for (int j = 0; j < 8; ++j) { o[j] -= mu; q += o[j] * o[j]; }
        q += __shfl_xor(q, 1); q += __shfl_xor(q, 2); q += __shfl_xor(q, 4);
        const float rstd = rsqrtf(q * (1.f / 64.f) + LNX_EPS);
        float bon = 0.f; float vv[8];
#pragma unroll
        for (int j = 0; j < 8; ++j) {
            const int c = 8 * lane + j;
            const float r_ = bf2f(Rr[off + j]), k_ = bf2f(Kk[off + j]); vv[j] = bf2f(Vv[off + j]);
            const float a0 = bf2f(AA[off + j]), a1 = bf2f(AA[(long)M * RC + off + j]); const float ka = p.rwkv_k_a[c];
            const float kd = k_ * (1.f + (a0 - 1.f) * ka) + k_ * (1.f + (a1 - 1.f) * ka);
            bon += r_ * kd * p.rwkv_r_k[c];
        }
        bon += __shfl_xor(bon, 1); bon += __shfl_xor(bon, 2); bon += __shfl_xor(bon, 4);
#pragma unroll
        for (int j = 0; j < 8; ++j) {
            const int c = 8 * lane + j;
            const float y = (o[j] * rstd * p.rwkv_lnx_w[c] + p.rwkv_lnx_b[c] + bon * vv[j]) * bf2f(G[off + j]);
            YC[(long)r * DM + c] = f2bf(y);
        }
    }
}

__device__ void mla_attn_naive(const Params& p, int unit  , int tid) {
    const int b = unit / 64, h = (unit / 8) % 8, q = (unit % 8) * 256 + tid;
    const bf16_t* Q = (const bf16_t*)(p.ws + WS_Q); const bf16_t* KV = (const bf16_t*)(p.ws + WS_KV); const float* KR = (const float*)(p.ws + WS_KR);
    bf16_t* YC = (bf16_t*)(p.ws + WS_YCAT);
    const long row = (long)b * SEQ + q;
    float qv[96];
#pragma unroll
    for (int j = 0; j < 96; ++j) qv[j] = bf2f(Q[row * 768 + h * 96 + j]);
    {
        const float pos = (float)p.pos[row];
#pragma unroll
        for (int i = 0; i < 16; ++i) {
            const float inv_freq = powf(10000.f, -(float)(2 * i) / 32.f); float sn, cs; sincosf(pos * inv_freq, &sn, &cs);
            const float x1 = qv[64 + i], x2 = qv[80 + i]; qv[64 + i] = x1 * cs - x2 * sn; qv[80 + i] = x2 * cs + x1 * sn;
        }
    }
    const float scale = 0.10206207261596575f;
#pragma unroll
    for (int j = 0; j < 96; ++j) qv[j] *= scale;
    float o[64]; float m = -1e30f, l = 0.f;
#pragma unroll
    for (int j = 0; j < 64; ++j) o[j] = 0.f;
    for (int kv = 0; kv < SEQ; ++kv) {
        const long krow = (long)b * SEQ + kv;
        const u32x4* kp = (const u32x4*)(KV + krow * 1024 + h * 128); const f32x4* kr = (const f32x4*)(KR + krow * 32);
        float s = 0.f;
#pragma unroll
        for (int j = 0; j < 8; ++j) { const u32x4 w = kp[j];
#pragma unroll
            for (int e = 0; e < 4; ++e) { s += qv[8 * j + 2 * e] * __uint_as_float(w[e] << 16); s += qv[8 * j + 2 * e + 1] * __uint_as_float(w[e] & 0xffff0000u); } }
#pragma unroll
        for (int j = 0; j < 8; ++j) { const f32x4 w = kr[j]; s += qv[64 + 4 * j] * w.x + qv[64 + 4 * j + 1] * w.y + qv[64 + 4 * j + 2] * w.z + qv[64 + 4 * j + 3] * w.w; }
        const float mn = fmaxf(m, s), f = __expf(m - mn), pe = __expf(s - mn);
        l = l * f + pe; m = mn;
#pragma unroll
        for (int j = 0; j < 8; ++j) { const u32x4 w = kp[8 + j];
#pragma unroll
            for (int e = 0; e < 4; ++e) { o[8 * j + 2 * e] = o[8 * j + 2 * e] * f + pe * __uint_as_float(w[e] << 16); o[8 * j + 2 * e + 1] = o[8 * j + 2 * e + 1] * f + pe * __uint_as_float(w[e] & 0xffff0000u); } }
    }
    const float il = 1.f / l;
#pragma unroll
    for (int j = 0; j < 64; ++j) YC[row * DM + 512 + h * 64 + j] = f2bf(o[j] * il);
}

__device__ void softmax_rows(const Params& p, int gw, int ngw, int lane) {
    const float* SC = (const float*)(p.ws + WS_SC); bf16_t* P = (bf16_t*)(p.ws + WS_P);
    for (int r = gw; r < 32 * SEQ; r += ngw) {
        const f32x4 v = ((const f32x4*)(SC + (long)r * 256))[lane];
        float mx = fmaxf(fmaxf(v.x, v.y), fmaxf(v.z, v.w));
#pragma unroll
        for (int o = 1; o < 64; o <<= 1) mx = fmaxf(mx, __shfl_xor(mx, o));
        const float e0 = __expf(v.x - mx), e1 = __expf(v.y - mx), e2 = __expf(v.z - mx), e3 = __expf(v.w - mx);
        const float inv = 1.f / wave_sum(e0 + e1 + e2 + e3);
        ((unsigned long long*)(P + (long)r * 256))[lane] = (unsigned long long)pk2(e0 * inv, e1 * inv) | ((unsigned long long)pk2(e2 * inv, e3 * inv) << 32);
    }
}

constexpr int NTHREADS = 512;
constexpr int LDS_BYTES = 2 * 128 * 40 * 2;

template <int PH>
__device__ void run_phase(const Params& p, unsigned char* smem, int bid, int nblk) {
    const int tid = threadIdx.x, lane = tid & 63, wid = tid >> 6;
    const int gw = bid * (NTHREADS / 64) + wid, ngw = nblk * (NTHREADS / 64);
    unsigned char* ws = p.ws;
    if constexpr (PH == 0) {
        norm_rows_bf16(p.x, p.norm_mix_pre, (bf16_t*)(ws + WS_XN), M, gw, ngw, lane);
    } else if constexpr (PH == 1) {
        GemmDesc g{(const bf16_t*)(ws + WS_XN), DM, 0, 0, p.w_in, D_IN, 0, 0, M, D_IN, DM, 1, 1};
        bf16_t* Z = (bf16_t*)(ws + WS_Z);
        gemm_simple<0>(g, [=](int, int r, int c, float v) { Z[(long)r * D_IN + c] = f2bf(v); }, smem, bid, nblk);
    } else if constexpr (PH == 2) {
        mla_prep_rows(p, gw, ngw, lane);
    } else if constexpr (PH == 3) {
        { GemmDesc g{(const bf16_t*)(ws + WS_CQ), 256, 0, 0, p.mla_w_uq, 768, 0, 0, M, 768, 256, 1, 1};
          bf16_t* Q = (bf16_t*)(ws + WS_Q);
          gemm_simple<0>(g, [=](int, int r, int c, float v) { Q[(long)r * 768 + c] = f2bf(v); }, smem, bid, nblk); }
        { GemmDesc g{(const bf16_t*)(ws + WS_CKV), 128, 0, 0, p.mla_w_ukv, 1024, 0, 0, M, 1024, 128, 1, 1};
          bf16_t* KV = (bf16_t*)(ws + WS_KV);
          gemm_simple<0>(g, [=](int, int r, int c, float v) { KV[(long)r * 1024 + c] = f2bf(v); }, smem, bid, nblk); }
    } else if constexpr (PH == 4) {
        for (int u = __builtin_amdgcn_readfirstlane(bid * 2 + (tid >> 8)); u < 512; u += nblk * 2) mla_attn_naive(p, u, tid & 255);
    } else if constexpr (PH == 5) {
        rwkv_prep_rows(p, gw, ngw, lane);
    } else if constexpr (PH == 6) {
        const bf16_t* LIN = (const bf16_t*)(ws + WS_LIN);
        for (int d = 0; d < 2; ++d) {
            { GemmDesc g{LIN + 32 * d, 256, 0, 0, p.rwkv_w2 + (long)d * 32 * RC, RC, 0, 0, M, RC, 32, 1, 1};
              bf16_t* LW = (bf16_t*)(ws + WS_LW) + (long)d * M * RC; const float* w0 = p.rwkv_w0 + d * RC;
              gemm_simple<0>(g, [=](int, int r, int c, float v) {
                  const float xx = -(w0[c] + v);
                  const float sp = fmaxf(xx, 0.f) + log1pf(__expf(-fabsf(xx)));
                  LW[(long)r * RC + c] = f2bf(-__expf(-sp - 0.5f)); }, smem, bid, nblk); }
            { GemmDesc g{LIN + 64 + 32 * d, 256, 0, 0, p.rwkv_a2 + (long)d * 32 * RC, RC, 0, 0, M, RC, 32, 1, 1};
              bf16_t* AA = (bf16_t*)(ws + WS_AA) + (long)d * M * RC; const float* a0 = p.rwkv_a0 + d * RC;
              gemm_simple<0>(g, [=](int, int r, int c, float v) { AA[(long)r * RC + c] = f2bf(sigmoidf_(a0[c] + v)); }, smem, bid, nblk); }
        }
        { GemmDesc g{LIN + 128, 256, 0, 0, p.rwkv_g2, RC, 0, 0, M, RC, 96, 1, 1};
          bf16_t* G = (bf16_t*)(ws + WS_G);
          gemm_simple<0>(g, [=](int, int r, int c, float v) { G[(long)r * RC + c] = f2bf(v); }, smem, bid, nblk); }
    } else if constexpr (PH == 7) {
        for (int c = gw; c < 2 * BATCH * RH; c += ngw) rwkv_scan_naive(p, c, lane);
    } else if constexpr (PH == 8) {
        rwkv_combine_rows(p, gw, ngw, lane);
    } else if constexpr (PH == 9) {
        GemmDesc g{(const bf16_t*)(ws + WS_YCAT), DM, 0, 0, p.w_out, DM, 0, 0, M, DM, DM, 1, 1};
        float* Y = (float*)(ws + WS_Y);
        gemm_simple<0>(g, [=](int, int r, int c, float v) { Y[(long)r * DM + c] = v; }, smem, bid, nblk);
    } else if constexpr (PH == 10) {
        resid_norm_rows(p.x, (const float*)(ws + WS_Y), p.norm_mix_post, p.out, p.norm_mem_pre, (bf16_t*)(ws + WS_XN), gw, ngw, lane);
        norm_rows_bf16(p.mem, p.norm_memtok, (bf16_t*)(ws + WS_MN), BATCH * MEMT, gw, ngw, lane);
    } else if constexpr (PH == 11) {
        { GemmDesc g{(const bf16_t*)(ws + WS_XN), DM, 0, 0, p.mem_wq, DM, 0, 0, M, DM, DM, 1, 1};
          bf16_t* QM = (bf16_t*)(ws + WS_QM);
          gemm_simple<0>(g, [=](int, int r, int c, float v) { QM[(long)r * DM + c] = f2bf(v); }, smem, bid, nblk); }
        { GemmDesc g{(const bf16_t*)(ws + WS_MN), DM, 0, 0, p.mem_wkv, 2048, 0, 0, BATCH * MEMT, 2048, DM, 1, 1};
          bf16_t* KVM = (bf16_t*)(ws + WS_KVM);
          gemm_simple<0>(g, [=](int, int r, int c, float v) { KVM[(long)r * 2048 + c] = f2bf(v); }, smem, bid, nblk); }
    } else if constexpr (PH == 12) {
        GemmDesc g{(const bf16_t*)(ws + WS_QM), DM, (long)SEQ * DM, MEMD, (const bf16_t*)(ws + WS_KVM), 2048, (long)MEMT * 2048, MEMD, SEQ, MEMT, MEMD, BATCH * MEMH, MEMH};
        float* SC = (float*)(ws + WS_SC);
        gemm_simple<2>(g, [=](int bi, int r, int c, float v) { SC[((long)bi * SEQ + r) * MEMT + c] = v * 0.0625f; }, smem, bid, nblk);
    } else if constexpr (PH == 13) {
        softmax_rows(p, gw, ngw, lane);
    } else if constexpr (PH == 14) {
        GemmDesc g{(const bf16_t*)(ws + WS_P), MEMT, (long)MEMH * SEQ * MEMT, (long)SEQ * MEMT, (const bf16_t*)(ws + WS_KVM) + 1024, 2048, (long)MEMT * 2048, MEMD, SEQ, MEMD, MEMT, BATCH * MEMH, MEMH};
        bf16_t* OM = (bf16_t*)(ws + WS_OM);
        gemm_simple<1>(g, [=](int bi, int r, int c, float v) { OM[((long)(bi / MEMH) * SEQ + r) * DM + (bi % MEMH) * MEMD + c] = f2bf(v); }, smem, bid, nblk);
    } else if constexpr (PH == 15) {
        GemmDesc g{(const bf16_t*)(ws + WS_OM), DM, 0, 0, p.mem_wo, DM, 0, 0, M, DM, DM, 1, 1};
        float* Y = (float*)(ws + WS_Y);
        gemm_simple<0>(g, [=](int, int r, int c, float v) { Y[(long)r * DM + c] = v; }, smem, bid, nblk);
    } else if constexpr (PH == 16) {
        resid_norm_rows(p.out, (const float*)(ws + WS_Y), p.norm_mem_post, p.out, p.norm_mlp_pre, (bf16_t*)(ws + WS_XN), gw, ngw, lane);
    } else if constexpr (PH == 17) {
        GemmDesc g{(const bf16_t*)(ws + WS_XN), DM, 0, 0, p.mlp_w1, DFF, 0, 0, M, DFF, DM, 1, 1};
        bf16_t* H = (bf16_t*)(ws + WS_HID);
        gemm_simple<0>(g, [=](int, int r, int c, float v) { const float t = fmaxf(v, 0.f); H[(long)r * DFF + c] = f2bf(t * t); }, smem, bid, nblk);
    } else if constexpr (PH == 18) {
        GemmDesc g{(const bf16_t*)(ws + WS_HID), DFF, 0, 0, p.mlp_w2, DM, 0, 0, M, DM, DFF, 1, 1};
        float* Y = (float*)(ws + WS_Y);
        gemm_simple<0>(g, [=](int, int r, int c, float v) { Y[(long)r * DM + c] = v; }, smem, bid, nblk);
    } else if constexpr (PH == 19) {
        resid_norm_rows(p.out, (const float*)(ws + WS_Y), p.norm_mlp_post, p.out, nullptr, nullptr, gw, ngw, lane);
    }
}

template <int PH>
__global__ void __launch_bounds__(NTHREADS, 2) phase_kernel(Params p) {
    __shared__ __attribute__((aligned(16))) unsigned char smem[LDS_BYTES];
    run_phase<PH>(p, smem, blockIdx.x, gridDim.x);
}

template <int PH> __device__ __forceinline__ void run_all(const Params& p, unsigned char* smem, cg::grid_group& grid) {
    run_phase<PH>(p, smem, blockIdx.x, gridDim.x);
    if constexpr (PH + 1 < 20) { grid.sync(); run_all<PH + 1>(p, smem, grid); }
}
__global__ void __launch_bounds__(NTHREADS, 2) mega_kernel(Params p) {
    __shared__ __attribute__((aligned(16))) unsigned char smem[LDS_BYTES];
    cg::grid_group grid = cg::this_grid();
    run_all<0>(p, smem, grid);
}

extern "C" void kernel_launch(void* const* d_in, const int* in_sizes, int n_in, void* d_out, int out_size, void* d_ws, size_t ws_size, hipStream_t stream) {
    static int grid_blocks = 0;
    if (!grid_blocks) {
        int dev = 0, cus = 0, per_cu = 0;
        (void)hipGetDevice(&dev);
        (void)hipDeviceGetAttribute(&cus, hipDeviceAttributeMultiprocessorCount, dev);
        (void)hipOccupancyMaxActiveBlocksPerMultiprocessor(&per_cu, mega_kernel, NTHREADS, 0);
        if (per_cu < 1) per_cu = 1;
        grid_blocks = cus * per_cu;
        fprintf(stderr, "kernel_launch: cus=%d per_cu=%d grid=%d\n", cus, per_cu, grid_blocks);
    }
    Params p{};
    p.x = (const float*)d_in[0]; p.mem = (const float*)d_in[1]; p.pos = (const int*)d_in[2];
    const float** f = &p.norm_mix_pre;
    for (int i = 0; i < 29; ++i) f[i] = (const float*)d_in[3 + i];
    p.out = (float*)d_out; p.ws = (unsigned char*)d_ws;
    void* args[] = {&p};
    hipError_t e = hipLaunchCooperativeKernel((void*)mega_kernel, dim3(grid_blocks), dim3(NTHREADS), args, 0, stream);
    if (e != hipSuccess) fprintf(stderr, "cooperative launch failed: %s (grid %d)\n", hipGetErrorString(e), grid_blocks);
}
```

```cpp
#include <hip/hip_runtime.h>
#include <hip/hip_cooperative_groups.h>
namespace cg = cooperative_groups;
#include <cstdio>
#include <cstdint>

typedef unsigned short bf16_t;
typedef short bf16x8 __attribute__((ext_vector_type(8)));
typedef float f32x4 __attribute__((ext_vector_type(4)));
typedef unsigned u32x4 __attribute__((ext_vector_type(4)));

constexpr int BATCH = 8, SEQ = 2048, DM = 1024, M = BATCH * SEQ;
constexpr int RH = 8, RN = 64, RC = 512;
constexpr int RWKV_COLS = 1760, MLA_COLS = 416, D_IN = 2176;
constexpr int ZC_XW = 1536, ZC_XA = 1600, ZC_XG = 1664;
constexpr int ZC_CQ = 1760, ZC_CKV = 2016, ZC_KR = 2144;
constexpr int MH = 8, NOPE = 64, ROPE = 32, VD = 64, QKD = 96;
constexpr int MEMT = 256, MEMH = 4, MEMD = 256;
constexpr int DFF = 4096;
constexpr float NORM_EPS = 1e-6f, LNX_EPS = 64e-5f;

constexpr size_t MiB = 1u << 20;
constexpr int ZLD = 2304;
constexpr size_t WS_WIN  = 0;
constexpr size_t WS_WOUT = 5 * MiB;
constexpr size_t WS_WQ   = 7 * MiB;
constexpr size_t WS_WKV  = 9 * MiB;
constexpr size_t WS_WO   = 13 * MiB;
constexpr size_t WS_W1   = 15 * MiB;
constexpr size_t WS_W2   = 23 * MiB;
constexpr size_t WS_WUQ  = 31 * MiB;
constexpr size_t WS_WUKV = 31 * MiB + 512 * 1024;
constexpr size_t WS_WLG  = 32 * MiB;
constexpr size_t WS_XN   = 34 * MiB;
constexpr size_t WS_Z    = 66 * MiB;
constexpr size_t WS_YCAT = 138 * MiB;
constexpr size_t WS_CQ   = 170 * MiB;
constexpr size_t WS_CKV  = 178 * MiB;
constexpr size_t WS_KR   = 186 * MiB;
constexpr size_t WS_Q    = 188 * MiB;
constexpr size_t WS_KV   = 212 * MiB;
constexpr size_t WS_LIN  = 170 * MiB;
constexpr size_t WS_LW   = 178 * MiB;
constexpr size_t WS_AA   = 210 * MiB;
constexpr size_t WS_G    = 34 * MiB;
constexpr size_t WS_O01  = 66 * MiB;
constexpr size_t WS_Y    = 66 * MiB;
constexpr size_t WS_QM   = 98 * MiB;
constexpr size_t WS_MN   = 130 * MiB;
constexpr size_t WS_KVM  = 134 * MiB;
constexpr size_t WS_SC   = 142 * MiB;
constexpr size_t WS_P    = 206 * MiB;
constexpr size_t WS_OM   = 98 * MiB;
constexpr size_t WS_HID  = 98 * MiB;

struct Params {
    const float* x; const float* mem; const int* pos;
    const float *norm_mix_pre, *w_in, *conv_rwkv, *rwkv_w0, *rwkv_w2, *rwkv_a0, *rwkv_a2, *rwkv_g2, *rwkv_k_k, *rwkv_k_a, *rwkv_r_k,
                *rwkv_lnx_w, *rwkv_lnx_b, *mla_q_norm, *mla_w_uq, *mla_kv_norm, *mla_w_ukv, *w_out, *norm_mix_post, *norm_mem_pre,
                *norm_memtok, *mem_wq, *mem_wkv, *mem_wo, *norm_mem_post, *norm_mlp_pre, *mlp_w1, *mlp_w2, *norm_mlp_post;
    float* out; unsigned char* ws;
};

__device__ __forceinline__ float bf2f(bf16_t v) { return __uint_as_float((unsigned)v << 16); }
__device__ __forceinline__ bf16_t f2bf(float f) { unsigned u = __float_as_uint(f); return (bf16_t)((u + 0x7fffu + ((u >> 16) & 1u)) >> 16); }
__device__ __forceinline__ unsigned pk2(float lo, float hi) { return (unsigned)f2bf(lo) | ((unsigned)f2bf(hi) << 16); }
__device__ __forceinline__ float wave_sum(float v) {
#pragma unroll
    for (int o = 1; o < 64; o <<= 1) v += __shfl_xor(v, o);
    return v;
}
__device__ __forceinline__ float sigmoidf_(float x) { return 1.f / (1.f + __expf(-x)); }
__device__ __forceinline__ float rdlane(float v, int k) { return __uint_as_float((unsigned)__builtin_amdgcn_readlane((int)__float_as_uint(v), k)); }

namespace pg8 {
#define PG8_LAS __attribute__((address_space(3)))
typedef unsigned short bf16_t;
typedef short bf16x8 __attribute__((ext_vector_type(8)));
typedef float f32x4 __attribute__((ext_vector_type(4)));
typedef unsigned u32x4 __attribute__((ext_vector_type(4)));
constexpr int BM = 256, BK = 64, HALF = 128, HTB = HALF * BK * 2  , STAGE_BYTES = 8 * HTB, NXCD = 8, WGM = 8;

__host__ __device__ __forceinline__ int lds_byte(int r, int c) { const int st = (r >> 4) * 2 + (c >> 5), rr = r & 15, cc = c & 31, ob = rr * 64 + cc * 2; return st * 1024 + (ob ^ (((ob >> 9) & 1) << 5)); }
__host__ __device__ __forceinline__ void stage_rc(int b, int& R, int& C) { const int st = b / 1024, sb = b % 1024, swz = sb ^ (((sb >> 9) & 1) << 5); R = (st >> 1) * 16 + swz / 64; C = (st & 1) * 32 + (swz % 64) / 2; }
__host__ __device__ __forceinline__ int perm32(int rho) { const int n = rho >> 4, i = rho & 15; return 8 * (i >> 2) + 4 * n + (i & 3); }

struct Unit { int pm, pn, bi; };
struct Gemm { const bf16_t* A; const bf16_t* Bt; int lda, ldb, K; };

struct StaticOrder {
    int nM, nN, nwg, G, c;
    __host__ __device__ void init(int M, int N, int G_, int c_) { nM = M / BM; nN = N / BM; nwg = nM * nN; G = G_; c = c_; }
    __host__ __device__ bool next(int i, Unit& u) const {
        const long L = (long)i * G + c; if (L >= nwg) return false;
        int wgid = (int)L; { const int q = nwg / NXCD, r = nwg % NXCD, xcd = wgid % NXCD, off = wgid / NXCD; wgid = (xcd < r ? xcd * (q + 1) : r * (q + 1) + (xcd - r) * q) + off; }
        const int nig = WGM * nN, gid = wgid / nig, fm = gid * WGM, gsz = (nM - fm) < WGM ? (nM - fm) : WGM;
        u.pm = fm + ((wgid % nig) % gsz); u.pn = (wgid % nig) / gsz; u.bi = 0; return true;
    }
    __device__ __forceinline__ const char* a_ptr(const Gemm& g, const Unit& u) const { return (const char*)(g.A + (size_t)u.pm * BM * g.lda); }
    __device__ __forceinline__ const char* b_ptr(const Gemm& g, const Unit& u) const { return (const char*)(g.Bt + (size_t)u.pn * BM * g.ldb); }
    __device__ __forceinline__ void a_ready(const Unit&) const {}
    __device__ __forceinline__ void done(const Unit&) const {}
};

__device__ __forceinline__ unsigned cvt_pk_bf16(float lo, float hi) { unsigned r; asm volatile("v_cvt_pk_bf16_f32 %0, %1, %2" : "=v"(r) : "v"(lo), "v"(hi)); return r; }
typedef float f32x2 __attribute__((ext_vector_type(2)));


template <class P> struct EpiStore8 {
    static constexpr bool PERM = true, AFTER_DRAIN = false;
    P pol;
    __device__ __forceinline__ void operator()(const f32x4 (&acc)[2][2][4][2], const Unit& u, int wr, int wc, int fr, int fq) const {
        const int row0 = u.pm * BM + wr * 64 + fr, col0 = u.pn * BM + wc * 32 + 8 * fq;
#pragma unroll
        for (int ai = 0; ai < 2; ++ai)
#pragma unroll
            for (int m = 0; m < 4; ++m)
#pragma unroll
                for (int bj = 0; bj < 2; ++bj) pol.store8(u, row0 + ai * HALF + m * 16, col0 + bj * HALF, acc[ai][bj][m][0], acc[ai][bj][m][1]);
    }
};
__device__ __forceinline__ u32x4 pack8(const f32x4& v0, const f32x4& v1) { u32x4 w; w.x = cvt_pk_bf16(v0[0], v0[1]); w.y = cvt_pk_bf16(v0[2], v0[3]); w.z = cvt_pk_bf16(v1[0], v1[1]); w.w = cvt_pk_bf16(v1[2], v1[3]); return w; }
struct StBf16 { bf16_t* O; int ldc;
    __device__ __forceinline__ void store8(const Unit&, int row, int col, const f32x4& v0, const f32x4& v1) const { *(u32x4*)(O + (size_t)row * ldc + col) = pack8(v0, v1); } };
struct StRelu2 { bf16_t* O; int ldc;
    __device__ __forceinline__ void store8(const Unit&, int row, int col, f32x4 v0, f32x4 v1) const {
#pragma unroll
        for (int e = 0; e < 4; ++e) { const float a = fmaxf(v0[e], 0.f), b = fmaxf(v1[e], 0.f); v0[e] = a * a; v1[e] = b * b; }
        *(u32x4*)(O + (size_t)row * ldc + col) = pack8(v0, v1); } };
template <class Epi, class Sched, bool ALIGN_EPI = false, bool SP2 = false>
__device__ __forceinline__ void gemm_phase(PG8_LAS unsigned char* lds, const Gemm g, const Sched& S, const Epi& E) {
    const int tid = threadIdx.x, wid = __builtin_amdgcn_readfirstlane(tid >> 6), lane = tid & 63, wr = wid >> 2, wc = wid & 3, fr = lane & 15, fq = lane >> 4;
    const int K = g.K, nt = K / BK;
    unsigned voffA[2], voffB[2];
#pragma unroll
    for (int i = 0; i < 2; ++i) { int R, C; stage_rc(tid * 16 + i * 8192, R, C); const int Rb = Epi::PERM ? ((R & ~31) + perm32(R & 31)) : R;
        voffA[i] = (unsigned)(R * g.lda + C) * 2u; voffB[i] = (unsigned)(Rb * g.ldb + C) * 2u; }
    const size_t kstep = (size_t)(BK * 2);
    const size_t hstepA = (size_t)HALF * g.lda * 2, hstepB = (size_t)HALF * g.ldb * 2;
    const unsigned ldsw = (unsigned)wid * 1024u;
    const int aoff = lds_byte(wr * 64 + fr, fq * 8), boff = lds_byte(wc * 32 + fr, fq * 8);
#define PG8_SA(b, h) (((b) * 2 + (h)) * HTB)
#define PG8_SB(b, h) ((4 + (b) * 2 + (h)) * HTB)
#define PG8_STAGE(bufoff, gbase, voff) do { _Pragma("unroll") for (int _i = 0; _i < 2; ++_i) \
        __builtin_amdgcn_global_load_lds((const unsigned*)((const char*)(gbase) + (voff)[_i]), (PG8_LAS unsigned*)(lds + (bufoff) + ldsw + _i * 8192), 16, 0, 0); } while (0)
#define PG8_LDA(dst, b, h) do { _Pragma("unroll") for (int m = 0; m < 4; ++m) _Pragma("unroll") for (int k = 0; k < 2; ++k) dst[m][k] = *(const PG8_LAS bf16x8*)(lds + PG8_SA(b, h) + aoff + m * 2048 + k * 1024); } while (0)
#define PG8_LDB(dst, b, h) do { _Pragma("unroll") for (int n = 0; n < 2; ++n) _Pragma("unroll") for (int k = 0; k < 2; ++k) dst[n][k] = *(const PG8_LAS bf16x8*)(lds + PG8_SB(b, h) + boff + n * 2048 + k * 1024); } while (0)
#define PG8_MMA(ai, bj, At, Bt) do { __builtin_amdgcn_s_setprio(1); _Pragma("unroll") for (int m = 0; m < 4; ++m) _Pragma("unroll") for (int n = 0; n < 2; ++n) _Pragma("unroll") for (int k = 0; k < 2; ++k) \
        acc[ai][bj][m][n] = __builtin_amdgcn_mfma_f32_16x16x32_bf16(Bt[n][k], At[m][k], acc[ai][bj][m][n], 0, 0, 0); __builtin_amdgcn_s_setprio(0); } while (0)
#define PG8_WAIT_V(n) asm volatile("s_waitcnt vmcnt(" #n ")" ::: "memory")
#define PG8_WAIT_L(n) asm volatile("s_waitcnt lgkmcnt(" #n ")" ::: "memory")
#define PG8_BAR __builtin_amdgcn_s_barrier()
#define PG8_SCHED __builtin_amdgcn_sched_barrier(0)
    Unit cur, nxt; int ui = 0;
    if (!S.next(0, cur)) return;
    f32x4 acc[2][2][4][2];
#pragma unroll
    for (int a = 0; a < 2; ++a)
#pragma unroll
        for (int b = 0; b < 2; ++b)
#pragma unroll
            for (int m = 0; m < 4; ++m)
#pragma unroll
                for (int n = 0; n < 2; ++n) acc[a][b][m][n] = (f32x4){0.f, 0.f, 0.f, 0.f};
    bf16x8 At[4][2], B0[2][2], B1[2][2];
    const char* cA = S.a_ptr(g, cur); const char* cB = S.b_ptr(g, cur);
    S.a_ready(cur);
    if constexpr (SP2) {
        PG8_STAGE(PG8_SB(0, 0), cB, voffB); PG8_STAGE(PG8_SB(0, 1), cB + hstepB, voffB); PG8_STAGE(PG8_SA(0, 0), cA, voffA); PG8_STAGE(PG8_SA(0, 1), cA + hstepA, voffA);
        if (wr == 1) PG8_BAR;
        PG8_WAIT_V(2); PG8_BAR;
        PG8_STAGE(PG8_SB(1, 0), cB + kstep, voffB); PG8_STAGE(PG8_SA(1, 0), cA + kstep, voffA); PG8_STAGE(PG8_SB(1, 1), cB + hstepB + kstep, voffB);
        PG8_WAIT_V(6); PG8_BAR;
    } else {
        PG8_STAGE(PG8_SB(0, 0), cB, voffB); PG8_STAGE(PG8_SA(0, 0), cA, voffA); PG8_STAGE(PG8_SB(0, 1), cB + hstepB, voffB); PG8_STAGE(PG8_SA(0, 1), cA + hstepA, voffA);
        if (wr == 1) PG8_BAR;
        PG8_WAIT_V(4); PG8_BAR;
        PG8_STAGE(PG8_SB(1, 0), cB + kstep, voffB); PG8_STAGE(PG8_SA(1, 0), cA + kstep, voffA); PG8_STAGE(PG8_SB(1, 1), cB + hstepB + kstep, voffB);
        PG8_WAIT_V(6); PG8_BAR;
    }
    for (;;) {
        const bool has_next = S.next(ui + 1, nxt);
        const char* nA = has_next ? S.a_ptr(g, nxt) : cA; const char* nB = has_next ? S.b_ptr(g, nxt) : cB;
        for (int t = 0; t < nt; t += 2) {
            const bool last = (t == nt - 2);
            const char* a1 = cA + (size_t)(t + 1) * kstep;
            const char* a2 = last ? nA : cA + (size_t)(t + 2) * kstep; const char* b2 = last ? nB : cB + (size_t)(t + 2) * kstep;
            const char* a3 = a2 + kstep; const char* b3 = b2 + kstep;
            if (last && has_next) S.a_ready(nxt);
            if constexpr (SP2) {
            PG8_LDB(B0, 0, 0); PG8_LDB(B1, 0, 1); PG8_SCHED; PG8_LDA(At, 0, 0); PG8_STAGE(PG8_SA(1, 1), a1 + hstepA, voffA);
            PG8_WAIT_V(8); PG8_WAIT_L(0); PG8_BAR; PG8_MMA(0, 0, At, B0); PG8_MMA(0, 1, At, B1); PG8_BAR; PG8_SCHED;
            PG8_LDA(At, 0, 1); PG8_STAGE(PG8_SB(0, 0), b2, voffB); PG8_STAGE(PG8_SB(0, 1), b2 + hstepB, voffB); PG8_STAGE(PG8_SA(0, 0), a2, voffA);
            PG8_WAIT_V(8); PG8_WAIT_L(0); PG8_BAR; PG8_MMA(1, 0, At, B0); PG8_MMA(1, 1, At, B1); PG8_BAR; PG8_SCHED;
            PG8_LDB(B0, 1, 0); PG8_LDB(B1, 1, 1); PG8_SCHED; PG8_LDA(At, 1, 0); PG8_STAGE(PG8_SA(0, 1), a2 + hstepA, voffA);
            PG8_WAIT_V(8); PG8_WAIT_L(0); PG8_BAR; PG8_MMA(0, 0, At, B0); PG8_MMA(0, 1, At, B1); PG8_BAR; PG8_SCHED;
            PG8_LDA(At, 1, 1); PG8_STAGE(PG8_SB(1, 0), b3, voffB); PG8_STAGE(PG8_SB(1, 1), b3 + hstepB, voffB); PG8_STAGE(PG8_SA(1, 0), a3, voffA);
            PG8_WAIT_V(8); PG8_WAIT_L(0); PG8_BAR; PG8_MMA(1, 0, At, B0); PG8_MMA(1, 1, At, B1); PG8_BAR; PG8_SCHED;
            } else {
            PG8_LDB(B0, 0, 0); PG8_SCHED; PG8_LDA(At, 0, 0); PG8_STAGE(PG8_SA(1, 1), a1 + hstepA, voffA);
            PG8_WAIT_L(8); PG8_BAR; PG8_WAIT_L(0); PG8_MMA(0, 0, At, B0); PG8_BAR; PG8_SCHED;
            PG8_LDB(B1, 0, 1); PG8_STAGE(PG8_SB(0, 0), b2, voffB);
            PG8_BAR; PG8_WAIT_L(0); PG8_MMA(0, 1, At, B1); PG8_BAR;
            PG8_LDA(At, 0, 1); PG8_STAGE(PG8_SA(0, 0), a2, voffA);
            PG8_BAR; PG8_WAIT_L(0); PG8_MMA(1, 0, At, B0); PG8_BAR; PG8_SCHED;
            PG8_STAGE(PG8_SB(0, 1), b2 + hstepB, voffB);
            PG8_WAIT_V(6); PG8_BAR; PG8_MMA(1, 1, At, B1); PG8_BAR;
            PG8_LDB(B0, 1, 0); PG8_SCHED; PG8_LDA(At, 1, 0); PG8_STAGE(PG8_SA(0, 1), a2 + hstepA, voffA);
            PG8_WAIT_L(8); PG8_BAR; PG8_WAIT_L(0); PG8_MMA(0, 0, At, B0); PG8_BAR; PG8_SCHED;
            PG8_LDB(B1, 1, 1); PG8_STAGE(PG8_SB(1, 0), b3, voffB);
            PG8_BAR; PG8_WAIT_L(0); PG8_MMA(0, 1, At, B1); PG8_BAR;
            PG8_LDA(At, 1, 1); PG8_STAGE(PG8_SA(1, 0), a3, voffA);
            PG8_BAR; PG8_WAIT_L(0); PG8_MMA(1, 0, At, B0); PG8_BAR; PG8_SCHED;
            PG8_STAGE(PG8_SB(1, 1), b3 + hstepB, voffB);
            PG8_WAIT_V(6); PG8_BAR; PG8_MMA(1, 1, At, B1); PG8_BAR;
            }
        }
        if constexpr (ALIGN_EPI) { if (wr == 0) PG8_BAR; }
        if constexpr (!Epi::AFTER_DRAIN) { E(acc, cur, wr, wc, fr, fq); S.done(cur); }
        if (!has_next) break;
#pragma unroll
        for (int a = 0; a < 2; ++a)
#pragma unroll
            for (int b = 0; b < 2; ++b)
#pragma unroll
                for (int m = 0; m < 4; ++m)
#pragma unroll
                    for (int n = 0; n < 2; ++n) acc[a][b][m][n] = (f32x4){0.f, 0.f, 0.f, 0.f};
        cur = nxt; cA = nA; cB = nB; ++ui;
        if constexpr (ALIGN_EPI) { if (wr == 1) PG8_BAR; }
    }
    PG8_WAIT_V(0);
    if constexpr (!ALIGN_EPI) { if (wr == 0) PG8_BAR; }
    PG8_BAR;
    if constexpr (Epi::AFTER_DRAIN) { E.fused(acc, cur, wr, wc, fr, fq, lds, wid, lane); S.done(cur); }
#undef PG8_SA
#undef PG8_SB
#undef PG8_STAGE
#undef PG8_LDA
#undef PG8_LDB
#undef PG8_MMA
#undef PG8_WAIT_V
#undef PG8_WAIT_L
#undef PG8_BAR
#undef PG8_SCHED
}
}


struct GemmDesc {
    const bf16_t* A; int lda; long sAb, sAh;
    const void* B; int ldb; long sBb, sBh;
    int Mm, Nn, Kk, nbatch, nh;
};
template <int BMODE  , class EP>
__device__ void gemm_simple(const GemmDesc g, EP epi, unsigned char* smem, int bid, int nblk) {
    bf16_t* sA = (bf16_t*)smem;
    bf16_t* sB = sA + 128 * 40;
    const int tid = threadIdx.x, lane = tid & 63, wid = tid >> 6, wr = wid >> 2, wc = wid & 3, fr = lane & 15, fq = lane >> 4;
    const int tM = g.Mm / 128, tN = g.Nn / 128, ntile = tM * tN * g.nbatch;
    for (int t = bid; t < ntile; t += nblk) {
        const int bi = t / (tM * tN), tt = t % (tM * tN), tm = tt / tN, tn = tt % tN;
        const bf16_t* A = g.A + (long)(bi / g.nh) * g.sAb + (long)(bi % g.nh) * g.sAh + (long)tm * 128 * g.lda;
        const long boff = (long)(bi / g.nh) * g.sBb + (long)(bi % g.nh) * g.sBh;
        f32x4 acc[4][2];
#pragma unroll
        for (int i = 0; i < 4; ++i)
#pragma unroll
            for (int j = 0; j < 2; ++j) acc[i][j] = (f32x4){0.f, 0.f, 0.f, 0.f};
        for (int k0 = 0; k0 < g.Kk; k0 += 32) {
            __syncthreads();
            {
                const int r = tid >> 2, c = (tid & 3) * 8;
                const u32x4 v = *(const u32x4*)(A + (long)r * g.lda + k0 + c);
                *(u32x4*)(sA + r * 40 + c) = v;
            }
            if (BMODE == 2) {
                const bf16_t* B = (const bf16_t*)g.B + boff + (long)tn * 128 * g.ldb;
                const int r = tid >> 2, c = (tid & 3) * 8;
                const u32x4 v = *(const u32x4*)(B + (long)r * g.ldb + k0 + c);
                *(u32x4*)(sB + r * 40 + c) = v;
            } else if (BMODE == 0) {
                const float* B = (const float*)g.B + boff + (long)tn * 128;
                const int k = tid >> 4, n = (tid & 15) * 8;
                const f32x4 v0 = *(const f32x4*)(B + (long)(k0 + k) * g.ldb + n), v1 = *(const f32x4*)(B + (long)(k0 + k) * g.ldb + n + 4);
#pragma unroll
                for (int j = 0; j < 4; ++j) { sB[(n + j) * 40 + k] = f2bf(v0[j]); sB[(n + 4 + j) * 40 + k] = f2bf(v1[j]); }
            } else {
                const bf16_t* B = (const bf16_t*)g.B + boff + (long)tn * 128;
                const int k = tid >> 4, n = (tid & 15) * 8;
                const u32x4 v = *(const u32x4*)(B + (long)(k0 + k) * g.ldb + n);
                const bf16_t* e = (const bf16_t*)&v;
#pragma unroll
                for (int j = 0; j < 8; ++j) sB[(n + j) * 40 + k] = e[j];
            }
            __syncthreads();
            bf16x8 af[4], bfr[2];
#pragma unroll
            for (int i = 0; i < 4; ++i) af[i] = *(const bf16x8*)(sA + (wr * 64 + i * 16 + fr) * 40 + fq * 8);
#pragma unroll
            for (int j = 0; j < 2; ++j) bfr[j] = *(const bf16x8*)(sB + (wc * 32 + j * 16 + fr) * 40 + fq * 8);
#pragma unroll
            for (int i = 0; i < 4; ++i)
#pragma unroll
                for (int j = 0; j < 2; ++j) acc[i][j] = __builtin_amdgcn_mfma_f32_16x16x32_bf16(af[i], bfr[j], acc[i][j], 0, 0, 0);
        }
#pragma unroll
        for (int i = 0; i < 4; ++i)
#pragma unroll
            for (int j = 0; j < 2; ++j)
#pragma unroll
                for (int e = 0; e < 4; ++e) epi(bi, tm * 128 + wr * 64 + i * 16 + fq * 4 + e, tn * 128 + wc * 32 + j * 16 + fr, acc[i][j][e]);
    }
}

__device__ void norm_rows_bf16(const float* in, const float* gain, bf16_t* outb, int nrows, int gw, int ngw, int lane) {
    for (int r = gw; r < nrows; r += ngw) {
        const f32x4* xr = (const f32x4*)(in + (long)r * DM) + lane;
        f32x4 v[4]; float s = 0.f;
#pragma unroll
        for (int j = 0; j < 4; ++j) { v[j] = xr[64 * j]; s += v[j].x * v[j].x + v[j].y * v[j].y + v[j].z * v[j].z + v[j].w * v[j].w; }
        const float rstd = rsqrtf(wave_sum(s) * (1.f / DM) + NORM_EPS);
        unsigned long long* o8 = (unsigned long long*)(outb + (long)r * DM) + lane;
#pragma unroll
        for (int j = 0; j < 4; ++j) { const f32x4 gg = gain ? ((const f32x4*)gain)[lane + 64 * j] : (f32x4){1.f, 1.f, 1.f, 1.f};
            o8[64 * j] = (unsigned long long)pk2(v[j].x * rstd * gg.x, v[j].y * rstd * gg.y) | ((unsigned long long)pk2(v[j].z * rstd * gg.z, v[j].w * rstd * gg.w) << 32); }
    }
}
__device__ void resid_norm_rows(const float* base, const bf16_t* y, const float* g_post, float* xo, bf16_t* xn, int gw, int ngw, int lane) {
    for (int r = gw; r < M; r += ngw) {
        const unsigned long long* yr = (const unsigned long long*)(y + (long)r * DM) + lane; const f32x4* br = (const f32x4*)(base + (long)r * DM) + lane;
        f32x4 v[4], b[4]; float s = 0.f;
#pragma unroll
        for (int j = 0; j < 4; ++j) { const unsigned long long w = yr[64 * j]; const unsigned lo = (unsigned)w, hi = (unsigned)(w >> 32);
            v[j].x = __uint_as_float(lo << 16); v[j].y = __uint_as_float(lo & 0xffff0000u); v[j].z = __uint_as_float(hi << 16); v[j].w = __uint_as_float(hi & 0xffff0000u);
            b[j] = br[64 * j]; s += v[j].x * v[j].x + v[j].y * v[j].y + v[j].z * v[j].z + v[j].w * v[j].w; }
        const float rstd = rsqrtf(wave_sum(s) * (1.f / DM) + NORM_EPS);
        float s2 = 0.f;
#pragma unroll
        for (int j = 0; j < 4; ++j) { const f32x4 gg = ((const f32x4*)g_post)[lane + 64 * j];
            v[j].x = b[j].x + v[j].x * rstd * gg.x; v[j].y = b[j].y + v[j].y * rstd * gg.y; v[j].z = b[j].z + v[j].z * rstd * gg.z; v[j].w = b[j].w + v[j].w * rstd * gg.w;
            s2 += v[j].x * v[j].x + v[j].y * v[j].y + v[j].z * v[j].z + v[j].w * v[j].w; }
        f32x4* orow = (f32x4*)(xo + (long)r * DM) + lane;
#pragma unroll
        for (int j = 0; j < 4; ++j) orow[64 * j] = v[j];
        if (xn) {
            const float rstd2 = rsqrtf(wave_sum(s2) * (1.f / DM) + NORM_EPS);
            unsigned long long* o8 = (unsigned long long*)(xn + (long)r * DM) + lane;
#pragma unroll
            for (int j = 0; j < 4; ++j)
                o8[64 * j] = (unsigned long long)pk2(v[j].x * rstd2, v[j].y * rstd2) | ((unsigned long long)pk2(v[j].z * rstd2, v[j].w * rstd2) << 32);
        }
    }
}
__device__ __forceinline__ void transpose_item(const float* W, int N, const float* gain, bf16_t* WT, int ldk, float* scr, int item, int lane) {
    const int nblk = N / 32, kb = item / nblk, nb = item % nblk, k0 = 64 * kb, n0 = 32 * nb;
#pragma unroll 8
    for (int i = 0; i < 32; ++i) { const int kk = 2 * i + (lane >> 5); const float gg = gain ? gain[k0 + kk] : 1.f; scr[kk * 33 + (lane & 31)] = W[(size_t)(k0 + kk) * N + n0 + (lane & 31)] * gg; }
    asm volatile("s_waitcnt lgkmcnt(0)" ::: "memory");
    const int c = lane & 7;
#pragma unroll
    for (int j = 0; j < 4; ++j) { const int n = (lane >> 3) + 8 * j; const float* sp = scr + (8 * c) * 33 + n;
        u32x4 o; o.x = pk2(sp[0 * 33], sp[1 * 33]); o.y = pk2(sp[2 * 33], sp[3 * 33]); o.z = pk2(sp[4 * 33], sp[5 * 33]); o.w = pk2(sp[6 * 33], sp[7 * 33]);
        *(u32x4*)(WT + (size_t)(n0 + n) * ldk + k0 + 8 * c) = o; }
    asm volatile("s_waitcnt lgkmcnt(0)" ::: "memory");
}
struct TrJob { const float* W; int K, N; const float* gain; bf16_t* WT; int ldk; };
__device__ void prologue_weights(const Params& p, unsigned char* smem, int gw, int ngw, int wid, int lane) {
    unsigned char* ws = p.ws;
    float* scr = (float*)smem + wid * (64 * 33);
    const TrJob jobs[6] = {
        {p.w_in, DM, D_IN, p.norm_mix_pre, (bf16_t*)(ws + WS_WIN), DM},
        {p.w_out, DM, DM, nullptr, (bf16_t*)(ws + WS_WOUT), DM},
        {p.mem_wq, DM, DM, p.norm_mem_pre, (bf16_t*)(ws + WS_WQ), DM},
        {p.mem_wo, DM, DM, nullptr, (bf16_t*)(ws + WS_WO), DM},
        {p.mlp_w1, DM, DFF, p.norm_mlp_pre, (bf16_t*)(ws + WS_W1), DM},
        {p.mlp_w2, DFF, DM, nullptr, (bf16_t*)(ws + WS_W2), DFF}};
    int base = 0;
#pragma unroll
    for (int j = 0; j < 6; ++j) {
        const int items = (jobs[j].K / 64) * (jobs[j].N / 32);
        int first = gw - base; first = ((first % ngw) + ngw) % ngw;
        for (int it = first; it < items; it += ngw) transpose_item(jobs[j].W, jobs[j].N, jobs[j].gain, jobs[j].WT, jobs[j].ldk, scr, it, lane);
        base += items;
    }
    { u32x4* z = (u32x4*)((bf16_t*)(ws + WS_WIN) + (size_t)D_IN * DM); const int n16 = (ZLD - D_IN) * DM * 2 / 16;
      for (int i = gw * 64 + lane; i < n16; i += ngw * 64) z[i] = (u32x4){0u, 0u, 0u, 0u}; }
}

__device__ void mla_prep_rows(const Params& p, int gw, int ngw, int lane) {
    const bf16_t* Z = (const bf16_t*)(p.ws + WS_Z);
    bf16_t* CQ = (bf16_t*)(p.ws + WS_CQ); bf16_t* CKV = (bf16_t*)(p.ws + WS_CKV); float* KR = (float*)(p.ws + WS_KR);
    for (int r = gw; r < M; r += ngw) {
        const bf16_t* zr = Z + (long)r * ZLD;
        float q[4]; float s = 0.f;
#pragma unroll
        for (int j = 0; j < 4; ++j) { q[j] = bf2f(zr[ZC_CQ + 4 * lane + j]); s += q[j] * q[j]; }
        const float rq = rsqrtf(wave_sum(s) * (1.f / 256.f) + NORM_EPS);
#pragma unroll
        for (int j = 0; j < 4; ++j) CQ[(long)r * 256 + 4 * lane + j] = f2bf(q[j] * rq * p.mla_q_norm[4 * lane + j]);
        float c[2]; s = 0.f;
#pragma unroll
        for (int j = 0; j < 2; ++j) { c[j] = bf2f(zr[ZC_CKV + 2 * lane + j]); s += c[j] * c[j]; }
        const float rk = rsqrtf(wave_sum(s) * (1.f / 128.f) + NORM_EPS);
#pragma unroll
        for (int j = 0; j < 2; ++j) CKV[(long)r * 128 + 2 * lane + j] = f2bf(c[j] * rk * p.mla_kv_norm[2 * lane + j]);
        if (lane < 16) {
            const float x1 = bf2f(zr[ZC_KR + lane]), x2 = bf2f(zr[ZC_KR + 16 + lane]);
            const float inv_freq = powf(10000.f, -(float)(2 * lane) / 32.f);
            const float ang = (float)p.pos[r] * inv_freq; float sn, cs; sincosf(ang, &sn, &cs);
            KR[(long)r * 32 + lane] = x1 * cs - x2 * sn; KR[(long)r * 32 + 16 + lane] = x2 * cs + x1 * sn;
        }
    }
}

__device__ void rwkv_prep_rows(const Params& p, int gw, int ngw, int lane) {
    const bf16_t* Z = (const bf16_t*)(p.ws + WS_Z);
    bf16_t* RK = (bf16_t*)p.out;
    bf16_t* LIN = (bf16_t*)(p.ws + WS_LIN);
    for (int r = gw; r < M; r += ngw) {
        const int s = r % SEQ; const bool hp = s > 0, hn = s < SEQ - 1;
        const bf16_t* zc = Z + (long)r * ZLD;
        float val[3][8];
#pragma unroll
        for (int sec = 0; sec < 3; ++sec) {
            const int c0 = sec * 512 + 8 * lane;
#pragma unroll
            for (int j = 0; j < 8; ++j) {
                const int c = c0 + j;
                float a = p.conv_rwkv[RWKV_COLS + c] * bf2f(zc[c]);
                if (hp) a += p.conv_rwkv[c] * bf2f(zc[c - ZLD]);
                if (hn) a += p.conv_rwkv[2 * RWKV_COLS + c] * bf2f(zc[c + ZLD]);
                val[sec][j] = a;
            }
        }
        float kk[8]; float ss = 0.f;
#pragma unroll
        for (int j = 0; j < 8; ++j) { kk[j] = val[1][j] * p.rwkv_k_k[8 * lane + j]; ss += kk[j] * kk[j]; }
        ss += __shfl_xor(ss, 1); ss += __shfl_xor(ss, 2); ss += __shfl_xor(ss, 4);
        const float rn = rsqrtf(fmaxf(ss, 1e-24f));
#pragma unroll
        for (int j = 0; j < 8; ++j) {
            RK[(long)0 * M * RC + (long)r * RC + 8 * lane + j] = f2bf(val[0][j]);
            RK[(long)1 * M * RC + (long)r * RC + 8 * lane + j] = f2bf(val[1][j]);
            RK[(long)2 * M * RC + (long)r * RC + 8 * lane + j] = f2bf(val[2][j]);
            RK[(long)3 * M * RC + (long)r * RC + 8 * lane + j] = f2bf(kk[j] * rn);
        }
        if (lane < 56) {
#pragma unroll
            for (int j = 0; j < 4; ++j) {
                const int c = 1536 + 4 * lane + j;
                float a = p.conv_rwkv[RWKV_COLS + c] * bf2f(zc[c]);
                if (hp) a += p.conv_rwkv[c] * bf2f(zc[c - ZLD]);
                if (hn) a += p.conv_rwkv[2 * RWKV_COLS + c] * bf2f(zc[c + ZLD]);
                float o;
                if (c < ZC_XA) o = tanhf(a); else if (c < ZC_XG) o = a; else o = sigmoidf_(a);
                LIN[(long)r * 256 + 4 * lane + j] = f2bf(o);
            }
        } else {
#pragma unroll
            for (int j = 0; j < 4; ++j) LIN[(long)r * 256 + 4 * lane + j] = 0;
        }
    }
}

__device__ void rwkv_scan_naive(const Params& p, int chain, int lane) {
    const int d = chain / (BATCH * RH), b = (chain / RH) % BATCH, h = chain % RH;
    const bf16_t* RK = (const bf16_t*)p.out;
    const bf16_t* Rr = RK, *Kk = RK + (long)M * RC, *Vv = RK + 2L * M * RC, *KK = RK + 3L * M * RC;
    const bf16_t* LW = (const bf16_t*)(p.ws + WS_LW) + (long)d * M * RC;
    const bf16_t* AA = (const bf16_t*)(p.ws + WS_AA) + (long)d * M * RC;
    float* O = (float*)(p.ws + WS_O01) + (long)d * M * RC;
    const float ka = p.rwkv_k_a[h * RN + lane];
    float S[64];
#pragma unroll
    for (int k = 0; k < 64; ++k) S[k] = 0.f;
    for (int t = 0; t < SEQ; ++t) {
        const int s = d ? (SEQ - 1 - t) : t;
        const long off = ((long)(b * SEQ + s)) * RC + h * RN + lane;
        const float r_ = bf2f(Rr[off]), k_ = bf2f(Kk[off]), v_ = bf2f(Vv[off]), kk_ = bf2f(KK[off]);
        const float w_ = __expf(bf2f(LW[off])), a_ = bf2f(AA[off]);
        const float an = -kk_, bn = kk_ * a_, kn = k_ * (1.f + (a_ - 1.f) * ka);
        float sa = 0.f;
#pragma unroll
        for (int k = 0; k < 64; ++k) sa += S[k] * rdlane(an, k);
        float o = 0.f;
#pragma unroll
        for (int k = 0; k < 64; ++k) {
            S[k] = S[k] * rdlane(w_, k) + sa * rdlane(bn, k) + v_ * rdlane(kn, k);
            o += S[k] * rdlane(r_, k);
        }
        O[off] = o;
    }
}

__device__ void rwkv_combine_rows(const Params& p, int gw, int ngw, int lane) {
    const bf16_t* RK = (const bf16_t*)p.out;
    const bf16_t* Rr = RK, *Kk = RK + (long)M * RC, *Vv = RK + 2L * M * RC;
    const bf16_t* AA = (const bf16_t*)(p.ws + WS_AA); const bf16_t* G = (const bf16_t*)(p.ws + WS_G);
    const float* O = (const float*)(p.ws + WS_O01);
    bf16_t* YC = (bf16_t*)(p.ws + WS_YCAT);
    for (int r = gw; r < M; r += ngw) {
        const long off = (long)r * RC + 8 * lane;
        float o[8]; float s = 0.f;
#pragma unroll
        for (int j = 0; j < 8; ++j) { o[j] = O[off + j] + O[(long)M * RC + off + j]; s += o[j]; }
        s += __shfl_xor(s, 1); s += __shfl_xor(s, 2); s += __shfl_xor(s, 4);
        const float mu = s * (1.f / 64.f); float q = 0.f;
#pragma unroll
        for (int j = 0; j < 8; ++j) { o[j] -= mu; q += o[j] * o[j]; }
        q += __shfl_xor(q, 1); q += __shfl_xor(q, 2); q += __shfl_xor(q, 4);
        const float rstd = rsqrtf(q * (1.f / 64.f) + LNX_EPS);
        float bon = 0.f; float vv[8];
#pragma unroll
        for (int j = 0; j < 8; ++j) {
            const int c = 8 * lane + j;
            const float r_ = bf2f(Rr[off + j]), k_ = bf2f(Kk[off + j]); vv[j] = bf2f(Vv[off + j]);
            const float a0 = bf2f(AA[off + j]), a1 = bf2f(AA[(long)M * RC + off + j]); const float ka = p.rwkv_k_a[c];
            const float kd = k_ * (1.f + (a0 - 1.f) * ka) + k_ * (1.f + (a1 - 1.f) * ka);
            bon += r_ * kd * p.rwkv_r_k[c];
        }
        bon += __shfl_xor(bon, 1); bon += __shfl_xor(bon, 2); bon += __shfl_xor(bon, 4);
#pragma unroll
        for (int j = 0; j < 8; ++j) {
            const int c = 8 * lane + j;
            const float y = (o[j] * rstd * p.rwkv_lnx_w[c] + p.rwkv_lnx_b[c] + bon * vv[j]) * bf2f(G[off + j]);
            YC[(long)r * DM + c] = f2bf(y);
        }
    }
}

__device__ void mla_attn_naive(const Params& p, int unit  , int tid) {
    const int b = unit / 64, h = (unit / 8) % 8, q = (unit % 8) * 256 + tid;
    const bf16_t* Q = (const bf16_t*)(p.ws + WS_Q); const bf16_t* KV = (const bf16_t*)(p.ws + WS_KV); const float* KR = (const float*)(p.ws + WS_KR);
    bf16_t* YC = (bf16_t*)(p.ws + WS_YCAT);
    const long row = (long)b * SEQ + q;
    float qv[96];
#pragma unroll
    for (int j = 0; j < 96; ++j) qv[j] = bf2f(Q[row * 768 + h * 96 + j]);
    {
        const float pos = (float)p.pos[row];
#pragma unroll
        for (int i = 0; i < 16; ++i) {
            const float inv_freq = powf(10000.f, -(float)(2 * i) / 32.f); float sn, cs; sincosf(pos * inv_freq, &sn, &cs);
            const float x1 = qv[64 + i], x2 = qv[80 + i]; qv[64 + i] = x1 * cs - x2 * sn; qv[80 + i] = x2 * cs + x1 * sn;
        }
    }
    const float scale = 0.10206207261596575f;
#pragma unroll
    for (int j = 0; j < 96; ++j) qv[j] *= scale;
    float o[64]; float m = -1e30f, l = 0.f;
#pragma unroll
    for (int j = 0; j < 64; ++j) o[j] = 0.f;
    for (int kv = 0; kv < SEQ; ++kv) {
        const long krow = (long)b * SEQ + kv;
        const u32x4* kp = (const u32x4*)(KV + krow * 1024 + h * 128); const f32x4* kr = (const f32x4*)(KR + krow * 32);
        float s = 0.f;
#pragma unroll
        for (int j = 0; j < 8; ++j) { const u32x4 w = kp[j];
#pragma unroll
            for (int e = 0; e < 4; ++e) { s += qv[8 * j + 2 * e] * __uint_as_float(w[e] << 16); s += qv[8 * j + 2 * e + 1] * __uint_as_float(w[e] & 0xffff0000u); } }
#pragma unroll
        for (int j = 0; j < 8; ++j) { const f32x4 w = kr[j]; s += qv[64 + 4 * j] * w.x + qv[64 + 4 * j + 1] * w.y + qv[64 + 4 * j + 2] * w.z + qv[64 + 4 * j + 3] * w.w; }
        const float mn = fmaxf(m, s), f = __expf(m - mn), pe = __expf(s - mn);
        l = l * f + pe; m = mn;
#pragma unroll
        for (int j = 0; j < 8; ++j) { const u32x4 w = kp[8 + j];
#pragma unroll
            for (int e = 0; e < 4; ++e) { o[8 * j + 2 * e] = o[8 * j + 2 * e] * f + pe * __uint_as_float(w[e] << 16); o[8 * j + 2 * e + 1] = o[8 * j + 2 * e + 1] * f + pe * __uint_as_float(w[e] & 0xffff0000u); } }
    }
    const float il = 1.f / l;
#pragma unroll
    for (int j = 0; j < 64; ++j) YC[row * DM + 512 + h * 64 + j] = f2bf(o[j] * il);
}

__device__ void softmax_rows(const Params& p, int gw, int ngw, int lane) {
    const float* SC = (const float*)(p.ws + WS_SC); bf16_t* P = (bf16_t*)(p.ws + WS_P);
    for (int r = gw; r < 32 * SEQ; r += ngw) {
        const f32x4 v = ((const f32x4*)(SC + (long)r * 256))[lane];
        float mx = fmaxf(fmaxf(v.x, v.y), fmaxf(v.z, v.w));
#pragma unroll
        for (int o = 1; o < 64; o <<= 1) mx = fmaxf(mx, __shfl_xor(mx, o));
        const float e0 = __expf(v.x - mx), e1 = __expf(v.y - mx), e2 = __expf(v.z - mx), e3 = __expf(v.w - mx);
        const float inv = 1.f / wave_sum(e0 + e1 + e2 + e3);
        ((unsigned long long*)(P + (long)r * 256))[lane] = (unsigned long long)pk2(e0 * inv, e1 * inv) | ((unsigned long long)pk2(e2 * inv, e3 * inv) << 32);
    }
}

constexpr int NTHREADS = 512;
constexpr int LDS_BYTES = 147456;

template <class Pol>
__device__ __forceinline__ void big_gemm(unsigned char* smem, const bf16_t* A, int lda, const bf16_t* Bt, int ldb, int Mm, int Nn, int K, const Pol pol) {
    pg8::Gemm g{A, Bt, lda, ldb, K}; pg8::StaticOrder S; S.init(Mm, Nn, (int)gridDim.x, (int)blockIdx.x);
    pg8::EpiStore8<Pol> E{pol};
    pg8::gemm_phase<pg8::EpiStore8<Pol>, pg8::StaticOrder, true, true>((PG8_LAS unsigned char*)smem, g, S, E);
}

template <int PH>
__device__ __forceinline__ void run_phase(const Params& p, unsigned char* smem, int bid, int nblk) {
    const int tid = threadIdx.x, lane = tid & 63, wid = tid >> 6;
    const int gw = bid * (NTHREADS / 64) + wid, ngw = nblk * (NTHREADS / 64);
    unsigned char* ws = p.ws;
    if constexpr (PH == 0) {
        prologue_weights(p, smem, gw, ngw, wid, lane);
        norm_rows_bf16(p.x, nullptr, (bf16_t*)(ws + WS_XN), M, gw, ngw, lane);
    } else if constexpr (PH == 1) {
        big_gemm(smem, (const bf16_t*)(ws + WS_XN), DM, (const bf16_t*)(ws + WS_WIN), DM, M, ZLD, DM, pg8::StBf16{(bf16_t*)(ws + WS_Z), ZLD});
    } else if constexpr (PH == 2) {
        mla_prep_rows(p, gw, ngw, lane);
    } else if constexpr (PH == 3) {
        { GemmDesc g{(const bf16_t*)(ws + WS_CQ), 256, 0, 0, p.mla_w_uq, 768, 0, 0, M, 768, 256, 1, 1};
          bf16_t* Q = (bf16_t*)(ws + WS_Q);
          gemm_simple<0>(g, [=](int, int r, int c, float v) { Q[(long)r * 768 + c] = f2bf(v); }, smem, bid, nblk); }
        { GemmDesc g{(const bf16_t*)(ws + WS_CKV), 128, 0, 0, p.mla_w_ukv, 1024, 0, 0, M, 1024, 128, 1, 1};
          bf16_t* KV = (bf16_t*)(ws + WS_KV);
          gemm_simple<0>(g, [=](int, int r, int c, float v) { KV[(long)r * 1024 + c] = f2bf(v); }, smem, bid, nblk); }
    } else if constexpr (PH == 4) {
        for (int u = __builtin_amdgcn_readfirstlane(bid * 2 + (tid >> 8)); u < 512; u += nblk * 2) mla_attn_naive(p, u, tid & 255);
    } else if constexpr (PH == 5) {
        rwkv_prep_rows(p, gw, ngw, lane);
    } else if constexpr (PH == 6) {
        const bf16_t* LIN = (const bf16_t*)(ws + WS_LIN);
        for (int d = 0; d < 2; ++d) {
            { GemmDesc g{LIN + 32 * d, 256, 0, 0, p.rwkv_w2 + (long)d * 32 * RC, RC, 0, 0, M, RC, 32, 1, 1};
              bf16_t* LW = (bf16_t*)(ws + WS_LW) + (long)d * M * RC; const float* w0 = p.rwkv_w0 + d * RC;
              gemm_simple<0>(g, [=](int, int r, int c, float v) {
                  const float xx = -(w0[c] + v);
                  const float sp = fmaxf(xx, 0.f) + log1pf(__expf(-fabsf(xx)));
                  LW[(long)r * RC + c] = f2bf(-__expf(-sp - 0.5f)); }, smem, bid, nblk); }
            { GemmDesc g{LIN + 64 + 32 * d, 256, 0, 0, p.rwkv_a2 + (long)d * 32 * RC, RC, 0, 0, M, RC, 32, 1, 1};
              bf16_t* AA = (bf16_t*)(ws + WS_AA) + (long)d * M * RC; const float* a0 = p.rwkv_a0 + d * RC;
              gemm_simple<0>(g, [=](int, int r, int c, float v) { AA[(long)r * RC + c] = f2bf(sigmoidf_(a0[c] + v)); }, smem, bid, nblk); }
        }
        { GemmDesc g{LIN + 128, 256, 0, 0, p.rwkv_g2, RC, 0, 0, M, RC, 96, 1, 1};
          bf16_t* G = (bf16_t*)(ws + WS_G);
          gemm_simple<0>(g, [=](int, int r, int c, float v) { G[(long)r * RC + c] = f2bf(v); }, smem, bid, nblk); }
    } else if constexpr (PH == 7) {
        for (int c = gw; c < 2 * BATCH * RH; c += ngw) rwkv_scan_naive(p, c, lane);
    } else if constexpr (PH == 8) {
        rwkv_combine_rows(p, gw, ngw, lane);
    } else if constexpr (PH == 9) {
        big_gemm(smem, (const bf16_t*)(ws + WS_YCAT), DM, (const bf16_t*)(ws + WS_WOUT), DM, M, DM, DM, pg8::StBf16{(bf16_t*)(ws + WS_Y), DM});
    } else if constexpr (PH == 10) {
        resid_norm_rows(p.x, (const bf16_t*)(ws + WS_Y), p.norm_mix_post, p.out, (bf16_t*)(ws + WS_XN), gw, ngw, lane);
        norm_rows_bf16(p.mem, p.norm_memtok, (bf16_t*)(ws + WS_MN), BATCH * MEMT, gw, ngw, lane);
    } else if constexpr (PH == 11) {
        big_gemm(smem, (const bf16_t*)(ws + WS_XN), DM, (const bf16_t*)(ws + WS_WQ), DM, M, DM, DM, pg8::StBf16{(bf16_t*)(ws + WS_QM), DM});
        { GemmDesc g{(const bf16_t*)(ws + WS_MN), DM, 0, 0, p.mem_wkv, 2048, 0, 0, BATCH * MEMT, 2048, DM, 1, 1};
          bf16_t* KVM = (bf16_t*)(ws + WS_KVM);
          gemm_simple<0>(g, [=](int, int r, int c, float v) { KVM[(long)r * 2048 + c] = f2bf(v); }, smem, bid, nblk); }
    } else if constexpr (PH == 12) {
        GemmDesc g{(const bf16_t*)(ws + WS_QM), DM, (long)SEQ * DM, MEMD, (const bf16_t*)(ws + WS_KVM), 2048, (long)MEMT * 2048, MEMD, SEQ, MEMT, MEMD, BATCH * MEMH, MEMH};
        float* SC = (float*)(ws + WS_SC);
        gemm_simple<2>(g, [=](int bi, int r, int c, float v) { SC[((long)bi * SEQ + r) * MEMT + c] = v * 0.0625f; }, smem, bid, nblk);
    } else if constexpr (PH == 13) {
        softmax_rows(p, gw, ngw, lane);
    } else if constexpr (PH == 14) {
        GemmDesc g{(const bf16_t*)(ws + WS_P), MEMT, (long)MEMH * SEQ * MEMT, (long)SEQ * MEMT, (const bf16_t*)(ws + WS_KVM) + 1024, 2048, (long)MEMT * 2048, MEMD, SEQ, MEMD, MEMT, BATCH * MEMH, MEMH};
        bf16_t* OM = (bf16_t*)(ws + WS_OM);
        gemm_simple<1>(g, [=](int bi, int r, int c, float v) { OM[((long)(bi / MEMH) * SEQ + r) * DM + (bi % MEMH) * MEMD + c] = f2bf(v); }, smem, bid, nblk);
    } else if constexpr (PH == 15) {
        big_gemm(smem, (const bf16_t*)(ws + WS_OM), DM, (const bf16_t*)(ws + WS_WO), DM, M, DM, DM, pg8::StBf16{(bf16_t*)(ws + WS_Y), DM});
    } else if constexpr (PH == 16) {
        resid_norm_rows(p.out, (const bf16_t*)(ws + WS_Y), p.norm_mem_post, p.out, (bf16_t*)(ws + WS_XN), gw, ngw, lane);
    } else if constexpr (PH == 17) {
        big_gemm(smem, (const bf16_t*)(ws + WS_XN), DM, (const bf16_t*)(ws + WS_W1), DM, M, DFF, DM, pg8::StRelu2{(bf16_t*)(ws + WS_HID), DFF});
    } else if constexpr (PH == 18) {
        big_gemm(smem, (const bf16_t*)(ws + WS_HID), DFF, (const bf16_t*)(ws + WS_W2), DFF, M, DM, DFF, pg8::StBf16{(bf16_t*)(ws + WS_Y), DM});
    } else if constexpr (PH == 19) {
        resid_norm_rows(p.out, (const bf16_t*)(ws + WS_Y), p.norm_mlp_post, p.out, nullptr, gw, ngw, lane);
    }
}

template <int PH> __device__ __forceinline__ void run_all(const Params& p, unsigned char* smem, cg::grid_group& grid) {
    run_phase<PH>(p, smem, blockIdx.x, gridDim.x);
    if constexpr (PH + 1 < 20) { grid.sync(); run_all<PH + 1>(p, smem, grid); }
}
__global__ void __launch_bounds__(NTHREADS, 2) mega_kernel(Params p) {
    extern __shared__ __attribute__((aligned(16))) unsigned char smem[];
    cg::grid_group grid = cg::this_grid();
    run_all<0>(p, smem, grid);
}

extern "C" void kernel_launch(void* const* d_in, const int* in_sizes, int n_in, void* d_out, int out_size, void* d_ws, size_t ws_size, hipStream_t stream) {
    static int grid_blocks = 0;
    if (!grid_blocks) {
        int dev = 0, cus = 0, per_cu = 0;
        (void)hipFuncSetAttribute((const void*)mega_kernel, hipFuncAttributeMaxDynamicSharedMemorySize, LDS_BYTES);
        (void)hipGetDevice(&dev);
        (void)hipDeviceGetAttribute(&cus, hipDeviceAttributeMultiprocessorCount, dev);
        (void)hipOccupancyMaxActiveBlocksPerMultiprocessor(&per_cu, mega_kernel, NTHREADS, LDS_BYTES);
        if (per_cu < 1) per_cu = 1;
        grid_blocks = cus * per_cu;
        fprintf(stderr, "kernel_launch: cus=%d per_cu=%d grid=%d\n", cus, per_cu, grid_blocks);
    }
    Params p{};
    p.x = (const float*)d_in[0]; p.mem = (const float*)d_in[1]; p.pos = (const int*)d_in[2];
    const float** f = &p.norm_mix_pre;
    for (int i = 0; i < 29; ++i) f[i] = (const float*)d_in[3 + i];
    p.out = (float*)d_out; p.ws = (unsigned char*)d_ws;
    void* args[] = {&p};
    hipError_t e = hipLaunchCooperativeKernel((void*)mega_kernel, dim3(grid_blocks), dim3(NTHREADS), args, LDS_BYTES, stream);
    if (e != hipSuccess) fprintf(stderr, "cooperative launch failed: %s (grid %d)\n", hipGetErrorString(e), grid_blocks);
}
```

```cpp
#include <hip/hip_runtime.h>
#include <hip/hip_cooperative_groups.h>
namespace cg = cooperative_groups;
#include <cstdio>
#include <cstdint>

typedef unsigned short bf16_t;
typedef short bf16x8 __attribute__((ext_vector_type(8)));
typedef float f32x4 __attribute__((ext_vector_type(4)));
typedef unsigned u32x4 __attribute__((ext_vector_type(4)));

constexpr int BATCH = 8, SEQ = 2048, DM = 1024, M = BATCH * SEQ;
constexpr int RH = 8, RN = 64, RC = 512;
constexpr int RWKV_COLS = 1760, MLA_COLS = 416, D_IN = 2176;
constexpr int ZC_XW = 1536, ZC_XA = 1600, ZC_XG = 1664;
constexpr int ZC_CQ = 1760, ZC_CKV = 2016, ZC_KR = 2144;
constexpr int MH = 8, NOPE = 64, ROPE = 32, VD = 64, QKD = 96;
constexpr int MEMT = 256, MEMH = 4, MEMD = 256;
constexpr int DFF = 4096;
constexpr float NORM_EPS = 1e-6f, LNX_EPS = 64e-5f;

constexpr size_t MiB = 1u << 20;
constexpr int ZLD = 2304;
constexpr size_t WS_WIN  = 0;
constexpr size_t WS_WOUT = 5 * MiB;
constexpr size_t WS_WQ   = 7 * MiB;
constexpr size_t WS_WKV  = 9 * MiB;
constexpr size_t WS_WO   = 13 * MiB;
constexpr size_t WS_W1   = 15 * MiB;
constexpr size_t WS_W2   = 23 * MiB;
constexpr size_t WS_WUQ  = 31 * MiB;
constexpr size_t WS_WUKV = 31 * MiB + 512 * 1024;
constexpr size_t WS_WLG  = 32 * MiB;
constexpr size_t WS_XN   = 34 * MiB;
constexpr size_t WS_Z    = 66 * MiB;
constexpr size_t WS_YCAT = 138 * MiB;
constexpr size_t WS_CQ   = 170 * MiB;
constexpr size_t WS_CKV  = 178 * MiB;
constexpr size_t WS_KR   = 186 * MiB;
constexpr size_t WS_Q    = 188 * MiB;
constexpr size_t WS_KV   = 212 * MiB;
constexpr size_t WS_LIN  = 170 * MiB;
constexpr size_t WS_LW   = 178 * MiB;
constexpr size_t WS_AA   = 210 * MiB;
constexpr size_t WS_G    = 34 * MiB;
constexpr size_t WS_O01  = 66 * MiB;
constexpr size_t WS_Y    = 66 * MiB;
constexpr size_t WS_QM   = 98 * MiB;
constexpr size_t WS_MN   = 130 * MiB;
constexpr size_t WS_KVM  = 134 * MiB;
constexpr size_t WS_SC   = 142 * MiB;
constexpr size_t WS_P    = 206 * MiB;
constexpr size_t WS_OM   = 98 * MiB;
constexpr size_t WS_HID  = 98 * MiB;

struct Params {
    const float* x; const float* mem; const int* pos;
    const float *norm_mix_pre, *w_in, *conv_rwkv, *rwkv_w0, *rwkv_w2, *rwkv_a0, *rwkv_a2, *rwkv_g2, *rwkv_k_k, *rwkv_k_a, *rwkv_r_k,
                *rwkv_lnx_w, *rwkv_lnx_b, *mla_q_norm, *mla_w_uq, *mla_kv_norm, *mla_w_ukv, *w_out, *norm_mix_post, *norm_mem_pre,
                *norm_memtok, *mem_wq, *mem_wkv, *mem_wo, *norm_mem_post, *norm_mlp_pre, *mlp_w1, *mlp_w2, *norm_mlp_post;
    float* out; unsigned char* ws;
};

__device__ __forceinline__ float bf2f(bf16_t v) { return __uint_as_float((unsigned)v << 16); }
__device__ __forceinline__ bf16_t f2bf(float f) { unsigned u = __float_as_uint(f); return (bf16_t)((u + 0x7fffu + ((u >> 16) & 1u)) >> 16); }
__device__ __forceinline__ unsigned pk2(float lo, float hi) { return (unsigned)f2bf(lo) | ((unsigned)f2bf(hi) << 16); }
__device__ __forceinline__ float wave_sum(float v) {
#pragma unroll
    for (int o = 1; o < 64; o <<= 1) v += __shfl_xor(v, o);
    return v;
}
__device__ __forceinline__ float sigmoidf_(float x) { return 1.f / (1.f + __expf(-x)); }
__device__ __forceinline__ float rdlane(float v, int k) { return __uint_as_float((unsigned)__builtin_amdgcn_readlane((int)__float_as_uint(v), k)); }

namespace pg8 {
#define PG8_LAS __attribute__((address_space(3)))
typedef unsigned short bf16_t;
typedef short bf16x8 __attribute__((ext_vector_type(8)));
typedef float f32x4 __attribute__((ext_vector_type(4)));
typedef unsigned u32x4 __attribute__((ext_vector_type(4)));
constexpr int BM = 256, BK = 64, HALF = 128, HTB = HALF * BK * 2  , STAGE_BYTES = 8 * HTB, NXCD = 8, WGM = 8;

__host__ __device__ __forceinline__ int lds_byte(int r, int c) { const int st = (r >> 4) * 2 + (c >> 5), rr = r & 15, cc = c & 31, ob = rr * 64 + cc * 2; return st * 1024 + (ob ^ (((ob >> 9) & 1) << 5)); }
__host__ __device__ __forceinline__ void stage_rc(int b, int& R, int& C) { const int st = b / 1024, sb = b % 1024, swz = sb ^ (((sb >> 9) & 1) << 5); R = (st >> 1) * 16 + swz / 64; C = (st & 1) * 32 + (swz % 64) / 2; }
__host__ __device__ __forceinline__ int perm32(int rho) { const int n = rho >> 4, i = rho & 15; return 8 * (i >> 2) + 4 * n + (i & 3); }

struct Unit { int pm, pn, bi; };
struct Gemm { const bf16_t* A; const bf16_t* Bt; int lda, ldb, K; };

struct StaticOrder {
    int nM, nN, nwg, G, c;
    __host__ __device__ void init(int M, int N, int G_, int c_) { nM = M / BM; nN = N / BM; nwg = nM * nN; G = G_; c = c_; }
    __host__ __device__ bool next(int i, Unit& u) const {
        const long L = (long)i * G + c; if (L >= nwg) return false;
        int wgid = (int)L; { const int q = nwg / NXCD, r = nwg % NXCD, xcd = wgid % NXCD, off = wgid / NXCD; wgid = (xcd < r ? xcd * (q + 1) : r * (q + 1) + (xcd - r) * q) + off; }
        const int nig = WGM * nN, gid = wgid / nig, fm = gid * WGM, gsz = (nM - fm) < WGM ? (nM - fm) : WGM;
        u.pm = fm + ((wgid % nig) % gsz); u.pn = (wgid % nig) / gsz; u.bi = 0; return true;
    }
    __device__ __forceinline__ const char* a_ptr(const Gemm& g, const Unit& u) const { return (const char*)(g.A + (size_t)u.pm * BM * g.lda); }
    __device__ __forceinline__ const char* b_ptr(const Gemm& g, const Unit& u) const { return (const char*)(g.Bt + (size_t)u.pn * BM * g.ldb); }
    __device__ __forceinline__ void a_ready(const Unit&) const {}
    __device__ __forceinline__ void done(const Unit&) const {}
};

__device__ __forceinline__ unsigned cvt_pk_bf16(float lo, float hi) { unsigned r; asm volatile("v_cvt_pk_bf16_f32 %0, %1, %2" : "=v"(r) : "v"(lo), "v"(hi)); return r; }
typedef float f32x2 __attribute__((ext_vector_type(2)));


template <class P> struct EpiStore8 {
    static constexpr bool PERM = true, AFTER_DRAIN = false;
    P pol;
    __device__ __forceinline__ void operator()(const f32x4 (&acc)[2][2][4][2], const Unit& u, int wr, int wc, int fr, int fq) const {
        const int row0 = u.pm * BM + wr * 64 + fr, col0 = u.pn * BM + wc * 32 + 8 * fq;
#pragma unroll
        for (int ai = 0; ai < 2; ++ai)
#pragma unroll
            for (int m = 0; m < 4; ++m)
#pragma unroll
                for (int bj = 0; bj < 2; ++bj) pol.store8(u, row0 + ai * HALF + m * 16, col0 + bj * HALF, acc[ai][bj][m][0], acc[ai][bj][m][1]);
    }
};
__device__ __forceinline__ u32x4 pack8(const f32x4& v0, const f32x4& v1) { u32x4 w; w.x = cvt_pk_bf16(v0[0], v0[1]); w.y = cvt_pk_bf16(v0[2], v0[3]); w.z = cvt_pk_bf16(v1[0], v1[1]); w.w = cvt_pk_bf16(v1[2], v1[3]); return w; }
struct StBf16 { bf16_t* O; int ldc;
    __device__ __forceinline__ void store8(const Unit&, int row, int col, const f32x4& v0, const f32x4& v1) const { *(u32x4*)(O + (size_t)row * ldc + col) = pack8(v0, v1); } };
struct StRelu2 { bf16_t* O; int ldc;
    __device__ __forceinline__ void store8(const Unit&, int row, int col, f32x4 v0, f32x4 v1) const {
#pragma unroll
        for (int e = 0; e < 4; ++e) { const float a = fmaxf(v0[e], 0.f), b = fmaxf(v1[e], 0.f); v0[e] = a * a; v1[e] = b * b; }
        *(u32x4*)(O + (size_t)row * ldc + col) = pack8(v0, v1); } };
template <class Epi, class Sched, bool ALIGN_EPI = false, bool SP2 = false>
__device__ __forceinline__ void gemm_phase(PG8_LAS unsigned char* lds, const Gemm g, const Sched& S, const Epi& E) {
    const int tid = threadIdx.x, wid = __builtin_amdgcn_readfirstlane(tid >> 6), lane = tid & 63, wr = wid >> 2, wc = wid & 3, fr = lane & 15, fq = lane >> 4;
    const int K = g.K, nt = K / BK;
    unsigned voffA[2], voffB[2];
#pragma unroll
    for (int i = 0; i < 2; ++i) { int R, C; stage_rc(tid * 16 + i * 8192, R, C); const int Rb = Epi::PERM ? ((R & ~31) + perm32(R & 31)) : R;
        voffA[i] = (unsigned)(R * g.lda + C) * 2u; voffB[i] = (unsigned)(Rb * g.ldb + C) * 2u; }
    const size_t kstep = (size_t)(BK * 2);
    const size_t hstepA = (size_t)HALF * g.lda * 2, hstepB = (size_t)HALF * g.ldb * 2;
    const unsigned ldsw = (unsigned)wid * 1024u;
    const int aoff = lds_byte(wr * 64 + fr, fq * 8), boff = lds_byte(wc * 32 + fr, fq * 8);
#define PG8_SA(b, h) (((b) * 2 + (h)) * HTB)
#define PG8_SB(b, h) ((4 + (b) * 2 + (h)) * HTB)
#define PG8_STAGE(bufoff, gbase, voff) do { _Pragma("unroll") for (int _i = 0; _i < 2; ++_i) \
        __builtin_amdgcn_global_load_lds((const unsigned*)((const char*)(gbase) + (voff)[_i]), (PG8_LAS unsigned*)(lds + (bufoff) + ldsw + _i * 8192), 16, 0, 0); } while (0)
#define PG8_LDA(dst, b, h) do { _Pragma("unroll") for (int m = 0; m < 4; ++m) _Pragma("unroll") for (int k = 0; k < 2; ++k) dst[m][k] = *(const PG8_LAS bf16x8*)(lds + PG8_SA(b, h) + aoff + m * 2048 + k * 1024); } while (0)
#define PG8_LDB(dst, b, h) do { _Pragma("unroll") for (int n = 0; n < 2; ++n) _Pragma("unroll") for (int k = 0; k < 2; ++k) dst[n][k] = *(const PG8_LAS bf16x8*)(lds + PG8_SB(b, h) + boff + n * 2048 + k * 1024); } while (0)
#define PG8_MMA(ai, bj, At, Bt) do { __builtin_amdgcn_s_setprio(1); _Pragma("unroll") for (int m = 0; m < 4; ++m) _Pragma("unroll") for (int n = 0; n < 2; ++n) _Pragma("unroll") for (int k = 0; k < 2; ++k) \
        acc[ai][bj][m][n] = __builtin_amdgcn_mfma_f32_16x16x32_bf16(Bt[n][k], At[m][k], acc[ai][bj][m][n], 0, 0, 0); __builtin_amdgcn_s_setprio(0); } while (0)
#define PG8_WAIT_V(n) asm volatile("s_waitcnt vmcnt(" #n ")" ::: "memory")
#define PG8_WAIT_L(n) asm volatile("s_waitcnt lgkmcnt(" #n ")" ::: "memory")
#define PG8_BAR __builtin_amdgcn_s_barrier()
#define PG8_SCHED __builtin_amdgcn_sched_barrier(0)
    Unit cur, nxt; int ui = 0;
    if (!S.next(0, cur)) return;
    f32x4 acc[2][2][4][2];
#pragma unroll
    for (int a = 0; a < 2; ++a)
#pragma unroll
        for (int b = 0; b < 2; ++b)
#pragma unroll
            for (int m = 0; m < 4; ++m)
#pragma unroll
                for (int n = 0; n < 2; ++n) acc[a][b][m][n] = (f32x4){0.f, 0.f, 0.f, 0.f};
    bf16x8 At[4][2], B0[2][2], B1[2][2];
    const char* cA = S.a_ptr(g, cur); const char* cB = S.b_ptr(g, cur);
    S.a_ready(cur);
    if constexpr (SP2) {
        PG8_STAGE(PG8_SB(0, 0), cB, voffB); PG8_STAGE(PG8_SB(0, 1), cB + hstepB, voffB); PG8_STAGE(PG8_SA(0, 0), cA, voffA); PG8_STAGE(PG8_SA(0, 1), cA + hstepA, voffA);
        if (wr == 1) PG8_BAR;
        PG8_WAIT_V(2); PG8_BAR;
        PG8_STAGE(PG8_SB(1, 0), cB + kstep, voffB); PG8_STAGE(PG8_SA(1, 0), cA + kstep, voffA); PG8_STAGE(PG8_SB(1, 1), cB + hstepB + kstep, voffB);
        PG8_WAIT_V(6); PG8_BAR;
    } else {
        PG8_STAGE(PG8_SB(0, 0), cB, voffB); PG8_STAGE(PG8_SA(0, 0), cA, voffA); PG8_STAGE(PG8_SB(0, 1), cB + hstepB, voffB); PG8_STAGE(PG8_SA(0, 1), cA + hstepA, voffA);
        if (wr == 1) PG8_BAR;
        PG8_WAIT_V(4); PG8_BAR;
        PG8_STAGE(PG8_SB(1, 0), cB + kstep, voffB); PG8_STAGE(PG8_SA(1, 0), cA + kstep, voffA); PG8_STAGE(PG8_SB(1, 1), cB + hstepB + kstep, voffB);
        PG8_WAIT_V(6); PG8_BAR;
    }
    for (;;) {
        const bool has_next = S.next(ui + 1, nxt);
        const char* nA = has_next ? S.a_ptr(g, nxt) : cA; const char* nB = has_next ? S.b_ptr(g, nxt) : cB;
        for (int t = 0; t < nt; t += 2) {
            const bool last = (t == nt - 2);
            const char* a1 = cA + (size_t)(t + 1) * kstep;
            const char* a2 = last ? nA : cA + (size_t)(t + 2) * kstep; const char* b2 = last ? nB : cB + (size_t)(t + 2) * kstep;
            const char* a3 = a2 + kstep; const char* b3 = b2 + kstep;
            if (last && has_next) S.a_ready(nxt);
            if constexpr (SP2) {
            PG8_LDB(B0, 0, 0); PG8_LDB(B1, 0, 1); PG8_SCHED; PG8_LDA(At, 0, 0); PG8_STAGE(PG8_SA(1, 1), a1 + hstepA, voffA);
            PG8_WAIT_V(8); PG8_WAIT_L(0); PG8_BAR; PG8_MMA(0, 0, At, B0); PG8_MMA(0, 1, At, B1); PG8_BAR; PG8_SCHED;
            PG8_LDA(At, 0, 1); PG8_STAGE(PG8_SB(0, 0), b2, voffB); PG8_STAGE(PG8_SB(0, 1), b2 + hstepB, voffB); PG8_STAGE(PG8_SA(0, 0), a2, voffA);
            PG8_WAIT_V(8); PG8_WAIT_L(0); PG8_BAR; PG8_MMA(1, 0, At, B0); PG8_MMA(1, 1, At, B1); PG8_BAR; PG8_SCHED;
            PG8_LDB(B0, 1, 0); PG8_LDB(B1, 1, 1); PG8_SCHED; PG8_LDA(At, 1, 0); PG8_STAGE(PG8_SA(0, 1), a2 + hstepA, voffA);
            PG8_WAIT_V(8); PG8_WAIT_L(0); PG8_BAR; PG8_MMA(0, 0, At, B0); PG8_MMA(0, 1, At, B1); PG8_BAR; PG8_SCHED;
            PG8_LDA(At, 1, 1); PG8_STAGE(PG8_SB(1, 0), b3, voffB); PG8_STAGE(PG8_SB(1, 1), b3 + hstepB, voffB); PG8_STAGE(PG8_SA(1, 0), a3, voffA);
            PG8_WAIT_V(8); PG8_WAIT_L(0); PG8_BAR; PG8_MMA(1, 0, At, B0); PG8_MMA(1, 1, At, B1); PG8_BAR; PG8_SCHED;
            } else {
            PG8_LDB(B0, 0, 0); PG8_SCHED; PG8_LDA(At, 0, 0); PG8_STAGE(PG8_SA(1, 1), a1 + hstepA, voffA);
            PG8_WAIT_L(8); PG8_BAR; PG8_WAIT_L(0); PG8_MMA(0, 0, At, B0); PG8_BAR; PG8_SCHED;
            PG8_LDB(B1, 0, 1); PG8_STAGE(PG8_SB(0, 0), b2, voffB);
            PG8_BAR; PG8_WAIT_L(0); PG8_MMA(0, 1, At, B1); PG8_BAR;
            PG8_LDA(At, 0, 1); PG8_STAGE(PG8_SA(0, 0), a2, voffA);
            PG8_BAR; PG8_WAIT_L(0); PG8_MMA(1, 0, At, B0); PG8_BAR; PG8_SCHED;
            PG8_STAGE(PG8_SB(0, 1), b2 + hstepB, voffB);
            PG8_WAIT_V(6); PG8_BAR; PG8_MMA(1, 1, At, B1); PG8_BAR;
            PG8_LDB(B0, 1, 0); PG8_SCHED; PG8_LDA(At, 1, 0); PG8_STAGE(PG8_SA(0, 1), a2 + hstepA, voffA);
            PG8_WAIT_L(8); PG8_BAR; PG8_WAIT_L(0); PG8_MMA(0, 0, At, B0); PG8_BAR; PG8_SCHED;
            PG8_LDB(B1, 1, 1); PG8_STAGE(PG8_SB(1, 0), b3, voffB);
            PG8_BAR; PG8_WAIT_L(0); PG8_MMA(0, 1, At, B1); PG8_BAR;
            PG8_LDA(At, 1, 1); PG8_STAGE(PG8_SA(1, 0), a3, voffA);
            PG8_BAR; PG8_WAIT_L(0); PG8_MMA(1, 0, At, B0); PG8_BAR; PG8_SCHED;
            PG8_STAGE(PG8_SB(1, 1), b3 + hstepB, voffB);
            PG8_WAIT_V(6); PG8_BAR; PG8_MMA(1, 1, At, B1); PG8_BAR;
            }
        }
        if constexpr (ALIGN_EPI) { if (wr == 0) PG8_BAR; }
        if constexpr (!Epi::AFTER_DRAIN) { E(acc, cur, wr, wc, fr, fq); S.done(cur); }
        if (!has_next) break;
#pragma unroll
        for (int a = 0; a < 2; ++a)
#pragma unroll
            for (int b = 0; b < 2; ++b)
#pragma unroll
                for (int m = 0; m < 4; ++m)
#pragma unroll
                    for (int n = 0; n < 2; ++n) acc[a][b][m][n] = (f32x4){0.f, 0.f, 0.f, 0.f};
        cur = nxt; cA = nA; cB = nB; ++ui;
        if constexpr (ALIGN_EPI) { if (wr == 1) PG8_BAR; }
    }
    PG8_WAIT_V(0);
    if constexpr (!ALIGN_EPI) { if (wr == 0) PG8_BAR; }
    PG8_BAR;
    if constexpr (Epi::AFTER_DRAIN) { E.fused(acc, cur, wr, wc, fr, fq, lds, wid, lane); S.done(cur); }
#undef PG8_SA
#undef PG8_SB
#undef PG8_STAGE
#undef PG8_LDA
#undef PG8_LDB
#undef PG8_MMA
#undef PG8_WAIT_V
#undef PG8_WAIT_L
#undef PG8_BAR
#undef PG8_SCHED
}
}


struct GemmDesc {
    const bf16_t* A; int lda; long sAb, sAh;
    const void* B; int ldb; long sBb, sBh;
    int Mm, Nn, Kk, nbatch, nh;
};
template <int BMODE  , class EP>
__device__ void gemm_simple(const GemmDesc g, EP epi, unsigned char* smem, int bid, int nblk) {
    bf16_t* sA = (bf16_t*)smem;
    bf16_t* sB = sA + 128 * 40;
    const int tid = threadIdx.x, lane = tid & 63, wid = tid >> 6, wr = wid >> 2, wc = wid & 3, fr = lane & 15, fq = lane >> 4;
    const int tM = g.Mm / 128, tN = g.Nn / 128, ntile = tM * tN * g.nbatch;
    for (int t = bid; t < ntile; t += nblk) {
        const int bi = t / (tM * tN), tt = t % (tM * tN), tm = tt / tN, tn = tt % tN;
        const bf16_t* A = g.A + (long)(bi / g.nh) * g.sAb + (long)(bi % g.nh) * g.sAh + (long)tm * 128 * g.lda;
        const long boff = (long)(bi / g.nh) * g.sBb + (long)(bi % g.nh) * g.sBh;
        f32x4 acc[4][2];
#pragma unroll
        for (int i = 0; i < 4; ++i)
#pragma unroll
            for (int j = 0; j < 2; ++j) acc[i][j] = (f32x4){0.f, 0.f, 0.f, 0.f};
        for (int k0 = 0; k0 < g.Kk; k0 += 32) {
            __syncthreads();
            {
                const int r = tid >> 2, c = (tid & 3) * 8;
                const u32x4 v = *(const u32x4*)(A + (long)r * g.lda + k0 + c);
                *(u32x4*)(sA + r * 40 + c) = v;
            }
            if (BMODE == 2) {
                const bf16_t* B = (const bf16_t*)g.B + boff + (long)tn * 128 * g.ldb;
                const int r = tid >> 2, c = (tid & 3) * 8;
                const u32x4 v = *(const u32x4*)(B + (long)r * g.ldb + k0 + c);
                *(u32x4*)(sB + r * 40 + c) = v;
            } else if (BMODE == 0) {
                const float* B = (const float*)g.B + boff + (long)tn * 128;
                const int k = tid >> 4, n = (tid & 15) * 8;
                const f32x4 v0 = *(const f32x4*)(B + (long)(k0 + k) * g.ldb + n), v1 = *(const f32x4*)(B + (long)(k0 + k) * g.ldb + n + 4);
#pragma unroll
                for (int j = 0; j < 4; ++j) { sB[(n + j) * 40 + k] = f2bf(v0[j]); sB[(n + 4 + j) * 40 + k] = f2bf(v1[j]); }
            } else {
                const bf16_t* B = (const bf16_t*)g.B + boff + (long)tn * 128;
                const int k = tid >> 4, n = (tid & 15) * 8;
                const u32x4 v = *(const u32x4*)(B + (long)(k0 + k) * g.ldb + n);
                const bf16_t* e = (const bf16_t*)&v;
#pragma unroll
                for (int j = 0; j < 8; ++j) sB[(n + j) * 40 + k] = e[j];
            }
            __syncthreads();
            bf16x8 af[4], bfr[2];
#pragma unroll
            for (int i = 0; i < 4; ++i) af[i] = *(const bf16x8*)(sA + (wr * 64 + i * 16 + fr) * 40 + fq * 8);
#pragma unroll
            for (int j = 0; j < 2; ++j) bfr[j] = *(const bf16x8*)(sB + (wc * 32 + j * 16 + fr) * 40 + fq * 8);
#pragma unroll
            for (int i = 0; i < 4; ++i)
#pragma unroll
                for (int j = 0; j < 2; ++j) acc[i][j] = __builtin_amdgcn_mfma_f32_16x16x32_bf16(af[i], bfr[j], acc[i][j], 0, 0, 0);
        }
#pragma unroll
        for (int i = 0; i < 4; ++i)
#pragma unroll
            for (int j = 0; j < 2; ++j)
#pragma unroll
                for (int e = 0; e < 4; ++e) epi(bi, tm * 128 + wr * 64 + i * 16 + fq * 4 + e, tn * 128 + wc * 32 + j * 16 + fr, acc[i][j][e]);
    }
}

__device__ void norm_rows_bf16(const float* in, const float* gain, bf16_t* outb, int nrows, int gw, int ngw, int lane) {
    for (int r = gw; r < nrows; r += ngw) {
        const f32x4* xr = (const f32x4*)(in + (long)r * DM) + lane;
        f32x4 v[4]; float s = 0.f;
#pragma unroll
        for (int j = 0; j < 4; ++j) { v[j] = xr[64 * j]; s += v[j].x * v[j].x + v[j].y * v[j].y + v[j].z * v[j].z + v[j].w * v[j].w; }
        const float rstd = rsqrtf(wave_sum(s) * (1.f / DM) + NORM_EPS);
        unsigned long long* o8 = (unsigned long long*)(outb + (long)r * DM) + lane;
#pragma unroll
        for (int j = 0; j < 4; ++j) { const f32x4 gg = gain ? ((const f32x4*)gain)[lane + 64 * j] : (f32x4){1.f, 1.f, 1.f, 1.f};
            o8[64 * j] = (unsigned long long)pk2(v[j].x * rstd * gg.x, v[j].y * rstd * gg.y) | ((unsigned long long)pk2(v[j].z * rstd * gg.z, v[j].w * rstd * gg.w) << 32); }
    }
}
__device__ void resid_norm_rows(const float* base, const bf16_t* y, const float* g_post, float* xo, bf16_t* xn, int gw, int ngw, int lane) {
    for (int r = gw; r < M; r += ngw) {
        const unsigned long long* yr = (const unsigned long long*)(y + (long)r * DM) + lane; const f32x4* br = (const f32x4*)(base + (long)r * DM) + lane;
        f32x4 v[4], b[4]; float s = 0.f;
#pragma unroll
        for (int j = 0; j < 4; ++j) { const unsigned long long w = yr[64 * j]; const unsigned lo = (unsigned)w, hi = (unsigned)(w >> 32);
            v[j].x = __uint_as_float(lo << 16); v[j].y = __uint_as_float(lo & 0xffff0000u); v[j].z = __uint_as_float(hi << 16); v[j].w = __uint_as_float(hi & 0xffff0000u);
            b[j] = br[64 * j]; s += v[j].x * v[j].x + v[j].y * v[j].y + v[j].z * v[j].z + v[j].w * v[j].w; }
        const float rstd = rsqrtf(wave_sum(s) * (1.f / DM) + NORM_EPS);
        float s2 = 0.f;
#pragma unroll
        for (int j = 0; j < 4; ++j) { const f32x4 gg = ((const f32x4*)g_post)[lane + 64 * j];
            v[j].x = b[j].x + v[j].x * rstd * gg.x; v[j].y = b[j].y + v[j].y * rstd * gg.y; v[j].z = b[j].z + v[j].z * rstd * gg.z; v[j].w = b[j].w + v[j].w * rstd * gg.w;
            s2 += v[j].x * v[j].x + v[j].y * v[j].y + v[j].z * v[j].z + v[j].w * v[j].w; }
        f32x4* orow = (f32x4*)(xo + (long)r * DM) + lane;
#pragma unroll
        for (int j = 0; j < 4; ++j) orow[64 * j] = v[j];
        if (xn) {
            const float rstd2 = rsqrtf(wave_sum(s2) * (1.f / DM) + NORM_EPS);
            unsigned long long* o8 = (unsigned long long*)(xn + (long)r * DM) + lane;
#pragma unroll
            for (int j = 0; j < 4; ++j)
                o8[64 * j] = (unsigned long long)pk2(v[j].x * rstd2, v[j].y * rstd2) | ((unsigned long long)pk2(v[j].z * rstd2, v[j].w * rstd2) << 32);
        }
    }
}
__device__ __forceinline__ void transpose_item(const float* W, int N, const float* gain, bf16_t* WT, int ldk, float* scr, int item, int lane) {
    const int nblk = N / 32, kb = item / nblk, nb = item % nblk, k0 = 64 * kb, n0 = 32 * nb;
#pragma unroll 8
    for (int i = 0; i < 32; ++i) { const int kk = 2 * i + (lane >> 5); const float gg = gain ? gain[k0 + kk] : 1.f; scr[kk * 33 + (lane & 31)] = W[(size_t)(k0 + kk) * N + n0 + (lane & 31)] * gg; }
    asm volatile("s_waitcnt lgkmcnt(0)" ::: "memory");
    const int c = lane & 7;
#pragma unroll
    for (int j = 0; j < 4; ++j) { const int n = (lane >> 3) + 8 * j; const float* sp = scr + (8 * c) * 33 + n;
        u32x4 o; o.x = pk2(sp[0 * 33], sp[1 * 33]); o.y = pk2(sp[2 * 33], sp[3 * 33]); o.z = pk2(sp[4 * 33], sp[5 * 33]); o.w = pk2(sp[6 * 33], sp[7 * 33]);
        *(u32x4*)(WT + (size_t)(n0 + n) * ldk + k0 + 8 * c) = o; }
    asm volatile("s_waitcnt lgkmcnt(0)" ::: "memory");
}
struct TrJob { const float* W; int K, N; const float* gain; bf16_t* WT; int ldk; };
__device__ void prologue_weights(const Params& p, unsigned char* smem, int gw, int ngw, int wid, int lane) {
    unsigned char* ws = p.ws;
    float* scr = (float*)smem + wid * (64 * 33);
    const TrJob jobs[6] = {
        {p.w_in, DM, D_IN, p.norm_mix_pre, (bf16_t*)(ws + WS_WIN), DM},
        {p.w_out, DM, DM, nullptr, (bf16_t*)(ws + WS_WOUT), DM},
        {p.mem_wq, DM, DM, p.norm_mem_pre, (bf16_t*)(ws + WS_WQ), DM},
        {p.mem_wo, DM, DM, nullptr, (bf16_t*)(ws + WS_WO), DM},
        {p.mlp_w1, DM, DFF, p.norm_mlp_pre, (bf16_t*)(ws + WS_W1), DM},
        {p.mlp_w2, DFF, DM, nullptr, (bf16_t*)(ws + WS_W2), DFF}};
    int base = 0;
#pragma unroll
    for (int j = 0; j < 6; ++j) {
        const int items = (jobs[j].K / 64) * (jobs[j].N / 32);
        int first = gw - base; first = ((first % ngw) + ngw) % ngw;
        for (int it = first; it < items; it += ngw) transpose_item(jobs[j].W, jobs[j].N, jobs[j].gain, jobs[j].WT, jobs[j].ldk, scr, it, lane);
        base += items;
    }
    { u32x4* z = (u32x4*)((bf16_t*)(ws + WS_WIN) + (size_t)D_IN * DM); const int n16 = (ZLD - D_IN) * DM * 2 / 16;
      for (int i = gw * 64 + lane; i < n16; i += ngw * 64) z[i] = (u32x4){0u, 0u, 0u, 0u}; }
}

__device__ void mla_prep_rows(const Params& p, int gw, int ngw, int lane) {
    const bf16_t* Z = (const bf16_t*)(p.ws + WS_Z);
    bf16_t* CQ = (bf16_t*)(p.ws + WS_CQ); bf16_t* CKV = (bf16_t*)(p.ws + WS_CKV); bf16_t* KR = (bf16_t*)(p.ws + WS_KR);
    for (int r = gw; r < M; r += ngw) {
        const bf16_t* zr = Z + (long)r * ZLD;
        float q[4]; float s = 0.f;
#pragma unroll
        for (int j = 0; j < 4; ++j) { q[j] = bf2f(zr[ZC_CQ + 4 * lane + j]); s += q[j] * q[j]; }
        const float rq = rsqrtf(wave_sum(s) * (1.f / 256.f) + NORM_EPS);
#pragma unroll
        for (int j = 0; j < 4; ++j) CQ[(long)r * 256 + 4 * lane + j] = f2bf(q[j] * rq * p.mla_q_norm[4 * lane + j]);
        float c[2]; s = 0.f;
#pragma unroll
        for (int j = 0; j < 2; ++j) { c[j] = bf2f(zr[ZC_CKV + 2 * lane + j]); s += c[j] * c[j]; }
        const float rk = rsqrtf(wave_sum(s) * (1.f / 128.f) + NORM_EPS);
#pragma unroll
        for (int j = 0; j < 2; ++j) CKV[(long)r * 128 + 2 * lane + j] = f2bf(c[j] * rk * p.mla_kv_norm[2 * lane + j]);
        if (lane < 16) {
            const float x1 = bf2f(zr[ZC_KR + lane]), x2 = bf2f(zr[ZC_KR + 16 + lane]);
            const float inv_freq = powf(10000.f, -(float)(2 * lane) / 32.f);
            const float ang = (float)p.pos[r] * inv_freq; float sn, cs; sincosf(ang, &sn, &cs);
            KR[(long)r * 32 + lane] = f2bf(x1 * cs - x2 * sn); KR[(long)r * 32 + 16 + lane] = f2bf(x2 * cs + x1 * sn);
        }
    }
}

__device__ void rwkv_prep_rows(const Params& p, int gw, int ngw, int lane) {
    const bf16_t* Z = (const bf16_t*)(p.ws + WS_Z);
    bf16_t* RK = (bf16_t*)p.out;
    bf16_t* LIN = (bf16_t*)(p.ws + WS_LIN);
    for (int r = gw; r < M; r += ngw) {
        const int s = r % SEQ; const bool hp = s > 0, hn = s < SEQ - 1;
        const bf16_t* zc = Z + (long)r * ZLD;
        float val[3][8];
#pragma unroll
        for (int sec = 0; sec < 3; ++sec) {
            const int c0 = sec * 512 + 8 * lane;
#pragma unroll
            for (int j = 0; j < 8; ++j) {
                const int c = c0 + j;
                float a = p.conv_rwkv[RWKV_COLS + c] * bf2f(zc[c]);
                if (hp) a += p.conv_rwkv[c] * bf2f(zc[c - ZLD]);
                if (hn) a += p.conv_rwkv[2 * RWKV_COLS + c] * bf2f(zc[c + ZLD]);
                val[sec][j] = a;
            }
        }
        float kk[8]; float ss = 0.f;
#pragma unroll
        for (int j = 0; j < 8; ++j) { kk[j] = val[1][j] * p.rwkv_k_k[8 * lane + j]; ss += kk[j] * kk[j]; }
        ss += __shfl_xor(ss, 1); ss += __shfl_xor(ss, 2); ss += __shfl_xor(ss, 4);
        const float rn = rsqrtf(fmaxf(ss, 1e-24f));
#pragma unroll
        for (int j = 0; j < 8; ++j) {
            RK[(long)0 * M * RC + (long)r * RC + 8 * lane + j] = f2bf(val[0][j]);
            RK[(long)1 * M * RC + (long)r * RC + 8 * lane + j] = f2bf(val[1][j]);
            RK[(long)2 * M * RC + (long)r * RC + 8 * lane + j] = f2bf(val[2][j]);
            RK[(long)3 * M * RC + (long)r * RC + 8 * lane + j] = f2bf(kk[j] * rn);
        }
        if (lane < 56) {
#pragma unroll
            for (int j = 0; j < 4; ++j) {
                const int c = 1536 + 4 * lane + j;
                float a = p.conv_rwkv[RWKV_COLS + c] * bf2f(zc[c]);
                if (hp) a += p.conv_rwkv[c] * bf2f(zc[c - ZLD]);
                if (hn) a += p.conv_rwkv[2 * RWKV_COLS + c] * bf2f(zc[c + ZLD]);
                float o;
                if (c < ZC_XA) o = tanhf(a); else if (c < ZC_XG) o = a; else o = sigmoidf_(a);
                LIN[(long)r * 256 + 4 * lane + j] = f2bf(o);
            }
        } else {
#pragma unroll
            for (int j = 0; j < 4; ++j) LIN[(long)r * 256 + 4 * lane + j] = 0;
        }
    }
}

__device__ void rwkv_scan_naive(const Params& p, int chain, int lane) {
    const int d = chain / (BATCH * RH), b = (chain / RH) % BATCH, h = chain % RH;
    const bf16_t* RK = (const bf16_t*)p.out;
    const bf16_t* Rr = RK, *Kk = RK + (long)M * RC, *Vv = RK + 2L * M * RC, *KK = RK + 3L * M * RC;
    const bf16_t* LW = (const bf16_t*)(p.ws + WS_LW) + (long)d * M * RC;
    const bf16_t* AA = (const bf16_t*)(p.ws + WS_AA) + (long)d * M * RC;
    float* O = (float*)(p.ws + WS_O01) + (long)d * M * RC;
    const float ka = p.rwkv_k_a[h * RN + lane];
    float S[64];
#pragma unroll
    for (int k = 0; k < 64; ++k) S[k] = 0.f;
    for (int t = 0; t < SEQ; ++t) {
        const int s = d ? (SEQ - 1 - t) : t;
        const long off = ((long)(b * SEQ + s)) * RC + h * RN + lane;
        const float r_ = bf2f(Rr[off]), k_ = bf2f(Kk[off]), v_ = bf2f(Vv[off]), kk_ = bf2f(KK[off]);
        const float w_ = __expf(bf2f(LW[off])), a_ = bf2f(AA[off]);
        const float an = -kk_, bn = kk_ * a_, kn = k_ * (1.f + (a_ - 1.f) * ka);
        float sa = 0.f;
#pragma unroll
        for (int k = 0; k < 64; ++k) sa += S[k] * rdlane(an, k);
        float o = 0.f;
#pragma unroll
        for (int k = 0; k < 64; ++k) {
            S[k] = S[k] * rdlane(w_, k) + sa * rdlane(bn, k) + v_ * rdlane(kn, k);
            o += S[k] * rdlane(r_, k);
        }
        O[off] = o;
    }
}

__device__ void rwkv_combine_rows(const Params& p, int gw, int ngw, int lane) {
    const bf16_t* RK = (const bf16_t*)p.out;
    const bf16_t* Rr = RK, *Kk = RK + (long)M * RC, *Vv = RK + 2L * M * RC;
    const bf16_t* AA = (const bf16_t*)(p.ws + WS_AA); const bf16_t* G = (const bf16_t*)(p.ws + WS_G);
    const float* O = (const float*)(p.ws + WS_O01);
    bf16_t* YC = (bf16_t*)(p.ws + WS_YCAT);
    for (int r = gw; r < M; r += ngw) {
        const long off = (long)r * RC + 8 * lane;
        float o[8]; float s = 0.f;
#pragma unroll
        for (int j = 0; j < 8; ++j) { o[j] = O[off + j] + O[(long)M * RC + off + j]; s += o[j]; }
        s += __shfl_xor(s, 1); s += __shfl_xor(s, 2); s += __shfl_xor(s, 4);
        const float mu = s * (1.f / 64.f); float q = 0.f;
#pragma unroll
        for (int j = 0; j < 8; ++j) { o[j] -= mu; q += o[j] * o[j]; }
        q += __shfl_xor(q, 1); q += __shfl_xor(q, 2); q += __shfl_xor(q, 4);
        const float rstd = rsqrtf(q * (1.f / 64.f) + LNX_EPS);
        float bon = 0.f; float vv[8];
#pragma unroll
        for (int j = 0; j < 8; ++j) {
            const int c = 8 * lane + j;
            const float r_ = bf2f(Rr[off + j]), k_ = bf2f(Kk[off + j]); vv[j] = bf2f(Vv[off + j]);
            const float a0 = bf2f(AA[off + j]), a1 = bf2f(AA[(long)M * RC + off + j]); const float ka = p.rwkv_k_a[c];
            const float kd = k_ * (1.f + (a0 - 1.f) * ka) + k_ * (1.f + (a1 - 1.f) * ka);
            bon += r_ * kd * p.rwkv_r_k[c];
        }
        bon += __shfl_xor(bon, 1); bon += __shfl_xor(bon, 2); bon += __shfl_xor(bon, 4);
#pragma unroll
        for (int j = 0; j < 8; ++j) {
            const int c = 8 * lane + j;
            const float y = (o[j] * rstd * p.rwkv_lnx_w[c] + p.rwkv_lnx_b[c] + bon * vv[j]) * bf2f(G[off + j]);
            YC[(long)r * DM + c] = f2bf(y);
        }
    }
}

typedef float f32x16 __attribute__((ext_vector_type(16)));
typedef short v4i16_t __attribute__((ext_vector_type(4)));
#define LDSAS __attribute__((address_space(3)))
constexpr int ATT_KROW = 208;
constexpr int ATT_KBUF = 64 * ATT_KROW;
constexpr int ATT_VBUF = 8192;
constexpr int ATT_V0 = 2 * ATT_KBUF;
__device__ __forceinline__ unsigned cvtpk(float lo, float hi) { unsigned r; asm volatile("v_cvt_pk_bf16_f32 %0, %1, %2" : "=v"(r) : "v"(lo), "v"(hi)); return r; }
__device__ __forceinline__ void mla_attn_unit(const Params& p, unsigned char* smem, int unit) {
    const int tid = threadIdx.x, lane = tid & 63, wid = tid >> 6, r32 = lane & 31, hi = lane >> 5;
    const int b = unit / 64, hd = (unit / 8) % 8, qb = unit % 8;
    const bf16_t* Q = (const bf16_t*)(p.ws + WS_Q); const bf16_t* KV = (const bf16_t*)(p.ws + WS_KV); const bf16_t* KR = (const bf16_t*)(p.ws + WS_KR);
    bf16_t* YC = (bf16_t*)(p.ws + WS_YCAT);
    const long rowbase = (long)b * SEQ;
    const long qrow = rowbase + qb * 256 + wid * 32 + r32;
    bf16x8 qf[6];
    {
        float qv[6][8];
#pragma unroll
        for (int s6 = 0; s6 < 6; ++s6) { const u32x4 w = *(const u32x4*)(Q + qrow * 768 + hd * 96 + 16 * s6 + 8 * hi);
#pragma unroll
            for (int e = 0; e < 4; ++e) { qv[s6][2 * e] = __uint_as_float(w[e] << 16); qv[s6][2 * e + 1] = __uint_as_float(w[e] & 0xffff0000u); } }
        const float pos = (float)p.pos[qrow];
#pragma unroll
        for (int j = 0; j < 8; ++j) { const int i = 8 * hi + j; const float inv_freq = powf(10000.f, -(float)(2 * i) / 32.f); float sn, cs; sincosf(pos * inv_freq, &sn, &cs);
            const float x1 = qv[4][j], x2 = qv[5][j]; qv[4][j] = x1 * cs - x2 * sn; qv[5][j] = x2 * cs + x1 * sn; }
        const float sc = 0.10206207261596575f * 1.4426950408889634f;
#pragma unroll
        for (int s6 = 0; s6 < 6; ++s6) { u32x4 w;
#pragma unroll
            for (int e = 0; e < 4; ++e) w[e] = cvtpk(qv[s6][2 * e] * sc, qv[s6][2 * e + 1] * sc);
            qf[s6] = __builtin_bit_cast(bf16x8, w); }
    }
    const int srow = tid >> 3, sc8 = tid & 7;
    const int rrow = (tid & 255) >> 2, rc4 = tid & 3;
    const bf16_t* gK = KV + (rowbase + srow) * 1024 + hd * 128 + sc8 * 8;
    const bf16_t* gV = gK + 64;
    const bf16_t* gR = KR + (rowbase + rrow) * 32 + rc4 * 8;
    const int dK = srow * ATT_KROW + sc8 * 16;
    const int dV = (sc8 >> 2) * 4096 + (srow >> 3) * 512 + (srow & 7) * 64 + (sc8 & 3) * 16;
    const int dR = rrow * ATT_KROW + 128 + rc4 * 16;
    u32x4 stK, stV, stR;
    stK = *(const u32x4*)gK; stV = *(const u32x4*)gV; if (tid < 256) stR = *(const u32x4*)gR;
    __syncthreads();
    *(u32x4*)(smem + dK) = stK; *(u32x4*)(smem + ATT_V0 + dV) = stV; if (tid < 256) *(u32x4*)(smem + dR) = stR;
    __syncthreads();
    const int kbase = r32 * ATT_KROW + hi * 16;
    const int vbase = ATT_V0 + ((lane >> 4) & 1) * 32 + (lane & 3) * 8 + (4 * hi + ((lane & 15) >> 2)) * 64;
    f32x16 ot[2]; ot[0] = f32x16{}; ot[1] = f32x16{};
    float m = -1e30f, l = 0.f;
    constexpr int NT = SEQ / 64;
    for (int j = 0; j < NT; ++j) {
        const int cur = j & 1;
        if (j + 1 < NT) { const long o = (long)(j + 1) * 64; stK = *(const u32x4*)(gK + o * 1024); stV = *(const u32x4*)(gV + o * 1024); if (tid < 256) stR = *(const u32x4*)(gR + o * 32); }
        const unsigned char* Kb = smem + cur * ATT_KBUF;
        f32x16 p0 = f32x16{}, p1 = f32x16{};
#pragma unroll
        for (int s6 = 0; s6 < 6; ++s6) {
            const bf16x8 k0 = *(const bf16x8*)(Kb + kbase + s6 * 32);
            const bf16x8 k1 = *(const bf16x8*)(Kb + kbase + 32 * ATT_KROW + s6 * 32);
            p0 = __builtin_amdgcn_mfma_f32_32x32x16_bf16(k0, qf[s6], p0, 0, 0, 0);
            p1 = __builtin_amdgcn_mfma_f32_32x32x16_bf16(k1, qf[s6], p1, 0, 0, 0);
        }
        float mx = fmaxf(p0[0], p1[0]);
#pragma unroll
        for (int r = 1; r < 16; ++r) mx = fmaxf(mx, fmaxf(p0[r], p1[r]));
        mx = fmaxf(mx, __shfl_xor(mx, 32));
        const float mn = fmaxf(m, mx), alpha = __builtin_amdgcn_exp2f(m - mn);
        m = mn;
        float sum = 0.f;
#pragma unroll
        for (int r = 0; r < 16; ++r) { p0[r] = __builtin_amdgcn_exp2f(p0[r] - mn); p1[r] = __builtin_amdgcn_exp2f(p1[r] - mn); sum += p0[r] + p1[r]; }
        l = l * alpha + sum;
#pragma unroll
        for (int r = 0; r < 16; ++r) { ot[0][r] *= alpha; ot[1][r] *= alpha; }
        bf16x8 pw[4];
#pragma unroll
        for (int s2 = 0; s2 < 2; ++s2) {
            u32x4 w0, w1;
#pragma unroll
            for (int e = 0; e < 4; ++e) { w0[e] = cvtpk(p0[8 * s2 + 2 * e], p0[8 * s2 + 2 * e + 1]); w1[e] = cvtpk(p1[8 * s2 + 2 * e], p1[8 * s2 + 2 * e + 1]); }
            pw[s2] = __builtin_bit_cast(bf16x8, w0); pw[2 + s2] = __builtin_bit_cast(bf16x8, w1);
        }
        const LDSAS unsigned char* Vb = (const LDSAS unsigned char*)(smem) + vbase + cur * ATT_VBUF;
#pragma unroll
        for (int d0 = 0; d0 < 2; ++d0)
#pragma unroll
            for (int ks = 0; ks < 4; ++ks) {
                const v4i16_t lo = __builtin_amdgcn_ds_read_tr16_b64_v4i16((LDSAS v4i16_t*)(Vb + d0 * 4096 + ks * 1024));
                const v4i16_t hh = __builtin_amdgcn_ds_read_tr16_b64_v4i16((LDSAS v4i16_t*)(Vb + d0 * 4096 + ks * 1024 + 512));
                const bf16x8 vf = (bf16x8){lo[0], lo[1], lo[2], lo[3], hh[0], hh[1], hh[2], hh[3]};
                ot[d0] = __builtin_amdgcn_mfma_f32_32x32x16_bf16(vf, pw[ks], ot[d0], 0, 0, 0);
            }
        if (j + 1 < NT) {
            const int nb = cur ^ 1;
            *(u32x4*)(smem + nb * ATT_KBUF + dK) = stK; *(u32x4*)(smem + ATT_V0 + nb * ATT_VBUF + dV) = stV; if (tid < 256) *(u32x4*)(smem + nb * ATT_KBUF + dR) = stR;
        }
        __syncthreads();
    }
    l += __shfl_xor(l, 32);
    const float il = 1.f / l;
    bf16_t* orow = YC + qrow * DM + 512 + hd * 64 + 4 * hi;
#pragma unroll
    for (int d0 = 0; d0 < 2; ++d0)
#pragma unroll
        for (int g = 0; g < 4; ++g) {
            const unsigned lo = cvtpk(ot[d0][4 * g] * il, ot[d0][4 * g + 1] * il), hh = cvtpk(ot[d0][4 * g + 2] * il, ot[d0][4 * g + 3] * il);
            *(unsigned long long*)(orow + 32 * d0 + 8 * g) = (unsigned long long)lo | ((unsigned long long)hh << 32);
        }
}

__device__ void softmax_rows(const Params& p, int gw, int ngw, int lane) {
    const float* SC = (const float*)(p.ws + WS_SC); bf16_t* P = (bf16_t*)(p.ws + WS_P);
    for (int r = gw; r < 32 * SEQ; r += ngw) {
        const f32x4 v = ((const f32x4*)(SC + (long)r * 256))[lane];
        float mx = fmaxf(fmaxf(v.x, v.y), fmaxf(v.z, v.w));
#pragma unroll
        for (int o = 1; o < 64; o <<= 1) mx = fmaxf(mx, __shfl_xor(mx, o));
        const float e0 = __expf(v.x - mx), e1 = __expf(v.y - mx), e2 = __expf(v.z - mx), e3 = __expf(v.w - mx);
        const float inv = 1.f / wave_sum(e0 + e1 + e2 + e3);
        ((unsigned long long*)(P + (long)r * 256))[lane] = (unsigned long long)pk2(e0 * inv, e1 * inv) | ((unsigned long long)pk2(e2 * inv, e3 * inv) << 32);
    }
}

constexpr int NTHREADS = 512;
constexpr int LDS_BYTES = 147456;

template <class Pol>
__device__ __forceinline__ void big_gemm(unsigned char* smem, const bf16_t* A, int lda, const bf16_t* Bt, int ldb, int Mm, int Nn, int K, const Pol pol) {
    pg8::Gemm g{A, Bt, lda, ldb, K}; pg8::StaticOrder S; S.init(Mm, Nn, (int)gridDim.x, (int)blockIdx.x);
    pg8::EpiStore8<Pol> E{pol};
    pg8::gemm_phase<pg8::EpiStore8<Pol>, pg8::StaticOrder, true, true>((PG8_LAS unsigned char*)smem, g, S, E);
}

template <int PH>
__device__ __forceinline__ void run_phase(const Params& p, unsigned char* smem, int bid, int nblk) {
    const int tid = threadIdx.x, lane = tid & 63, wid = tid >> 6;
    const int gw = bid * (NTHREADS / 64) + wid, ngw = nblk * (NTHREADS / 64);
    unsigned char* ws = p.ws;
    if constexpr (PH == 0) {
        prologue_weights(p, smem, gw, ngw, wid, lane);
        norm_rows_bf16(p.x, nullptr, (bf16_t*)(ws + WS_XN), M, gw, ngw, lane);
    } else if constexpr (PH == 1) {
        big_gemm(smem, (const bf16_t*)(ws + WS_XN), DM, (const bf16_t*)(ws + WS_WIN), DM, M, ZLD, DM, pg8::StBf16{(bf16_t*)(ws + WS_Z), ZLD});
    } else if constexpr (PH == 2) {
        mla_prep_rows(p, gw, ngw, lane);
    } else if constexpr (PH == 3) {
        { GemmDesc g{(const bf16_t*)(ws + WS_CQ), 256, 0, 0, p.mla_w_uq, 768, 0, 0, M, 768, 256, 1, 1};
          bf16_t* Q = (bf16_t*)(ws + WS_Q);
          gemm_simple<0>(g, [=](int, int r, int c, float v) { Q[(long)r * 768 + c] = f2bf(v); }, smem, bid, nblk); }
        { GemmDesc g{(const bf16_t*)(ws + WS_CKV), 128, 0, 0, p.mla_w_ukv, 1024, 0, 0, M, 1024, 128, 1, 1};
          bf16_t* KV = (bf16_t*)(ws + WS_KV);
          gemm_simple<0>(g, [=](int, int r, int c, float v) { KV[(long)r * 1024 + c] = f2bf(v); }, smem, bid, nblk); }
    } else if constexpr (PH == 4) {
        { const int vcu = (nblk % 8 == 0) ? (bid % 8) * (nblk / 8) + bid / 8 : bid;
          for (int u = vcu * 2; u < 512; u += nblk * 2) { mla_attn_unit(p, smem, u); if (u + 1 < 512) mla_attn_unit(p, smem, u + 1); } }
    } else if constexpr (PH == 5) {
        rwkv_prep_rows(p, gw, ngw, lane);
    } else if constexpr (PH == 6) {
        const bf16_t* LIN = (const bf16_t*)(ws + WS_LIN);
        for (int d = 0; d < 2; ++d) {
            { GemmDesc g{LIN + 32 * d, 256, 0, 0, p.rwkv_w2 + (long)d * 32 * RC, RC, 0, 0, M, RC, 32, 1, 1};
              bf16_t* LW = (bf16_t*)(ws + WS_LW) + (long)d * M * RC; const float* w0 = p.rwkv_w0 + d * RC;
              gemm_simple<0>(g, [=](int, int r, int c, float v) {
                  const float xx = -(w0[c] + v);
                  const float sp = fmaxf(xx, 0.f) + log1pf(__expf(-fabsf(xx)));
                  LW[(long)r * RC + c] = f2bf(-__expf(-sp - 0.5f)); }, smem, bid, nblk); }
            { GemmDesc g{LIN + 64 + 32 * d, 256, 0, 0, p.rwkv_a2 + (long)d * 32 * RC, RC, 0, 0, M, RC, 32, 1, 1};
              bf16_t* AA = (bf16_t*)(ws + WS_AA) + (long)d * M * RC; const float* a0 = p.rwkv_a0 + d * RC;
              gemm_simple<0>(g, [=](int, int r, int c, float v) { AA[(long)r * RC + c] = f2bf(sigmoidf_(a0[c] + v)); }, smem, bid, nblk); }
        }
        { GemmDesc g{LIN + 128, 256, 0, 0, p.rwkv_g2, RC, 0, 0, M, RC, 96, 1, 1};
          bf16_t* G = (bf16_t*)(ws + WS_G);
          gemm_simple<0>(g, [=](int, int r, int c, float v) { G[(long)r * RC + c] = f2bf(v); }, smem, bid, nblk); }
    } else if constexpr (PH == 7) {
        for (int c = gw; c < 2 * BATCH * RH; c += ngw) rwkv_scan_naive(p, c, lane);
    } else if constexpr (PH == 8) {
        rwkv_combine_rows(p, gw, ngw, lane);
    } else if constexpr (PH == 9) {
        big_gemm(smem, (const bf16_t*)(ws + WS_YCAT), DM, (const bf16_t*)(ws + WS_WOUT), DM, M, DM, DM, pg8::StBf16{(bf16_t*)(ws + WS_Y), DM});
    } else if constexpr (PH == 10) {
        resid_norm_rows(p.x, (const bf16_t*)(ws + WS_Y), p.norm_mix_post, p.out, (bf16_t*)(ws + WS_XN), gw, ngw, lane);
        norm_rows_bf16(p.mem, p.norm_memtok, (bf16_t*)(ws + WS_MN), BATCH * MEMT, gw, ngw, lane);
    } else if constexpr (PH == 11) {
        big_gemm(smem, (const bf16_t*)(ws + WS_XN), DM, (const bf16_t*)(ws + WS_WQ), DM, M, DM, DM, pg8::StBf16{(bf16_t*)(ws + WS_QM), DM});
        { GemmDesc g{(const bf16_t*)(ws + WS_MN), DM, 0, 0, p.mem_wkv, 2048, 0, 0, BATCH * MEMT, 2048, DM, 1, 1};
          bf16_t* KVM = (bf16_t*)(ws + WS_KVM);
          gemm_simple<0>(g, [=](int, int r, int c, float v) { KVM[(long)r * 2048 + c] = f2bf(v); }, smem, bid, nblk); }
    } else if constexpr (PH == 12) {
        GemmDesc g{(const bf16_t*)(ws + WS_QM), DM, (long)SEQ * DM, MEMD, (const bf16_t*)(ws + WS_KVM), 2048, (long)MEMT * 2048, MEMD, SEQ, MEMT, MEMD, BATCH * MEMH, MEMH};
        float* SC = (float*)(ws + WS_SC);
        gemm_simple<2>(g, [=](int bi, int r, int c, float v) { SC[((long)bi * SEQ + r) * MEMT + c] = v * 0.0625f; }, smem, bid, nblk);
    } else if constexpr (PH == 13) {
        softmax_rows(p, gw, ngw, lane);
    } else if constexpr (PH == 14) {
        GemmDesc g{(const bf16_t*)(ws + WS_P), MEMT, (long)MEMH * SEQ * MEMT, (long)SEQ * MEMT, (const bf16_t*)(ws + WS_KVM) + 1024, 2048, (long)MEMT * 2048, MEMD, SEQ, MEMD, MEMT, BATCH * MEMH, MEMH};
        bf16_t* OM = (bf16_t*)(ws + WS_OM);
        gemm_simple<1>(g, [=](int bi, int r, int c, float v) { OM[((long)(bi / MEMH) * SEQ + r) * DM + (bi % MEMH) * MEMD + c] = f2bf(v); }, smem, bid, nblk);
    } else if constexpr (PH == 15) {
        big_gemm(smem, (const bf16_t*)(ws + WS_OM), DM, (const bf16_t*)(ws + WS_WO), DM, M, DM, DM, pg8::StBf16{(bf16_t*)(ws + WS_Y), DM});
    } else if constexpr (PH == 16) {
        resid_norm_rows(p.out, (const bf16_t*)(ws + WS_Y), p.norm_mem_post, p.out, (bf16_t*)(ws + WS_XN), gw, ngw, lane);
    } else if constexpr (PH == 17) {
        big_gemm(smem, (const bf16_t*)(ws + WS_XN), DM, (const bf16_t*)(ws + WS_W1), DM, M, DFF, DM, pg8::StRelu2{(bf16_t*)(ws + WS_HID), DFF});
    } else if constexpr (PH == 18) {
        big_gemm(smem, (const bf16_t*)(ws + WS_HID), DFF, (const bf16_t*)(ws + WS_W2), DFF, M, DM, DFF, pg8::StBf16{(bf16_t*)(ws + WS_Y), DM});
    } else if constexpr (PH == 19) {
        resid_norm_rows(p.out, (const bf16_t*)(ws + WS_Y), p.norm_mlp_post, p.out, nullptr, gw, ngw, lane);
    }
}

template <int PH> __device__ __forceinline__ void run_all(const Params& p, unsigned char* smem, cg::grid_group& grid) {
    run_phase<PH>(p, smem, blockIdx.x, gridDim.x);
    if constexpr (PH + 1 < 20) { grid.sync(); run_all<PH + 1>(p, smem, grid); }
}
__global__ void __launch_bounds__(NTHREADS, 2) mega_kernel(Params p) {
    extern __shared__ __attribute__((aligned(16))) unsigned char smem[];
    cg::grid_group grid = cg::this_grid();
    run_all<0>(p, smem, grid);
}

extern "C" void kernel_launch(void* const* d_in, const int* in_sizes, int n_in, void* d_out, int out_size, void* d_ws, size_t ws_size, hipStream_t stream) {
    static int grid_blocks = 0;
    if (!grid_blocks) {
        int dev = 0, cus = 0, per_cu = 0;
        (void)hipFuncSetAttribute((const void*)mega_kernel, hipFuncAttributeMaxDynamicSharedMemorySize, LDS_BYTES);
        (void)hipGetDevice(&dev);
        (void)hipDeviceGetAttribute(&cus, hipDeviceAttributeMultiprocessorCount, dev);
        (void)hipOccupancyMaxActiveBlocksPerMultiprocessor(&per_cu, mega_kernel, NTHREADS, LDS_BYTES);
        if (per_cu < 1) per_cu = 1;
        grid_blocks = cus * per_cu;
        fprintf(stderr, "kernel_launch: cus=%d per_cu=%d grid=%d\n", cus, per_cu, grid_blocks);
    }
    Params p{};
    p.x = (const float*)d_in[0]; p.mem = (const float*)d_in[1]; p.pos = (const int*)d_in[2];
    const float** f = &p.norm_mix_pre;
    for (int i = 0; i < 29; ++i) f[i] = (const float*)d_in[3 + i];
    p.out = (float*)d_out; p.ws = (unsigned char*)d_ws;
    void* args[] = {&p};
    hipError_t e = hipLaunchCooperativeKernel((void*)mega_kernel, dim3(grid_blocks), dim3(NTHREADS), args, LDS_BYTES, stream);
    if (e != hipSuccess) fprintf(stderr, "cooperative launch failed: %s (grid %d)\n", hipGetErrorString(e), grid_blocks);
}
```

```cpp
#include <hip/hip_runtime.h>
#include <hip/hip_cooperative_groups.h>
namespace cg = cooperative_groups;
#include <cstdio>
#include <cstdint>

typedef unsigned short bf16_t;
typedef short bf16x8 __attribute__((ext_vector_type(8)));
typedef float f32x4 __attribute__((ext_vector_type(4)));
typedef unsigned u32x4 __attribute__((ext_vector_type(4)));

constexpr int BATCH = 8, SEQ = 2048, DM = 1024, M = BATCH * SEQ;
constexpr int RH = 8, RN = 64, RC = 512;
constexpr int RWKV_COLS = 1760, MLA_COLS = 416, D_IN = 2176;
constexpr int ZC_XW = 1536, ZC_XA = 1600, ZC_XG = 1664;
constexpr int ZC_CQ = 1760, ZC_CKV = 2016, ZC_KR = 2144;
constexpr int MH = 8, NOPE = 64, ROPE = 32, VD = 64, QKD = 96;
constexpr int MEMT = 256, MEMH = 4, MEMD = 256;
constexpr int DFF = 4096;
constexpr float NORM_EPS = 1e-6f, LNX_EPS = 64e-5f;

constexpr size_t MiB = 1u << 20;
constexpr int ZLD = 2304;
constexpr size_t WS_WIN  = 0;
constexpr size_t WS_WOUT = 5 * MiB;
constexpr size_t WS_WQ   = 7 * MiB;
constexpr size_t WS_WKV  = 9 * MiB;
constexpr size_t WS_WO   = 13 * MiB;
constexpr size_t WS_W1   = 15 * MiB;
constexpr size_t WS_W2   = 23 * MiB;
constexpr size_t WS_WUQ  = 31 * MiB;
constexpr size_t WS_WUKV = 31 * MiB + 512 * 1024;
constexpr size_t WS_WLG  = 32 * MiB;
constexpr size_t WS_XN   = 34 * MiB;
constexpr size_t WS_Z    = 66 * MiB;
constexpr size_t WS_YCAT = 138 * MiB;
constexpr size_t WS_CQ   = 170 * MiB;
constexpr size_t WS_CKV  = 178 * MiB;
constexpr size_t WS_KR   = 186 * MiB;
constexpr size_t WS_Q    = 188 * MiB;
constexpr size_t WS_KV   = 212 * MiB;
constexpr size_t WS_LIN  = 170 * MiB;
constexpr size_t WS_LW   = 178 * MiB;
constexpr size_t WS_AA   = 210 * MiB;
constexpr size_t WS_G    = 34 * MiB;
constexpr size_t WS_O01  = 66 * MiB;
constexpr size_t WS_Y    = 66 * MiB;
constexpr size_t WS_QM   = 98 * MiB;
constexpr size_t WS_MN   = 130 * MiB;
constexpr size_t WS_KVM  = 134 * MiB;
constexpr size_t WS_SC   = 142 * MiB;
constexpr size_t WS_P    = 206 * MiB;
constexpr size_t WS_OM   = 98 * MiB;
constexpr size_t WS_HID  = 98 * MiB;

struct Params {
    const float* x; const float* mem; const int* pos;
    const float *norm_mix_pre, *w_in, *conv_rwkv, *rwkv_w0, *rwkv_w2, *rwkv_a0, *rwkv_a2, *rwkv_g2, *rwkv_k_k, *rwkv_k_a, *rwkv_r_k,
                *rwkv_lnx_w, *rwkv_lnx_b, *mla_q_norm, *mla_w_uq, *mla_kv_norm, *mla_w_ukv, *w_out, *norm_mix_post, *norm_mem_pre,
                *norm_memtok, *mem_wq, *mem_wkv, *mem_wo, *norm_mem_post, *norm_mlp_pre, *mlp_w1, *mlp_w2, *norm_mlp_post;
    float* out; unsigned char* ws;
};

__device__ __forceinline__ float bf2f(bf16_t v) { return __uint_as_float((unsigned)v << 16); }
__device__ __forceinline__ bf16_t f2bf(float f) { unsigned u = __float_as_uint(f); return (bf16_t)((u + 0x7fffu + ((u >> 16) & 1u)) >> 16); }
__device__ __forceinline__ unsigned pk2(float lo, float hi) { return (unsigned)f2bf(lo) | ((unsigned)f2bf(hi) << 16); }
__device__ __forceinline__ float wave_sum(float v) {
#pragma unroll
    for (int o = 1; o < 64; o <<= 1) v += __shfl_xor(v, o);
    return v;
}
__device__ __forceinline__ float sigmoidf_(float x) { return 1.f / (1.f + __expf(-x)); }
__device__ __forceinline__ float rdlane(float v, int k) { return __uint_as_float((unsigned)__builtin_amdgcn_readlane((int)__float_as_uint(v), k)); }

namespace pg8 {
#define PG8_LAS __attribute__((address_space(3)))
typedef unsigned short bf16_t;
typedef short bf16x8 __attribute__((ext_vector_type(8)));
typedef float f32x4 __attribute__((ext_vector_type(4)));
typedef unsigned u32x4 __attribute__((ext_vector_type(4)));
constexpr int BM = 256, BK = 64, HALF = 128, HTB = HALF * BK * 2  , STAGE_BYTES = 8 * HTB, NXCD = 8, WGM = 8;

__host__ __device__ __forceinline__ int lds_byte(int r, int c) { const int st = (r >> 4) * 2 + (c >> 5), rr = r & 15, cc = c & 31, ob = rr * 64 + cc * 2; return st * 1024 + (ob ^ (((ob >> 9) & 1) << 5)); }
__host__ __device__ __forceinline__ void stage_rc(int b, int& R, int& C) { const int st = b / 1024, sb = b % 1024, swz = sb ^ (((sb >> 9) & 1) << 5); R = (st >> 1) * 16 + swz / 64; C = (st & 1) * 32 + (swz % 64) / 2; }
__host__ __device__ __forceinline__ int perm32(int rho) { const int n = rho >> 4, i = rho & 15; return 8 * (i >> 2) + 4 * n + (i & 3); }

struct Unit { int pm, pn, bi; };
struct Gemm { const bf16_t* A; const bf16_t* Bt; int lda, ldb, K; };

struct StaticOrder {
    int nM, nN, nwg, G, c;
    __host__ __device__ void init(int M, int N, int G_, int c_) { nM = M / BM; nN = N / BM; nwg = nM * nN; G = G_; c = c_; }
    __host__ __device__ bool next(int i, Unit& u) const {
        const long L = (long)i * G + c; if (L >= nwg) return false;
        int wgid = (int)L; { const int q = nwg / NXCD, r = nwg % NXCD, xcd = wgid % NXCD, off = wgid / NXCD; wgid = (xcd < r ? xcd * (q + 1) : r * (q + 1) + (xcd - r) * q) + off; }
        const int nig = WGM * nN, gid = wgid / nig, fm = gid * WGM, gsz = (nM - fm) < WGM ? (nM - fm) : WGM;
        u.pm = fm + ((wgid % nig) % gsz); u.pn = (wgid % nig) / gsz; u.bi = 0; return true;
    }
    __device__ __forceinline__ const char* a_ptr(const Gemm& g, const Unit& u) const { return (const char*)(g.A + (size_t)u.pm * BM * g.lda); }
    __device__ __forceinline__ const char* b_ptr(const Gemm& g, const Unit& u) const { return (const char*)(g.Bt + (size_t)u.pn * BM * g.ldb); }
    __device__ __forceinline__ void a_ready(const Unit&) const {}
    __device__ __forceinline__ void done(const Unit&) const {}
};

__device__ __forceinline__ unsigned cvt_pk_bf16(float lo, float hi) { unsigned r; asm volatile("v_cvt_pk_bf16_f32 %0, %1, %2" : "=v"(r) : "v"(lo), "v"(hi)); return r; }
typedef float f32x2 __attribute__((ext_vector_type(2)));


template <class P> struct EpiStore8 {
    static constexpr bool PERM = true, AFTER_DRAIN = false;
    P pol;
    __device__ __forceinline__ void operator()(const f32x4 (&acc)[2][2][4][2], const Unit& u, int wr, int wc, int fr, int fq) const {
        const int row0 = u.pm * BM + wr * 64 + fr, col0 = u.pn * BM + wc * 32 + 8 * fq;
#pragma unroll
        for (int ai = 0; ai < 2; ++ai)
#pragma unroll
            for (int m = 0; m < 4; ++m)
#pragma unroll
                for (int bj = 0; bj < 2; ++bj) pol.store8(u, row0 + ai * HALF + m * 16, col0 + bj * HALF, acc[ai][bj][m][0], acc[ai][bj][m][1]);
    }
};
__device__ __forceinline__ u32x4 pack8(const f32x4& v0, const f32x4& v1) { u32x4 w; w.x = cvt_pk_bf16(v0[0], v0[1]); w.y = cvt_pk_bf16(v0[2], v0[3]); w.z = cvt_pk_bf16(v1[0], v1[1]); w.w = cvt_pk_bf16(v1[2], v1[3]); return w; }
struct StBf16 { bf16_t* O; int ldc;
    __device__ __forceinline__ void store8(const Unit&, int row, int col, const f32x4& v0, const f32x4& v1) const { *(u32x4*)(O + (size_t)row * ldc + col) = pack8(v0, v1); } };
struct StRelu2 { bf16_t* O; int ldc;
    __device__ __forceinline__ void store8(const Unit&, int row, int col, f32x4 v0, f32x4 v1) const {
#pragma unroll
        for (int e = 0; e < 4; ++e) { const float a = fmaxf(v0[e], 0.f), b = fmaxf(v1[e], 0.f); v0[e] = a * a; v1[e] = b * b; }
        *(u32x4*)(O + (size_t)row * ldc + col) = pack8(v0, v1); } };
template <class Epi, class Sched, bool ALIGN_EPI = false, bool SP2 = false>
__device__ __forceinline__ void gemm_phase(PG8_LAS unsigned char* lds, const Gemm g, const Sched& S, const Epi& E) {
    const int tid = threadIdx.x, wid = __builtin_amdgcn_readfirstlane(tid >> 6), lane = tid & 63, wr = wid >> 2, wc = wid & 3, fr = lane & 15, fq = lane >> 4;
    const int K = g.K, nt = K / BK;
    unsigned voffA[2], voffB[2];
#pragma unroll
    for (int i = 0; i < 2; ++i) { int R, C; stage_rc(tid * 16 + i * 8192, R, C); const int Rb = Epi::PERM ? ((R & ~31) + perm32(R & 31)) : R;
        voffA[i] = (unsigned)(R * g.lda + C) * 2u; voffB[i] = (unsigned)(Rb * g.ldb + C) * 2u; }
    const size_t kstep = (size_t)(BK * 2);
    const size_t hstepA = (size_t)HALF * g.lda * 2, hstepB = (size_t)HALF * g.ldb * 2;
    const unsigned ldsw = (unsigned)wid * 1024u;
    const int aoff = lds_byte(wr * 64 + fr, fq * 8), boff = lds_byte(wc * 32 + fr, fq * 8);
#define PG8_SA(b, h) (((b) * 2 + (h)) * HTB)
#define PG8_SB(b, h) ((4 + (b) * 2 + (h)) * HTB)
#define PG8_STAGE(bufoff, gbase, voff) do { _Pragma("unroll") for (int _i = 0; _i < 2; ++_i) \
        __builtin_amdgcn_global_load_lds((const unsigned*)((const char*)(gbase) + (voff)[_i]), (PG8_LAS unsigned*)(lds + (bufoff) + ldsw + _i * 8192), 16, 0, 0); } while (0)
#define PG8_LDA(dst, b, h) do { _Pragma("unroll") for (int m = 0; m < 4; ++m) _Pragma("unroll") for (int k = 0; k < 2; ++k) dst[m][k] = *(const PG8_LAS bf16x8*)(lds + PG8_SA(b, h) + aoff + m * 2048 + k * 1024); } while (0)
#define PG8_LDB(dst, b, h) do { _Pragma("unroll") for (int n = 0; n < 2; ++n) _Pragma("unroll") for (int k = 0; k < 2; ++k) dst[n][k] = *(const PG8_LAS bf16x8*)(lds + PG8_SB(b, h) + boff + n * 2048 + k * 1024); } while (0)
#define PG8_MMA(ai, bj, At, Bt) do { __builtin_amdgcn_s_setprio(1); _Pragma("unroll") for (int m = 0; m < 4; ++m) _Pragma("unroll") for (int n = 0; n < 2; ++n) _Pragma("unroll") for (int k = 0; k < 2; ++k) \
        acc[ai][bj][m][n] = __builtin_amdgcn_mfma_f32_16x16x32_bf16(Bt[n][k], At[m][k], acc[ai][bj][m][n], 0, 0, 0); __builtin_amdgcn_s_setprio(0); } while (0)
#define PG8_WAIT_V(n) asm volatile("s_waitcnt vmcnt(" #n ")" ::: "memory")
#define PG8_WAIT_L(n) asm volatile("s_waitcnt lgkmcnt(" #n ")" ::: "memory")
#define PG8_BAR __builtin_amdgcn_s_barrier()
#define PG8_SCHED __builtin_amdgcn_sched_barrier(0)
    Unit cur, nxt; int ui = 0;
    if (!S.next(0, cur)) return;
    f32x4 acc[2][2][4][2];
#pragma unroll
    for (int a = 0; a < 2; ++a)
#pragma unroll
        for (int b = 0; b < 2; ++b)
#pragma unroll
            for (int m = 0; m < 4; ++m)
#pragma unroll
                for (int n = 0; n < 2; ++n) acc[a][b][m][n] = (f32x4){0.f, 0.f, 0.f, 0.f};
    bf16x8 At[4][2], B0[2][2], B1[2][2];
    const char* cA = S.a_ptr(g, cur); const char* cB = S.b_ptr(g, cur);
    S.a_ready(cur);
    if constexpr (SP2) {
        PG8_STAGE(PG8_SB(0, 0), cB, voffB); PG8_STAGE(PG8_SB(0, 1), cB + hstepB, voffB); PG8_STAGE(PG8_SA(0, 0), cA, voffA); PG8_STAGE(PG8_SA(0, 1), cA + hstepA, voffA);
        if (wr == 1) PG8_BAR;
        PG8_WAIT_V(2); PG8_BAR;
        PG8_STAGE(PG8_SB(1, 0), cB + kstep, voffB); PG8_STAGE(PG8_SA(1, 0), cA + kstep, voffA); PG8_STAGE(PG8_SB(1, 1), cB + hstepB + kstep, voffB);
        PG8_WAIT_V(6); PG8_BAR;
    } else {
        PG8_STAGE(PG8_SB(0, 0), cB, voffB); PG8_STAGE(PG8_SA(0, 0), cA, voffA); PG8_STAGE(PG8_SB(0, 1), cB + hstepB, voffB); PG8_STAGE(PG8_SA(0, 1), cA + hstepA, voffA);
        if (wr == 1) PG8_BAR;
        PG8_WAIT_V(4); PG8_BAR;
        PG8_STAGE(PG8_SB(1, 0), cB + kstep, voffB); PG8_STAGE(PG8_SA(1, 0), cA + kstep, voffA); PG8_STAGE(PG8_SB(1, 1), cB + hstepB + kstep, voffB);
        PG8_WAIT_V(6); PG8_BAR;
    }
    for (;;) {
        const bool has_next = S.next(ui + 1, nxt);
        const char* nA = has_next ? S.a_ptr(g, nxt) : cA; const char* nB = has_next ? S.b_ptr(g, nxt) : cB;
        for (int t = 0; t < nt; t += 2) {
            const bool last = (t == nt - 2);
            const char* a1 = cA + (size_t)(t + 1) * kstep;
            const char* a2 = last ? nA : cA + (size_t)(t + 2) * kstep; const char* b2 = last ? nB : cB + (size_t)(t + 2) * kstep;
            const char* a3 = a2 + kstep; const char* b3 = b2 + kstep;
            if (last && has_next) S.a_ready(nxt);
            if constexpr (SP2) {
            PG8_LDB(B0, 0, 0); PG8_LDB(B1, 0, 1); PG8_SCHED; PG8_LDA(At, 0, 0); PG8_STAGE(PG8_SA(1, 1), a1 + hstepA, voffA);
            PG8_WAIT_V(8); PG8_WAIT_L(0); PG8_BAR; PG8_MMA(0, 0, At, B0); PG8_MMA(0, 1, At, B1); PG8_BAR; PG8_SCHED;
            PG8_LDA(At, 0, 1); PG8_STAGE(PG8_SB(0, 0), b2, voffB); PG8_STAGE(PG8_SB(0, 1), b2 + hstepB, voffB); PG8_STAGE(PG8_SA(0, 0), a2, voffA);
            PG8_WAIT_V(8); PG8_WAIT_L(0); PG8_BAR; PG8_MMA(1, 0, At, B0); PG8_MMA(1, 1, At, B1); PG8_BAR; PG8_SCHED;
            PG8_LDB(B0, 1, 0); PG8_LDB(B1, 1, 1); PG8_SCHED; PG8_LDA(At, 1, 0); PG8_STAGE(PG8_SA(0, 1), a2 + hstepA, voffA);
            PG8_WAIT_V(8); PG8_WAIT_L(0); PG8_BAR; PG8_MMA(0, 0, At, B0); PG8_MMA(0, 1, At, B1); PG8_BAR; PG8_SCHED;
            PG8_LDA(At, 1, 1); PG8_STAGE(PG8_SB(1, 0), b3, voffB); PG8_STAGE(PG8_SB(1, 1), b3 + hstepB, voffB); PG8_STAGE(PG8_SA(1, 0), a3, voffA);
            PG8_WAIT_V(8); PG8_WAIT_L(0); PG8_BAR; PG8_MMA(1, 0, At, B0); PG8_MMA(1, 1, At, B1); PG8_BAR; PG8_SCHED;
            } else {
            PG8_LDB(B0, 0, 0); PG8_SCHED; PG8_LDA(At, 0, 0); PG8_STAGE(PG8_SA(1, 1), a1 + hstepA, voffA);
            PG8_WAIT_L(8); PG8_BAR; PG8_WAIT_L(0); PG8_MMA(0, 0, At, B0); PG8_BAR; PG8_SCHED;
            PG8_LDB(B1, 0, 1); PG8_STAGE(PG8_SB(0, 0), b2, voffB);
            PG8_BAR; PG8_WAIT_L(0); PG8_MMA(0, 1, At, B1); PG8_BAR;
            PG8_LDA(At, 0, 1); PG8_STAGE(PG8_SA(0, 0), a2, voffA);
            PG8_BAR; PG8_WAIT_L(0); PG8_MMA(1, 0, At, B0); PG8_BAR; PG8_SCHED;
            PG8_STAGE(PG8_SB(0, 1), b2 + hstepB, voffB);
            PG8_WAIT_V(6); PG8_BAR; PG8_MMA(1, 1, At, B1); PG8_BAR;
            PG8_LDB(B0, 1, 0); PG8_SCHED; PG8_LDA(At, 1, 0); PG8_STAGE(PG8_SA(0, 1), a2 + hstepA, voffA);
            PG8_WAIT_L(8); PG8_BAR; PG8_WAIT_L(0); PG8_MMA(0, 0, At, B0); PG8_BAR; PG8_SCHED;
            PG8_LDB(B1, 1, 1); PG8_STAGE(PG8_SB(1, 0), b3, voffB);
            PG8_BAR; PG8_WAIT_L(0); PG8_MMA(0, 1, At, B1); PG8_BAR;
            PG8_LDA(At, 1, 1); PG8_STAGE(PG8_SA(1, 0), a3, voffA);
            PG8_BAR; PG8_WAIT_L(0); PG8_MMA(1, 0, At, B0); PG8_BAR; PG8_SCHED;
            PG8_STAGE(PG8_SB(1, 1), b3 + hstepB, voffB);
            PG8_WAIT_V(6); PG8_BAR; PG8_MMA(1, 1, At, B1); PG8_BAR;
            }
        }
        if constexpr (ALIGN_EPI) { if (wr == 0) PG8_BAR; }
        if constexpr (!Epi::AFTER_DRAIN) { E(acc, cur, wr, wc, fr, fq); S.done(cur); }
        if (!has_next) break;
#pragma unroll
        for (int a = 0; a < 2; ++a)
#pragma unroll
            for (int b = 0; b < 2; ++b)
#pragma unroll
                for (int m = 0; m < 4; ++m)
#pragma unroll
                    for (int n = 0; n < 2; ++n) acc[a][b][m][n] = (f32x4){0.f, 0.f, 0.f, 0.f};
        cur = nxt; cA = nA; cB = nB; ++ui;
        if constexpr (ALIGN_EPI) { if (wr == 1) PG8_BAR; }
    }
    PG8_WAIT_V(0);
    if constexpr (!ALIGN_EPI) { if (wr == 0) PG8_BAR; }
    PG8_BAR;
    if constexpr (Epi::AFTER_DRAIN) { E.fused(acc, cur, wr, wc, fr, fq, lds, wid, lane); S.done(cur); }
#undef PG8_SA
#undef PG8_SB
#undef PG8_STAGE
#undef PG8_LDA
#undef PG8_LDB
#undef PG8_MMA
#undef PG8_WAIT_V
#undef PG8_WAIT_L
#undef PG8_BAR
#undef PG8_SCHED
}
}


struct GemmDesc {
    const bf16_t* A; int lda; long sAb, sAh;
    const void* B; int ldb; long sBb, sBh;
    int Mm, Nn, Kk, nbatch, nh;
};
template <int BMODE  , class EP>
__device__ void gemm_simple(const GemmDesc g, EP epi, unsigned char* smem, int bid, int nblk) {
    bf16_t* sA = (bf16_t*)smem;
    bf16_t* sB = sA + 128 * 40;
    const int tid = threadIdx.x, lane = tid & 63, wid = tid >> 6, wr = wid >> 2, wc = wid & 3, fr = lane & 15, fq = lane >> 4;
    const int tM = g.Mm / 128, tN = g.Nn / 128, ntile = tM * tN * g.nbatch;
    for (int t = bid; t < ntile; t += nblk) {
        const int bi = t / (tM * tN), tt = t % (tM * tN), tm = tt / tN, tn = tt % tN;
        const bf16_t* A = g.A + (long)(bi / g.nh) * g.sAb + (long)(bi % g.nh) * g.sAh + (long)tm * 128 * g.lda;
        const long boff = (long)(bi / g.nh) * g.sBb + (long)(bi % g.nh) * g.sBh;
        f32x4 acc[4][2];
#pragma unroll
        for (int i = 0; i < 4; ++i)
#pragma unroll
            for (int j = 0; j < 2; ++j) acc[i][j] = (f32x4){0.f, 0.f, 0.f, 0.f};
        for (int k0 = 0; k0 < g.Kk; k0 += 32) {
            __syncthreads();
            {
                const int r = tid >> 2, c = (tid & 3) * 8;
                const u32x4 v = *(const u32x4*)(A + (long)r * g.lda + k0 + c);
                *(u32x4*)(sA + r * 40 + c) = v;
            }
            if (BMODE == 2) {
                const bf16_t* B = (const bf16_t*)g.B + boff + (long)tn * 128 * g.ldb;
                const int r = tid >> 2, c = (tid & 3) * 8;
                const u32x4 v = *(const u32x4*)(B + (long)r * g.ldb + k0 + c);
                *(u32x4*)(sB + r * 40 + c) = v;
            } else if (BMODE == 0) {
                const float* B = (const float*)g.B + boff + (long)tn * 128;
                const int k = tid >> 4, n = (tid & 15) * 8;
                const f32x4 v0 = *(const f32x4*)(B + (long)(k0 + k) * g.ldb + n), v1 = *(const f32x4*)(B + (long)(k0 + k) * g.ldb + n + 4);
#pragma unroll
                for (int j = 0; j < 4; ++j) { sB[(n + j) * 40 + k] = f2bf(v0[j]); sB[(n + 4 + j) * 40 + k] = f2bf(v1[j]); }
            } else {
                const bf16_t* B = (const bf16_t*)g.B + boff + (long)tn * 128;
                const int k = tid >> 4, n = (tid & 15) * 8;
                const u32x4 v = *(const u32x4*)(B + (long)(k0 + k) * g.ldb + n);
                const bf16_t* e = (const bf16_t*)&v;
#pragma unroll
                for (int j = 0; j < 8; ++j) sB[(n + j) * 40 + k] = e[j];
            }
            __syncthreads();
            bf16x8 af[4], bfr[2];
#pragma unroll
            for (int i = 0; i < 4; ++i) af[i] = *(const bf16x8*)(sA + (wr * 64 + i * 16 + fr) * 40 + fq * 8);
#pragma unroll
            for (int j = 0; j < 2; ++j) bfr[j] = *(const bf16x8*)(sB + (wc * 32 + j * 16 + fr) * 40 + fq * 8);
#pragma unroll
            for (int i = 0; i < 4; ++i)
#pragma unroll
                for (int j = 0; j < 2; ++j) acc[i][j] = __builtin_amdgcn_mfma_f32_16x16x32_bf16(af[i], bfr[j], acc[i][j], 0, 0, 0);
        }
#pragma unroll
        for (int i = 0; i < 4; ++i)
#pragma unroll
            for (int j = 0; j < 2; ++j)
#pragma unroll
                for (int e = 0; e < 4; ++e) epi(bi, tm * 128 + wr * 64 + i * 16 + fq * 4 + e, tn * 128 + wc * 32 + j * 16 + fr, acc[i][j][e]);
    }
}

__device__ void norm_rows_bf16(const float* in, const float* gain, bf16_t* outb, int nrows, int gw, int ngw, int lane) {
    for (int r = gw; r < nrows; r += ngw) {
        const f32x4* xr = (const f32x4*)(in + (long)r * DM) + lane;
        f32x4 v[4]; float s = 0.f;
#pragma unroll
        for (int j = 0; j < 4; ++j) { v[j] = xr[64 * j]; s += v[j].x * v[j].x + v[j].y * v[j].y + v[j].z * v[j].z + v[j].w * v[j].w; }
        const float rstd = rsqrtf(wave_sum(s) * (1.f / DM) + NORM_EPS);
        unsigned long long* o8 = (unsigned long long*)(outb + (long)r * DM) + lane;
#pragma unroll
        for (int j = 0; j < 4; ++j) { const f32x4 gg = gain ? ((const f32x4*)gain)[lane + 64 * j] : (f32x4){1.f, 1.f, 1.f, 1.f};
            o8[64 * j] = (unsigned long long)pk2(v[j].x * rstd * gg.x, v[j].y * rstd * gg.y) | ((unsigned long long)pk2(v[j].z * rstd * gg.z, v[j].w * rstd * gg.w) << 32); }
    }
}
__device__ void resid_norm_rows(const float* base, const bf16_t* y, const float* g_post, float* xo, bf16_t* xn, int gw, int ngw, int lane) {
    for (int r = gw; r < M; r += ngw) {
        const unsigned long long* yr = (const unsigned long long*)(y + (long)r * DM) + lane; const f32x4* br = (const f32x4*)(base + (long)r * DM) + lane;
        f32x4 v[4], b[4]; float s = 0.f;
#pragma unroll
        for (int j = 0; j < 4; ++j) { const unsigned long long w = yr[64 * j]; const unsigned lo = (unsigned)w, hi = (unsigned)(w >> 32);
            v[j].x = __uint_as_float(lo << 16); v[j].y = __uint_as_float(lo & 0xffff0000u); v[j].z = __uint_as_float(hi << 16); v[j].w = __uint_as_float(hi & 0xffff0000u);
            b[j] = br[64 * j]; s += v[j].x * v[j].x + v[j].y * v[j].y + v[j].z * v[j].z + v[j].w * v[j].w; }
        const float rstd = rsqrtf(wave_sum(s) * (1.f / DM) + NORM_EPS);
        float s2 = 0.f;
#pragma unroll
        for (int j = 0; j < 4; ++j) { const f32x4 gg = ((const f32x4*)g_post)[lane + 64 * j];
            v[j].x = b[j].x + v[j].x * rstd * gg.x; v[j].y = b[j].y + v[j].y * rstd * gg.y; v[j].z = b[j].z + v[j].z * rstd * gg.z; v[j].w = b[j].w + v[j].w * rstd * gg.w;
            s2 += v[j].x * v[j].x + v[j].y * v[j].y + v[j].z * v[j].z + v[j].w * v[j].w; }
        f32x4* orow = (f32x4*)(xo + (long)r * DM) + lane;
#pragma unroll
        for (int j = 0; j < 4; ++j) orow[64 * j] = v[j];
        if (xn) {
            const float rstd2 = rsqrtf(wave_sum(s2) * (1.f / DM) + NORM_EPS);
            unsigned long long* o8 = (unsigned long long*)(xn + (long)r * DM) + lane;
#pragma unroll
            for (int j = 0; j < 4; ++j)
                o8[64 * j] = (unsigned long long)pk2(v[j].x * rstd2, v[j].y * rstd2) | ((unsigned long long)pk2(v[j].z * rstd2, v[j].w * rstd2) << 32);
        }
    }
}
__device__ __forceinline__ void transpose_item(const float* W, int N, const float* gain, bf16_t* WT, int ldk, float* scr, int item, int lane) {
    const int nblk = N / 32, kb = item / nblk, nb = item % nblk, k0 = 64 * kb, n0 = 32 * nb;
#pragma unroll 8
    for (int i = 0; i < 32; ++i) { const int kk = 2 * i + (lane >> 5); const float gg = gain ? gain[k0 + kk] : 1.f; scr[kk * 33 + (lane & 31)] = W[(size_t)(k0 + kk) * N + n0 + (lane & 31)] * gg; }
    asm volatile("s_waitcnt lgkmcnt(0)" ::: "memory");
    const int c = lane & 7;
#pragma unroll
    for (int j = 0; j < 4; ++j) { const int n = (lane >> 3) + 8 * j; const float* sp = scr + (8 * c) * 33 + n;
        u32x4 o; o.x = pk2(sp[0 * 33], sp[1 * 33]); o.y = pk2(sp[2 * 33], sp[3 * 33]); o.z = pk2(sp[4 * 33], sp[5 * 33]); o.w = pk2(sp[6 * 33], sp[7 * 33]);
        *(u32x4*)(WT + (size_t)(n0 + n) * ldk + k0 + 8 * c) = o; }
    asm volatile("s_waitcnt lgkmcnt(0)" ::: "memory");
}
struct TrJob { const float* W; int K, N; const float* gain; bf16_t* WT; int ldk; };
__device__ void prologue_weights(const Params& p, unsigned char* smem, int gw, int ngw, int wid, int lane) {
    unsigned char* ws = p.ws;
    float* scr = (float*)smem + wid * (64 * 33);
    const TrJob jobs[6] = {
        {p.w_in, DM, D_IN, p.norm_mix_pre, (bf16_t*)(ws + WS_WIN), DM},
        {p.w_out, DM, DM, nullptr, (bf16_t*)(ws + WS_WOUT), DM},
        {p.mem_wq, DM, DM, p.norm_mem_pre, (bf16_t*)(ws + WS_WQ), DM},
        {p.mem_wo, DM, DM, nullptr, (bf16_t*)(ws + WS_WO), DM},
        {p.mlp_w1, DM, DFF, p.norm_mlp_pre, (bf16_t*)(ws + WS_W1), DM},
        {p.mlp_w2, DFF, DM, nullptr, (bf16_t*)(ws + WS_W2), DFF}};
    int base = 0;
#pragma unroll
    for (int j = 0; j < 6; ++j) {
        const int items = (jobs[j].K / 64) * (jobs[j].N / 32);
        int first = gw - base; first = ((first % ngw) + ngw) % ngw;
        for (int it = first; it < items; it += ngw) transpose_item(jobs[j].W, jobs[j].N, jobs[j].gain, jobs[j].WT, jobs[j].ldk, scr, it, lane);
        base += items;
    }
    { u32x4* z = (u32x4*)((bf16_t*)(ws + WS_WIN) + (size_t)D_IN * DM); const int n16 = (ZLD - D_IN) * DM * 2 / 16;
      for (int i = gw * 64 + lane; i < n16; i += ngw * 64) z[i] = (u32x4){0u, 0u, 0u, 0u}; }
}

__device__ void mla_prep_rows(const Params& p, int gw, int ngw, int lane) {
    const bf16_t* Z = (const bf16_t*)(p.ws + WS_Z);
    bf16_t* CQ = (bf16_t*)(p.ws + WS_CQ); bf16_t* CKV = (bf16_t*)(p.ws + WS_CKV); bf16_t* KR = (bf16_t*)(p.ws + WS_KR);
    for (int r = gw; r < M; r += ngw) {
        const bf16_t* zr = Z + (long)r * ZLD;
        float q[4]; float s = 0.f;
#pragma unroll
        for (int j = 0; j < 4; ++j) { q[j] = bf2f(zr[ZC_CQ + 4 * lane + j]); s += q[j] * q[j]; }
        const float rq = rsqrtf(wave_sum(s) * (1.f / 256.f) + NORM_EPS);
#pragma unroll
        for (int j = 0; j < 4; ++j) CQ[(long)r * 256 + 4 * lane + j] = f2bf(q[j] * rq * p.mla_q_norm[4 * lane + j]);
        float c[2]; s = 0.f;
#pragma unroll
        for (int j = 0; j < 2; ++j) { c[j] = bf2f(zr[ZC_CKV + 2 * lane + j]); s += c[j] * c[j]; }
        const float rk = rsqrtf(wave_sum(s) * (1.f / 128.f) + NORM_EPS);
#pragma unroll
        for (int j = 0; j < 2; ++j) CKV[(long)r * 128 + 2 * lane + j] = f2bf(c[j] * rk * p.mla_kv_norm[2 * lane + j]);
        if (lane < 16) {
            const float x1 = bf2f(zr[ZC_KR + lane]), x2 = bf2f(zr[ZC_KR + 16 + lane]);
            const float inv_freq = powf(10000.f, -(float)(2 * lane) / 32.f);
            const float ang = (float)p.pos[r] * inv_freq; float sn, cs; sincosf(ang, &sn, &cs);
            KR[(long)r * 32 + lane] = f2bf(x1 * cs - x2 * sn); KR[(long)r * 32 + 16 + lane] = f2bf(x2 * cs + x1 * sn);
        }
    }
}

__device__ void rwkv_prep_rows(const Params& p, int gw, int ngw, int lane) {
    const bf16_t* Z = (const bf16_t*)(p.ws + WS_Z);
    bf16_t* RK = (bf16_t*)p.out;
    bf16_t* LIN = (bf16_t*)(p.ws + WS_LIN);
    for (int r = gw; r < M; r += ngw) {
        const int s = r % SEQ; const bool hp = s > 0, hn = s < SEQ - 1;
        const bf16_t* zc = Z + (long)r * ZLD;
        float val[3][8];
#pragma unroll
        for (int sec = 0; sec < 3; ++sec) {
            const int c0 = sec * 512 + 8 * lane;
#pragma unroll
            for (int j = 0; j < 8; ++j) {
                const int c = c0 + j;
                float a = p.conv_rwkv[RWKV_COLS + c] * bf2f(zc[c]);
                if (hp) a += p.conv_rwkv[c] * bf2f(zc[c - ZLD]);
                if (hn) a += p.conv_rwkv[2 * RWKV_COLS + c] * bf2f(zc[c + ZLD]);
                val[sec][j] = a;
            }
        }
        float kk[8]; float ss = 0.f;
#pragma unroll
        for (int j = 0; j < 8; ++j) { kk[j] = val[1][j] * p.rwkv_k_k[8 * lane + j]; ss += kk[j] * kk[j]; }
        ss += __shfl_xor(ss, 1); ss += __shfl_xor(ss, 2); ss += __shfl_xor(ss, 4);
        const float rn = rsqrtf(fmaxf(ss, 1e-24f));
#pragma unroll
        for (int j = 0; j < 8; ++j) {
            RK[(long)0 * M * RC + (long)r * RC + 8 * lane + j] = f2bf(val[0][j]);
            RK[(long)1 * M * RC + (long)r * RC + 8 * lane + j] = f2bf(val[1][j]);
            RK[(long)2 * M * RC + (long)r * RC + 8 * lane + j] = f2bf(val[2][j]);
            RK[(long)3 * M * RC + (long)r * RC + 8 * lane + j] = f2bf(kk[j] * rn);
        }
        if (lane < 56) {
#pragma unroll
            for (int j = 0; j < 4; ++j) {
                const int c = 1536 + 4 * lane + j;
                float a = p.conv_rwkv[RWKV_COLS + c] * bf2f(zc[c]);
                if (hp) a += p.conv_rwkv[c] * bf2f(zc[c - ZLD]);
                if (hn) a += p.conv_rwkv[2 * RWKV_COLS + c] * bf2f(zc[c + ZLD]);
                float o;
                if (c < ZC_XA) o = tanhf(a); else if (c < ZC_XG) o = a; else o = sigmoidf_(a);
                LIN[(long)r * 256 + 4 * lane + j] = f2bf(o);
            }
        } else {
#pragma unroll
            for (int j = 0; j < 4; ++j) LIN[(long)r * 256 + 4 * lane + j] = 0;
        }
    }
}

constexpr int SC_TB = 32;
constexpr int SC_VEC = SC_TB * 64 * 4;
constexpr int SC_BUF = 6 * SC_VEC + SC_TB * 32 * 4;
template <int CTRL> __device__ __forceinline__ float dpp_f(float v) { return __uint_as_float((unsigned)__builtin_amdgcn_update_dpp(0, (int)__float_as_uint(v), CTRL, 0xf, 0xf, true)); }
__device__ __forceinline__ float row16_sum(float x) {
    x += dpp_f<0x128>(x); x += dpp_f<0x124>(x); x += dpp_f<0x122>(x); x += dpp_f<0x121>(x); return x;
}
__device__ void rwkv_scan_block(const Params& p, unsigned char* smem, int job  ) {
    const int tid = threadIdx.x, lane = tid & 63, wid = tid >> 6, q = lane & 15, rho = lane >> 4;
    const int chain = job >> 1, half = job & 1;
    const int d = chain / (BATCH * RH), b = (chain / RH) % BATCH, h = chain % RH;
    const bf16_t* RK = (const bf16_t*)p.out;
    const bf16_t* Rr = RK, *Kk = RK + (long)M * RC, *Vv = RK + 2L * M * RC, *KK = RK + 3L * M * RC;
    const bf16_t* LW = (const bf16_t*)(p.ws + WS_LW) + (long)d * M * RC;
    const bf16_t* AA = (const bf16_t*)(p.ws + WS_AA) + (long)d * M * RC;
    float* O = (float*)(p.ws + WS_O01) + (long)d * M * RC;
    const int ps = tid >> 4, pc = (tid & 15) * 4;
    const f32x4 ka4 = *(const f32x4*)(p.rwkv_k_a + h * RN + pc);
    const int row_l = wid * 4 + rho;
    const int row_g = half * 32 + row_l;
    unsigned long long raw[6];
    auto load_raw = [&](int batch) {
        const int t = batch * SC_TB + ps, sidx = d ? (SEQ - 1 - t) : t;
        const long off = ((long)(b * SEQ + sidx)) * RC + h * RN + pc;
        raw[0] = *(const unsigned long long*)(Rr + off); raw[1] = *(const unsigned long long*)(Kk + off); raw[2] = *(const unsigned long long*)(Vv + off);
        raw[3] = *(const unsigned long long*)(KK + off); raw[4] = *(const unsigned long long*)(LW + off); raw[5] = *(const unsigned long long*)(AA + off);
    };
    auto un4 = [](unsigned long long w) { f32x4 v; const unsigned lo = (unsigned)w, hi = (unsigned)(w >> 32);
        v.x = __uint_as_float(lo << 16); v.y = __uint_as_float(lo & 0xffff0000u); v.z = __uint_as_float(hi << 16); v.w = __uint_as_float(hi & 0xffff0000u); return v; };
    auto store_batch = [&](unsigned char* buf) {
        const f32x4 r4 = un4(raw[0]), k4 = un4(raw[1]), v4 = un4(raw[2]), kk4 = un4(raw[3]), lw4 = un4(raw[4]), a4 = un4(raw[5]);
        f32x4 w4, an, bn, kd;
#pragma unroll
        for (int e = 0; e < 4; ++e) { w4[e] = __expf(lw4[e]); an[e] = -kk4[e]; bn[e] = kk4[e] * a4[e]; kd[e] = k4[e] * (1.f + (a4[e] - 1.f) * ka4[e]); }
        const int o = (ps * 64 + pc) * 4;
        *(f32x4*)(buf + 0 * SC_VEC + o) = w4; *(f32x4*)(buf + 1 * SC_VEC + o) = an; *(f32x4*)(buf + 2 * SC_VEC + o) = bn;
        *(f32x4*)(buf + 3 * SC_VEC + o) = kd; *(f32x4*)(buf + 4 * SC_VEC + o) = r4; *(f32x4*)(buf + 5 * SC_VEC + o) = v4;
    };
    float S0 = 0.f, S1 = 0.f, S2 = 0.f, S3 = 0.f;
    constexpr int NB = SEQ / SC_TB;
    __syncthreads();
    load_raw(0); store_batch(smem);
    __syncthreads();
    for (int bt = 0; bt < NB; ++bt) {
        unsigned char* cur = smem + (bt & 1) * SC_BUF; unsigned char* nxt = smem + ((bt + 1) & 1) * SC_BUF;
        if (bt + 1 < NB) load_raw(bt + 1);
        float* otile = (float*)(cur + 6 * SC_VEC);
#pragma unroll 4
        for (int s = 0; s < SC_TB; ++s) {
            const int vo = (s * 64 + 4 * q) * 4;
            const f32x4 w4 = *(const f32x4*)(cur + 0 * SC_VEC + vo), an = *(const f32x4*)(cur + 1 * SC_VEC + vo), bn = *(const f32x4*)(cur + 2 * SC_VEC + vo);
            const f32x4 kd = *(const f32x4*)(cur + 3 * SC_VEC + vo), r4 = *(const f32x4*)(cur + 4 * SC_VEC + vo);
            const float vv = *(const float*)(cur + 5 * SC_VEC + (s * 64 + row_g) * 4);
            float sa = (S0 * an.x + S1 * an.y) + (S2 * an.z + S3 * an.w);
            const float t0 = fmaf(vv, kd.x, S0 * w4.x), t1 = fmaf(vv, kd.y, S1 * w4.y), t2 = fmaf(vv, kd.z, S2 * w4.z), t3 = fmaf(vv, kd.w, S3 * w4.w);
            sa = row16_sum(sa);
            S0 = fmaf(sa, bn.x, t0); S1 = fmaf(sa, bn.y, t1); S2 = fmaf(sa, bn.z, t2); S3 = fmaf(sa, bn.w, t3);
            float o = (S0 * r4.x + S1 * r4.y) + (S2 * r4.z + S3 * r4.w);
            o = row16_sum(o);
            if (q == 0) otile[s * 32 + row_l] = o;
        }
        if (bt + 1 < NB) store_batch(nxt);
        __syncthreads();
        {
            const int t = bt * SC_TB + ps, sidx = d ? (SEQ - 1 - t) : t;
            const float2 ov = *(const float2*)(otile + ps * 32 + 2 * (tid & 15));
            *(float2*)(O + ((long)(b * SEQ + sidx)) * RC + h * RN + half * 32 + 2 * (tid & 15)) = ov;
        }
    }
}

__device__ void rwkv_combine_rows(const Params& p, int gw, int ngw, int lane) {
    const bf16_t* RK = (const bf16_t*)p.out;
    const bf16_t* Rr = RK, *Kk = RK + (long)M * RC, *Vv = RK + 2L * M * RC;
    const bf16_t* AA = (const bf16_t*)(p.ws + WS_AA); const bf16_t* G = (const bf16_t*)(p.ws + WS_G);
    const float* O = (const float*)(p.ws + WS_O01);
    bf16_t* YC = (bf16_t*)(p.ws + WS_YCAT);
    for (int r = gw; r < M; r += ngw) {
        const long off = (long)r * RC + 8 * lane;
        float o[8]; float s = 0.f;
#pragma unroll
        for (int j = 0; j < 8; ++j) { o[j] = O[off + j] + O[(long)M * RC + off + j]; s += o[j]; }
        s += __shfl_xor(s, 1); s += __shfl_xor(s, 2); s += __shfl_xor(s, 4);
        const float mu = s * (1.f / 64.f); float q = 0.f;
#pragma unroll
        for (int j = 0; j < 8; ++j) { o[j] -= mu; q += o[j] * o[j]; }
        q += __shfl_xor(q, 1); q += __shfl_xor(q, 2); q += __shfl_xor(q, 4);
        const float rstd = rsqrtf(q * (1.f / 64.f) + LNX_EPS);
        float bon = 0.f; float vv[8];
#pragma unroll
        for (int j = 0; j < 8; ++j) {
            const int c = 8 * lane + j;
            const float r_ = bf2f(Rr[off + j]), k_ = bf2f(Kk[off + j]); vv[j] = bf2f(Vv[off + j]);
            const float a0 = bf2f(AA[off + j]), a1 = bf2f(AA[(long)M * RC + off + j]); const float ka = p.rwkv_k_a[c];
            const float kd = k_ * (1.f + (a0 - 1.f) * ka) + k_ * (1.f + (a1 - 1.f) * ka);
            bon += r_ * kd * p.rwkv_r_k[c];
        }
        bon += __shfl_xor(bon, 1); bon += __shfl_xor(bon, 2); bon += __shfl_xor(bon, 4);
#pragma unroll
        for (int j = 0; j < 8; ++j) {
            const int c = 8 * lane + j;
            const float y = (o[j] * rstd * p.rwkv_lnx_w[c] + p.rwkv_lnx_b[c] + bon * vv[j]) * bf2f(G[off + j]);
            YC[(long)r * DM + c] = f2bf(y);
        }
    }
}

typedef float f32x16 __attribute__((ext_vector_type(16)));
typedef short v4i16_t __attribute__((ext_vector_type(4)));
#define LDSAS __attribute__((address_space(3)))
constexpr int ATT_KROW = 208;
constexpr int ATT_KBUF = 64 * ATT_KROW;
constexpr int ATT_VBUF = 8192;
constexpr int ATT_V0 = 2 * ATT_KBUF;
__device__ __forceinline__ unsigned cvtpk(float lo, float hi) { unsigned r; asm volatile("v_cvt_pk_bf16_f32 %0, %1, %2" : "=v"(r) : "v"(lo), "v"(hi)); return r; }
__device__ __forceinline__ void mla_attn_unit(const Params& p, unsigned char* smem, int unit) {
    const int tid = threadIdx.x, lane = tid & 63, wid = tid >> 6, r32 = lane & 31, hi = lane >> 5;
    const int b = unit / 64, hd = (unit / 8) % 8, qb = unit % 8;
    const bf16_t* Q = (const bf16_t*)(p.ws + WS_Q); const bf16_t* KV = (const bf16_t*)(p.ws + WS_KV); const bf16_t* KR = (const bf16_t*)(p.ws + WS_KR);
    bf16_t* YC = (bf16_t*)(p.ws + WS_YCAT);
    const long rowbase = (long)b * SEQ;
    const long qrow = rowbase + qb * 256 + wid * 32 + r32;
    bf16x8 qf[6];
    {
        float qv[6][8];
#pragma unroll
        for (int s6 = 0; s6 < 6; ++s6) { const u32x4 w = *(const u32x4*)(Q + qrow * 768 + hd * 96 + 16 * s6 + 8 * hi);
#pragma unroll
            for (int e = 0; e < 4; ++e) { qv[s6][2 * e] = __uint_as_float(w[e] << 16); qv[s6][2 * e + 1] = __uint_as_float(w[e] & 0xffff0000u); } }
        const float pos = (float)p.pos[qrow];
#pragma unroll
        for (int j = 0; j < 8; ++j) { const int i = 8 * hi + j; const float inv_freq = powf(10000.f, -(float)(2 * i) / 32.f); float sn, cs; sincosf(pos * inv_freq, &sn, &cs);
            const float x1 = qv[4][j], x2 = qv[5][j]; qv[4][j] = x1 * cs - x2 * sn; qv[5][j] = x2 * cs + x1 * sn; }
        const float sc = 0.10206207261596575f * 1.4426950408889634f;
#pragma unroll
        for (int s6 = 0; s6 < 6; ++s6) { u32x4 w;
#pragma unroll
            for (int e = 0; e < 4; ++e) w[e] = cvtpk(qv[s6][2 * e] * sc, qv[s6][2 * e + 1] * sc);
            qf[s6] = __builtin_bit_cast(bf16x8, w); }
    }
    const int srow = tid >> 3, sc8 = tid & 7;
    const int rrow = (tid & 255) >> 2, rc4 = tid & 3;
    const bf16_t* gK = KV + (rowbase + srow) * 1024 + hd * 128 + sc8 * 8;
    const bf16_t* gV = gK + 64;
    const bf16_t* gR = KR + (rowbase + rrow) * 32 + rc4 * 8;
    const int dK = srow * ATT_KROW + sc8 * 16;
    const int dV = (sc8 >> 2) * 4096 + (srow >> 3) * 512 + (srow & 7) * 64 + (sc8 & 3) * 16;
    const int dR = rrow * ATT_KROW + 128 + rc4 * 16;
    u32x4 stK, stV, stR;
    stK = *(const u32x4*)gK; stV = *(const u32x4*)gV; if (tid < 256) stR = *(const u32x4*)gR;
    __syncthreads();
    *(u32x4*)(smem + dK) = stK; *(u32x4*)(smem + ATT_V0 + dV) = stV; if (tid < 256) *(u32x4*)(smem + dR) = stR;
    __syncthreads();
    const int kbase = r32 * ATT_KROW + hi * 16;
    const int vbase = ATT_V0 + ((lane >> 4) & 1) * 32 + (lane & 3) * 8 + (4 * hi + ((lane & 15) >> 2)) * 64;
    f32x16 ot[2]; ot[0] = f32x16{}; ot[1] = f32x16{};
    float m = -1e30f, l = 0.f;
    constexpr int NT = SEQ / 64;
    for (int j = 0; j < NT; ++j) {
        const int cur = j & 1;
        if (j + 1 < NT) { const long o = (long)(j + 1) * 64; stK = *(const u32x4*)(gK + o * 1024); stV = *(const u32x4*)(gV + o * 1024); if (tid < 256) stR = *(const u32x4*)(gR + o * 32); }
        const unsigned char* Kb = smem + cur * ATT_KBUF;
        f32x16 p0 = f32x16{}, p1 = f32x16{};
#pragma unroll
        for (int s6 = 0; s6 < 6; ++s6) {
            const bf16x8 k0 = *(const bf16x8*)(Kb + kbase + s6 * 32);
            const bf16x8 k1 = *(const bf16x8*)(Kb + kbase + 32 * ATT_KROW + s6 * 32);
            p0 = __builtin_amdgcn_mfma_f32_32x32x16_bf16(k0, qf[s6], p0, 0, 0, 0);
            p1 = __builtin_amdgcn_mfma_f32_32x32x16_bf16(k1, qf[s6], p1, 0, 0, 0);
        }
        float mx = fmaxf(p0[0], p1[0]);
#pragma unroll
        for (int r = 1; r < 16; ++r) mx = fmaxf(mx, fmaxf(p0[r], p1[r]));
        mx = fmaxf(mx, __shfl_xor(mx, 32));
        const float mn = fmaxf(m, mx), alpha = __builtin_amdgcn_exp2f(m - mn);
        m = mn;
        float sum = 0.f;
#pragma unroll
        for (int r = 0; r < 16; ++r) { p0[r] = __builtin_amdgcn_exp2f(p0[r] - mn); p1[r] = __builtin_amdgcn_exp2f(p1[r] - mn); sum += p0[r] + p1[r]; }
        l = l * alpha + sum;
#pragma unroll
        for (int r = 0; r < 16; ++r) { ot[0][r] *= alpha; ot[1][r] *= alpha; }
        bf16x8 pw[4];
#pragma unroll
        for (int s2 = 0; s2 < 2; ++s2) {
            u32x4 w0, w1;
#pragma unroll
            for (int e = 0; e < 4; ++e) { w0[e] = cvtpk(p0[8 * s2 + 2 * e], p0[8 * s2 + 2 * e + 1]); w1[e] = cvtpk(p1[8 * s2 + 2 * e], p1[8 * s2 + 2 * e + 1]); }
            pw[s2] = __builtin_bit_cast(bf16x8, w0); pw[2 + s2] = __builtin_bit_cast(bf16x8, w1);
        }
        const LDSAS unsigned char* Vb = (const LDSAS unsigned char*)(smem) + vbase + cur * ATT_VBUF;
#pragma unroll
        for (int d0 = 0; d0 < 2; ++d0)
#pragma unroll
            for (int ks = 0; ks < 4; ++ks) {
                const v4i16_t lo = __builtin_amdgcn_ds_read_tr16_b64_v4i16((LDSAS v4i16_t*)(Vb + d0 * 4096 + ks * 1024));
                const v4i16_t hh = __builtin_amdgcn_ds_read_tr16_b64_v4i16((LDSAS v4i16_t*)(Vb + d0 * 4096 + ks * 1024 + 512));
                const bf16x8 vf = (bf16x8){lo[0], lo[1], lo[2], lo[3], hh[0], hh[1], hh[2], hh[3]};
                ot[d0] = __builtin_amdgcn_mfma_f32_32x32x16_bf16(vf, pw[ks], ot[d0], 0, 0, 0);
            }
        if (j + 1 < NT) {
            const int nb = cur ^ 1;
            *(u32x4*)(smem + nb * ATT_KBUF + dK) = stK; *(u32x4*)(smem + ATT_V0 + nb * ATT_VBUF + dV) = stV; if (tid < 256) *(u32x4*)(smem + nb * ATT_KBUF + dR) = stR;
        }
        __syncthreads();
    }
    l += __shfl_xor(l, 32);
    const float il = 1.f / l;
    bf16_t* orow = YC + qrow * DM + 512 + hd * 64 + 4 * hi;
#pragma unroll
    for (int d0 = 0; d0 < 2; ++d0)
#pragma unroll
        for (int g = 0; g < 4; ++g) {
            const unsigned lo = cvtpk(ot[d0][4 * g] * il, ot[d0][4 * g + 1] * il), hh = cvtpk(ot[d0][4 * g + 2] * il, ot[d0][4 * g + 3] * il);
            *(unsigned long long*)(orow + 32 * d0 + 8 * g) = (unsigned long long)lo | ((unsigned long long)hh << 32);
        }
}

__device__ void softmax_rows(const Params& p, int gw, int ngw, int lane) {
    const float* SC = (const float*)(p.ws + WS_SC); bf16_t* P = (bf16_t*)(p.ws + WS_P);
    for (int r = gw; r < 32 * SEQ; r += ngw) {
        const f32x4 v = ((const f32x4*)(SC + (long)r * 256))[lane];
        float mx = fmaxf(fmaxf(v.x, v.y), fmaxf(v.z, v.w));
#pragma unroll
        for (int o = 1; o < 64; o <<= 1) mx = fmaxf(mx, __shfl_xor(mx, o));
        const float e0 = __expf(v.x - mx), e1 = __expf(v.y - mx), e2 = __expf(v.z - mx), e3 = __expf(v.w - mx);
        const float inv = 1.f / wave_sum(e0 + e1 + e2 + e3);
        ((unsigned long long*)(P + (long)r * 256))[lane] = (unsigned long long)pk2(e0 * inv, e1 * inv) | ((unsigned long long)pk2(e2 * inv, e3 * inv) << 32);
    }
}

constexpr int NTHREADS = 512;
constexpr int LDS_BYTES = 147456;

template <class Pol>
__device__ __forceinline__ void big_gemm(unsigned char* smem, const bf16_t* A, int lda, const bf16_t* Bt, int ldb, int Mm, int Nn, int K, const Pol pol) {
    pg8::Gemm g{A, Bt, lda, ldb, K}; pg8::StaticOrder S; S.init(Mm, Nn, (int)gridDim.x, (int)blockIdx.x);
    pg8::EpiStore8<Pol> E{pol};
    pg8::gemm_phase<pg8::EpiStore8<Pol>, pg8::StaticOrder, true, true>((PG8_LAS unsigned char*)smem, g, S, E);
}

template <int PH>
__device__ __forceinline__ void run_phase(const Params& p, unsigned char* smem, int bid, int nblk) {
    const int tid = threadIdx.x, lane = tid & 63, wid = tid >> 6;
    const int gw = bid * (NTHREADS / 64) + wid, ngw = nblk * (NTHREADS / 64);
    unsigned char* ws = p.ws;
    if constexpr (PH == 0) {
        prologue_weights(p, smem, gw, ngw, wid, lane);
        norm_rows_bf16(p.x, nullptr, (bf16_t*)(ws + WS_XN), M, gw, ngw, lane);
    } else if constexpr (PH == 1) {
        big_gemm(smem, (const bf16_t*)(ws + WS_XN), DM, (const bf16_t*)(ws + WS_WIN), DM, M, ZLD, DM, pg8::StBf16{(bf16_t*)(ws + WS_Z), ZLD});
    } else if constexpr (PH == 2) {
        mla_prep_rows(p, gw, ngw, lane);
    } else if constexpr (PH == 3) {
        { GemmDesc g{(const bf16_t*)(ws + WS_CQ), 256, 0, 0, p.mla_w_uq, 768, 0, 0, M, 768, 256, 1, 1};
          bf16_t* Q = (bf16_t*)(ws + WS_Q);
          gemm_simple<0>(g, [=](int, int r, int c, float v) { Q[(long)r * 768 + c] = f2bf(v); }, smem, bid, nblk); }
        { GemmDesc g{(const bf16_t*)(ws + WS_CKV), 128, 0, 0, p.mla_w_ukv, 1024, 0, 0, M, 1024, 128, 1, 1};
          bf16_t* KV = (bf16_t*)(ws + WS_KV);
          gemm_simple<0>(g, [=](int, int r, int c, float v) { KV[(long)r * 1024 + c] = f2bf(v); }, smem, bid, nblk); }
    } else if constexpr (PH == 4) {
        { const int vcu = (nblk % 8 == 0) ? (bid % 8) * (nblk / 8) + bid / 8 : bid;
          for (int u = vcu * 2; u < 512; u += nblk * 2) { mla_attn_unit(p, smem, u); if (u + 1 < 512) mla_attn_unit(p, smem, u + 1); } }
    } else if constexpr (PH == 5) {
        rwkv_prep_rows(p, gw, ngw, lane);
    } else if constexpr (PH == 6) {
        const bf16_t* LIN = (const bf16_t*)(ws + WS_LIN);
        for (int d = 0; d < 2; ++d) {
            { GemmDesc g{LIN + 32 * d, 256, 0, 0, p.rwkv_w2 + (long)d * 32 * RC, RC, 0, 0, M, RC, 32, 1, 1};
              bf16_t* LW = (bf16_t*)(ws + WS_LW) + (long)d * M * RC; const float* w0 = p.rwkv_w0 + d * RC;
              gemm_simple<0>(g, [=](int, int r, int c, float v) {
                  const float xx = -(w0[c] + v);
                  const float sp = fmaxf(xx, 0.f) + log1pf(__expf(-fabsf(xx)));
                  LW[(long)r * RC + c] = f2bf(-__expf(-sp - 0.5f)); }, smem, bid, nblk); }
            { GemmDesc g{LIN + 64 + 32 * d, 256, 0, 0, p.rwkv_a2 + (long)d * 32 * RC, RC, 0, 0, M, RC, 32, 1, 1};
              bf16_t* AA = (bf16_t*)(ws + WS_AA) + (long)d * M * RC; const float* a0 = p.rwkv_a0 + d * RC;
              gemm_simple<0>(g, [=](int, int r, int c, float v) { AA[(long)r * RC + c] = f2bf(sigmoidf_(a0[c] + v)); }, smem, bid, nblk); }
        }
        { GemmDesc g{LIN + 128, 256, 0, 0, p.rwkv_g2, RC, 0, 0, M, RC, 96, 1, 1};
          bf16_t* G = (bf16_t*)(ws + WS_G);
          gemm_simple<0>(g, [=](int, int r, int c, float v) { G[(long)r * RC + c] = f2bf(v); }, smem, bid, nblk); }
    } else if constexpr (PH == 7) {
        for (int j = bid; j < 2 * 2 * BATCH * RH; j += nblk) rwkv_scan_block(p, smem, j);
    } else if constexpr (PH == 8) {
        rwkv_combine_rows(p, gw, ngw, lane);
    } else if constexpr (PH == 9) {
        big_gemm(smem, (const bf16_t*)(ws + WS_YCAT), DM, (const bf16_t*)(ws + WS_WOUT), DM, M, DM, DM, pg8::StBf16{(bf16_t*)(ws + WS_Y), DM});
    } else if constexpr (PH == 10) {
        resid_norm_rows(p.x, (const bf16_t*)(ws + WS_Y), p.norm_mix_post, p.out, (bf16_t*)(ws + WS_XN), gw, ngw, lane);
        norm_rows_bf16(p.mem, p.norm_memtok, (bf16_t*)(ws + WS_MN), BATCH * MEMT, gw, ngw, lane);
    } else if constexpr (PH == 11) {
        big_gemm(smem, (const bf16_t*)(ws + WS_XN), DM, (const bf16_t*)(ws + WS_WQ), DM, M, DM, DM, pg8::StBf16{(bf16_t*)(ws + WS_QM), DM});
        { GemmDesc g{(const bf16_t*)(ws + WS_MN), DM, 0, 0, p.mem_wkv, 2048, 0, 0, BATCH * MEMT, 2048, DM, 1, 1};
          bf16_t* KVM = (bf16_t*)(ws + WS_KVM);
          gemm_simple<0>(g, [=](int, int r, int c, float v) { KVM[(long)r * 2048 + c] = f2bf(v); }, smem, bid, nblk); }
    } else if constexpr (PH == 12) {
        GemmDesc g{(const bf16_t*)(ws + WS_QM), DM, (long)SEQ * DM, MEMD, (const bf16_t*)(ws + WS_KVM), 2048, (long)MEMT * 2048, MEMD, SEQ, MEMT, MEMD, BATCH * MEMH, MEMH};
        float* SC = (float*)(ws + WS_SC);
        gemm_simple<2>(g, [=](int bi, int r, int c, float v) { SC[((long)bi * SEQ + r) * MEMT + c] = v * 0.0625f; }, smem, bid, nblk);
    } else if constexpr (PH == 13) {
        softmax_rows(p, gw, ngw, lane);
    } else if constexpr (PH == 14) {
        GemmDesc g{(const bf16_t*)(ws + WS_P), MEMT, (long)MEMH * SEQ * MEMT, (long)SEQ * MEMT, (const bf16_t*)(ws + WS_KVM) + 1024, 2048, (long)MEMT * 2048, MEMD, SEQ, MEMD, MEMT, BATCH * MEMH, MEMH};
        bf16_t* OM = (bf16_t*)(ws + WS_OM);
        gemm_simple<1>(g, [=](int bi, int r, int c, float v) { OM[((long)(bi / MEMH) * SEQ + r) * DM + (bi % MEMH) * MEMD + c] = f2bf(v); }, smem, bid, nblk);
    } else if constexpr (PH == 15) {
        big_gemm(smem, (const bf16_t*)(ws + WS_OM), DM, (const bf16_t*)(ws + WS_WO), DM, M, DM, DM, pg8::StBf16{(bf16_t*)(ws + WS_Y), DM});
    } else if constexpr (PH == 16) {
        resid_norm_rows(p.out, (const bf16_t*)(ws + WS_Y), p.norm_mem_post, p.out, (bf16_t*)(ws + WS_XN), gw, ngw, lane);
    } else if constexpr (PH == 17) {
        big_gemm(smem, (const bf16_t*)(ws + WS_XN), DM, (const bf16_t*)(ws + WS_W1), DM, M, DFF, DM, pg8::StRelu2{(bf16_t*)(ws + WS_HID), DFF});
    } else if constexpr (PH == 18) {
        big_gemm(smem, (const bf16_t*)(ws + WS_HID), DFF, (const bf16_t*)(ws + WS_W2), DFF, M, DM, DFF, pg8::StBf16{(bf16_t*)(ws + WS_Y), DM});
    } else if constexpr (PH == 19) {
        resid_norm_rows(p.out, (const bf16_t*)(ws + WS_Y), p.norm_mlp_post, p.out, nullptr, gw, ngw, lane);
    }
}

template <int PH> __device__ __forceinline__ void run_all(const Params& p, unsigned char* smem, cg::grid_group& grid) {
    run_phase<PH>(p, smem, blockIdx.x, gridDim.x);
    if constexpr (PH + 1 < 20) { grid.sync(); run_all<PH + 1>(p, smem, grid); }
}
__global__ void __launch_bounds__(NTHREADS, 2) mega_kernel(Params p) {
    extern __shared__ __attribute__((aligned(16))) unsigned char smem[];
    cg::grid_group grid = cg::this_grid();
    run_all<0>(p, smem, grid);
}

extern "C" void kernel_launch(void* const* d_in, const int* in_sizes, int n_in, void* d_out, int out_size, void* d_ws, size_t ws_size, hipStream_t stream) {
    static int grid_blocks = 0;
    if (!grid_blocks) {
        int dev = 0, cus = 0, per_cu = 0;
        (void)hipFuncSetAttribute((const void*)mega_kernel, hipFuncAttributeMaxDynamicSharedMemorySize, LDS_BYTES);
        (void)hipGetDevice(&dev);
        (void)hipDeviceGetAttribute(&cus, hipDeviceAttributeMultiprocessorCount, dev);
        (void)hipOccupancyMaxActiveBlocksPerMultiprocessor(&per_cu, mega_kernel, NTHREADS, LDS_BYTES);
        if (per_cu < 1) per_cu = 1;
        grid_blocks = cus * per_cu;
        fprintf(stderr, "kernel_launch: cus=%d per_cu=%d grid=%d\n", cus, per_cu, grid_blocks);
    }
    Params p{};
    p.x = (const float*)d_in[0]; p.mem = (const float*)d_in[1]; p.pos = (const int*)d_in[2];
    const float** f = &p.norm_mix_pre;
    for (int i = 0; i < 29; ++i) f[i] = (const float*)d_in[3 + i];
    p.out = (float*)d_out; p.ws = (unsigned char*)d_ws;
    void* args[] = {&p};
    hipError_t e = hipLaunchCooperativeKernel((void*)mega_kernel, dim3(grid_blocks), dim3(NTHREADS), args, LDS_BYTES, stream);
    if (e != hipSuccess) fprintf(stderr, "cooperative launch failed: %s (grid %d)\n", hipGetErrorString(e), grid_blocks);
}
```

```cpp
#include <hip/hip_runtime.h>
#include <hip/hip_cooperative_groups.h>
namespace cg = cooperative_groups;
#include <cstdio>
#include <cstdint>

typedef unsigned short bf16_t;
typedef short bf16x8 __attribute__((ext_vector_type(8)));
typedef float f32x4 __attribute__((ext_vector_type(4)));
typedef unsigned u32x4 __attribute__((ext_vector_type(4)));

constexpr int BATCH = 8, SEQ = 2048, DM = 1024, M = BATCH * SEQ;
constexpr int RH = 8, RN = 64, RC = 512;
constexpr int RWKV_COLS = 1760, MLA_COLS = 416, D_IN = 2176;
constexpr int ZC_XW = 1536, ZC_XA = 1600, ZC_XG = 1664;
constexpr int ZC_CQ = 1760, ZC_CKV = 2016, ZC_KR = 2144;
constexpr int MH = 8, NOPE = 64, ROPE = 32, VD = 64, QKD = 96;
constexpr int MEMT = 256, MEMH = 4, MEMD = 256;
constexpr int DFF = 4096;
constexpr float NORM_EPS = 1e-6f, LNX_EPS = 64e-5f;

constexpr size_t MiB = 1u << 20;
constexpr int ZLD = 2304;
constexpr size_t WS_WIN  = 0;
constexpr size_t WS_WOUT = 5 * MiB;
constexpr size_t WS_WQ   = 7 * MiB;
constexpr size_t WS_WKV  = 9 * MiB;
constexpr size_t WS_WO   = 13 * MiB;
constexpr size_t WS_W1   = 15 * MiB;
constexpr size_t WS_W2   = 23 * MiB;
constexpr size_t WS_WUQ  = 31 * MiB;
constexpr size_t WS_WUKV = 31 * MiB + 512 * 1024;
constexpr size_t WS_WLG  = 32 * MiB;
constexpr size_t WS_XN   = 34 * MiB;
constexpr size_t WS_Z    = 66 * MiB;
constexpr size_t WS_YCAT = 138 * MiB;
constexpr size_t WS_CQ   = 170 * MiB;
constexpr size_t WS_CKV  = 178 * MiB;
constexpr size_t WS_KR   = 186 * MiB;
constexpr size_t WS_Q    = 188 * MiB;
constexpr size_t WS_KV   = 212 * MiB;
constexpr size_t WS_LIN  = 170 * MiB;
constexpr size_t WS_LW   = 178 * MiB;
constexpr size_t WS_AA   = 210 * MiB;
constexpr size_t WS_G    = 34 * MiB;
constexpr size_t WS_O01  = 66 * MiB;
constexpr size_t WS_Y    = 66 * MiB;
constexpr size_t WS_QM   = 98 * MiB;
constexpr size_t WS_MN   = 130 * MiB;
constexpr size_t WS_KVM  = 134 * MiB;
constexpr size_t WS_SC   = 142 * MiB;
constexpr size_t WS_P    = 206 * MiB;
constexpr size_t WS_OM   = 98 * MiB;
constexpr size_t WS_HID  = 98 * MiB;

struct Params {
    const float* x; const float* mem; const int* pos;
    const float *norm_mix_pre, *w_in, *conv_rwkv, *rwkv_w0, *rwkv_w2, *rwkv_a0, *rwkv_a2, *rwkv_g2, *rwkv_k_k, *rwkv_k_a, *rwkv_r_k,
                *rwkv_lnx_w, *rwkv_lnx_b, *mla_q_norm, *mla_w_uq, *mla_kv_norm, *mla_w_ukv, *w_out, *norm_mix_post, *norm_mem_pre,
                *norm_memtok, *mem_wq, *mem_wkv, *mem_wo, *norm_mem_post, *norm_mlp_pre, *mlp_w1, *mlp_w2, *norm_mlp_post;
    float* out; unsigned char* ws;
};

__device__ __forceinline__ float bf2f(bf16_t v) { return __uint_as_float((unsigned)v << 16); }
__device__ __forceinline__ bf16_t f2bf(float f) { unsigned u = __float_as_uint(f); return (bf16_t)((u + 0x7fffu + ((u >> 16) & 1u)) >> 16); }
__device__ __forceinline__ unsigned pk2(float lo, float hi) { return (unsigned)f2bf(lo) | ((unsigned)f2bf(hi) << 16); }
template <int CTRL> __device__ __forceinline__ float dpp_f(float v) { return __uint_as_float((unsigned)__builtin_amdgcn_update_dpp(0, (int)__float_as_uint(v), CTRL, 0xf, 0xf, true)); }
__device__ __forceinline__ float row16_sum(float x) {
    x += dpp_f<0x128>(x); x += dpp_f<0x124>(x); x += dpp_f<0x122>(x); x += dpp_f<0x121>(x); return x;
}
__device__ __forceinline__ float row16_max(float x) {
    x = fmaxf(x, dpp_f<0x128>(x)); x = fmaxf(x, dpp_f<0x124>(x)); x = fmaxf(x, dpp_f<0x122>(x)); x = fmaxf(x, dpp_f<0x121>(x)); return x;
}
__device__ __forceinline__ float wave_sum(float v) {
    v = row16_sum(v);
    { auto r = __builtin_amdgcn_permlane16_swap(__float_as_uint(v), __float_as_uint(v), false, false); v = __uint_as_float(r[0]) + __uint_as_float(r[1]); }
    { auto r = __builtin_amdgcn_permlane32_swap(__float_as_uint(v), __float_as_uint(v), false, false); v = __uint_as_float(r[0]) + __uint_as_float(r[1]); }
    return v;
}
__device__ __forceinline__ float wave_max(float v) {
    v = row16_max(v);
    { auto r = __builtin_amdgcn_permlane16_swap(__float_as_uint(v), __float_as_uint(v), false, false); v = fmaxf(__uint_as_float(r[0]), __uint_as_float(r[1])); }
    { auto r = __builtin_amdgcn_permlane32_swap(__float_as_uint(v), __float_as_uint(v), false, false); v = fmaxf(__uint_as_float(r[0]), __uint_as_float(r[1])); }
    return v;
}
__device__ __forceinline__ float oct_sum(float x) {
    x += dpp_f<0xB1>(x); x += dpp_f<0x4E>(x); x += dpp_f<0x141>(x); return x;
}
__device__ __forceinline__ float half_sum32(float v) { auto r = __builtin_amdgcn_permlane32_swap(__float_as_uint(v), __float_as_uint(v), false, false); return __uint_as_float(r[0]) + __uint_as_float(r[1]); }
__device__ __forceinline__ float half_max32(float v) { auto r = __builtin_amdgcn_permlane32_swap(__float_as_uint(v), __float_as_uint(v), false, false); return fmaxf(__uint_as_float(r[0]), __uint_as_float(r[1])); }
__device__ __forceinline__ int make_tid(int wid_s) { int l; asm volatile("v_mbcnt_lo_u32_b32 %0, -1, 0\n\tv_mbcnt_hi_u32_b32 %0, -1, %0" : "=v"(l)); return wid_s * 64 + l; }
__device__ __forceinline__ float sigmoidf_(float x) { return 1.f / (1.f + __expf(-x)); }
__device__ __forceinline__ float rdlane(float v, int k) { return __uint_as_float((unsigned)__builtin_amdgcn_readlane((int)__float_as_uint(v), k)); }

namespace pg8 {
#define PG8_LAS __attribute__((address_space(3)))
typedef unsigned short bf16_t;
typedef short bf16x8 __attribute__((ext_vector_type(8)));
typedef float f32x4 __attribute__((ext_vector_type(4)));
typedef unsigned u32x4 __attribute__((ext_vector_type(4)));
constexpr int BM = 256, BK = 64, HALF = 128, HTB = HALF * BK * 2  , STAGE_BYTES = 8 * HTB, NXCD = 8, WGM = 8;

__host__ __device__ __forceinline__ int lds_byte(int r, int c) { const int st = (r >> 4) * 2 + (c >> 5), rr = r & 15, cc = c & 31, ob = rr * 64 + cc * 2; return st * 1024 + (ob ^ (((ob >> 9) & 1) << 5)); }
__host__ __device__ __forceinline__ void stage_rc(int b, int& R, int& C) { const int st = b / 1024, sb = b % 1024, swz = sb ^ (((sb >> 9) & 1) << 5); R = (st >> 1) * 16 + swz / 64; C = (st & 1) * 32 + (swz % 64) / 2; }
__host__ __device__ __forceinline__ int perm32(int rho) { const int n = rho >> 4, i = rho & 15; return 8 * (i >> 2) + 4 * n + (i & 3); }

struct Unit { int pm, pn, bi; };
struct Gemm { const bf16_t* A; const bf16_t* Bt; int lda, ldb, K; };

struct StaticOrder {
    int nM, nN, nwg, G, c;
    __host__ __device__ void init(int M, int N, int G_, int c_) { nM = M / BM; nN = N / BM; nwg = nM * nN; G = G_; c = c_; }
    __host__ __device__ bool next(int i, Unit& u) const {
        const long L = (long)i * G + c; if (L >= nwg) return false;
        int wgid = (int)L; { const int q = nwg / NXCD, r = nwg % NXCD, xcd = wgid % NXCD, off = wgid / NXCD; wgid = (xcd < r ? xcd * (q + 1) : r * (q + 1) + (xcd - r) * q) + off; }
        const int nig = WGM * nN, gid = wgid / nig, fm = gid * WGM, gsz = (nM - fm) < WGM ? (nM - fm) : WGM;
        u.pm = fm + ((wgid % nig) % gsz); u.pn = (wgid % nig) / gsz; u.bi = 0; return true;
    }
    __device__ __forceinline__ const char* a_ptr(const Gemm& g, const Unit& u) const { return (const char*)(g.A + (size_t)u.pm * BM * g.lda); }
    __device__ __forceinline__ const char* b_ptr(const Gemm& g, const Unit& u) const { return (const char*)(g.Bt + (size_t)u.pn * BM * g.ldb); }
    __device__ __forceinline__ void a_ready(const Unit&) const {}
    __device__ __forceinline__ void done(const Unit&) const {}
};

__device__ __forceinline__ unsigned cvt_pk_bf16(float lo, float hi) { unsigned r; asm volatile("v_cvt_pk_bf16_f32 %0, %1, %2" : "=v"(r) : "v"(lo), "v"(hi)); return r; }
typedef float f32x2 __attribute__((ext_vector_type(2)));


template <class P> struct EpiStore8 {
    static constexpr bool PERM = true, AFTER_DRAIN = false;
    P pol;
    __device__ __forceinline__ void operator()(const f32x4 (&acc)[2][2][4][2], const Unit& u, int wr, int wc, int fr, int fq) const {
        const int row0 = u.pm * BM + wr * 64 + fr, col0 = u.pn * BM + wc * 32 + 8 * fq;
#pragma unroll
        for (int ai = 0; ai < 2; ++ai)
#pragma unroll
            for (int m = 0; m < 4; ++m)
#pragma unroll
                for (int bj = 0; bj < 2; ++bj) pol.store8(u, row0 + ai * HALF + m * 16, col0 + bj * HALF, acc[ai][bj][m][0], acc[ai][bj][m][1]);
    }
};
__device__ __forceinline__ u32x4 pack8(const f32x4& v0, const f32x4& v1) { u32x4 w; w.x = cvt_pk_bf16(v0[0], v0[1]); w.y = cvt_pk_bf16(v0[2], v0[3]); w.z = cvt_pk_bf16(v1[0], v1[1]); w.w = cvt_pk_bf16(v1[2], v1[3]); return w; }
struct StBf16 { bf16_t* O; int ldc;
    __device__ __forceinline__ void store8(const Unit&, int row, int col, const f32x4& v0, const f32x4& v1) const { *(u32x4*)(O + (size_t)row * ldc + col) = pack8(v0, v1); } };
struct StRelu2 { bf16_t* O; int ldc;
    __device__ __forceinline__ void store8(const Unit&, int row, int col, f32x4 v0, f32x4 v1) const {
#pragma unroll
        for (int e = 0; e < 4; ++e) { const float a = fmaxf(v0[e], 0.f), b = fmaxf(v1[e], 0.f); v0[e] = a * a; v1[e] = b * b; }
        *(u32x4*)(O + (size_t)row * ldc + col) = pack8(v0, v1); } };
struct BatchOrder {
    int nM, nN, nb, nh, G, c; long sAb, sAh, sBb, sBh;
    __device__ __forceinline__ bool next(int i, Unit& u) const {
        const long L = (long)i * G + c; if (L >= (long)nM * nN * nb) return false;
        const int per = nM * nN; u.bi = (int)(L / per); const int r = (int)(L % per); u.pn = r / nM; u.pm = r % nM; return true;
    }
    __device__ __forceinline__ const char* a_ptr(const Gemm& g, const Unit& u) const { return (const char*)(g.A + (size_t)(u.bi / nh) * sAb + (size_t)(u.bi % nh) * sAh + (size_t)u.pm * BM * g.lda); }
    __device__ __forceinline__ const char* b_ptr(const Gemm& g, const Unit& u) const { return (const char*)(g.Bt + (size_t)(u.bi / nh) * sBb + (size_t)(u.bi % nh) * sBh + (size_t)u.pn * BM * g.ldb); }
    __device__ __forceinline__ void a_ready(const Unit&) const {}
    __device__ __forceinline__ void done(const Unit&) const {}
};
struct StLora { bf16_t* LW; bf16_t* AA; bf16_t* G; int Mrows;
    __device__ __forceinline__ void store8(const Unit&, int row, int col, const f32x4& v0, const f32x4& v1) const {
        bf16_t* dst = (col < 1024) ? LW + ((size_t)(col >> 9) * Mrows + row) * 512 + (col & 511)
                    : (col < 2048) ? AA + ((size_t)((col - 1024) >> 9) * Mrows + row) * 512 + (col & 511)
                                   : G + (size_t)row * 512 + (col - 2048);
        *(u32x4*)dst = pack8(v0, v1);
    } };
struct StScoreF32 { float* SC; int rows, cols; float scale;
    __device__ __forceinline__ void store8(const Unit& u, int row, int col, const f32x4& v0, const f32x4& v1) const {
        float* o = SC + ((size_t)u.bi * rows + row) * cols + col; *(f32x4*)o = v0 * scale; *(f32x4*)(o + 4) = v1 * scale; } };
struct StBatchBf16 { bf16_t* O; int rows, cols, nh, ldc;
    __device__ __forceinline__ void store8(const Unit& u, int row, int col, const f32x4& v0, const f32x4& v1) const {
        *(u32x4*)(O + ((size_t)(u.bi / nh) * rows + row) * ldc + (u.bi % nh) * cols + col) = pack8(v0, v1); } };
template <class Epi, class Sched, bool ALIGN_EPI = false, bool SP2 = false>
__device__ __forceinline__ void gemm_phase(PG8_LAS unsigned char* lds, const Gemm g, const Sched& S, const Epi& E, const int tid) {
    const int wid = __builtin_amdgcn_readfirstlane(tid >> 6), lane = tid & 63, wr = wid >> 2, wc = wid & 3, fr = lane & 15, fq = lane >> 4;
    const int K = g.K, nt = K / BK;
    unsigned voffA[2], voffB[2];
#pragma unroll
    for (int i = 0; i < 2; ++i) { int R, C; stage_rc(tid * 16 + i * 8192, R, C); const int Rb = Epi::PERM ? ((R & ~31) + perm32(R & 31)) : R;
        voffA[i] = (unsigned)(R * g.lda + C) * 2u; voffB[i] = (unsigned)(Rb * g.ldb + C) * 2u; }
    const size_t kstep = (size_t)(BK * 2);
    const size_t hstepA = (size_t)HALF * g.lda * 2, hstepB = (size_t)HALF * g.ldb * 2;
    const unsigned ldsw = (unsigned)wid * 1024u;
    const int aoff = lds_byte(wr * 64 + fr, fq * 8), boff = lds_byte(wc * 32 + fr, fq * 8);
#define PG8_SA(b, h) (((b) * 2 + (h)) * HTB)
#define PG8_SB(b, h) ((4 + (b) * 2 + (h)) * HTB)
#define PG8_STAGE(bufoff, gbase, voff) do { _Pragma("unroll") for (int _i = 0; _i < 2; ++_i) \
        __builtin_amdgcn_global_load_lds((const unsigned*)((const char*)(gbase) + (voff)[_i]), (PG8_LAS unsigned*)(lds + (bufoff) + ldsw + _i * 8192), 16, 0, 0); } while (0)
#define PG8_LDA(dst, b, h) do { _Pragma("unroll") for (int m = 0; m < 4; ++m) _Pragma("unroll") for (int k = 0; k < 2; ++k) dst[m][k] = *(const PG8_LAS bf16x8*)(lds + PG8_SA(b, h) + aoff + m * 2048 + k * 1024); } while (0)
#define PG8_LDB(dst, b, h) do { _Pragma("unroll") for (int n = 0; n < 2; ++n) _Pragma("unroll") for (int k = 0; k < 2; ++k) dst[n][k] = *(const PG8_LAS bf16x8*)(lds + PG8_SB(b, h) + boff + n * 2048 + k * 1024); } while (0)
#define PG8_MMA(ai, bj, At, Bt) do { __builtin_amdgcn_s_setprio(1); _Pragma("unroll") for (int m = 0; m < 4; ++m) _Pragma("unroll") for (int n = 0; n < 2; ++n) _Pragma("unroll") for (int k = 0; k < 2; ++k) \
        acc[ai][bj][m][n] = __builtin_amdgcn_mfma_f32_16x16x32_bf16(Bt[n][k], At[m][k], acc[ai][bj][m][n], 0, 0, 0); __builtin_amdgcn_s_setprio(0); } while (0)
#define PG8_WAIT_V(n) asm volatile("s_waitcnt vmcnt(" #n ")" ::: "memory")
#define PG8_WAIT_L(n) asm volatile("s_waitcnt lgkmcnt(" #n ")" ::: "memory")
#define PG8_BAR __builtin_amdgcn_s_barrier()
#define PG8_SCHED __builtin_amdgcn_sched_barrier(0)
    Unit cur, nxt; int ui = 0;
    if (!S.next(0, cur)) return;
    f32x4 acc[2][2][4][2];
#pragma unroll
    for (int a = 0; a < 2; ++a)
#pragma unroll
        for (int b = 0; b < 2; ++b)
#pragma unroll
            for (int m = 0; m < 4; ++m)
#pragma unroll
                for (int n = 0; n < 2; ++n) acc[a][b][m][n] = (f32x4){0.f, 0.f, 0.f, 0.f};
    bf16x8 At[4][2], B0[2][2], B1[2][2];
    const char* cA = S.a_ptr(g, cur); const char* cB = S.b_ptr(g, cur);
    S.a_ready(cur);
    if constexpr (SP2) {
        PG8_STAGE(PG8_SB(0, 0), cB, voffB); PG8_STAGE(PG8_SB(0, 1), cB + hstepB, voffB); PG8_STAGE(PG8_SA(0, 0), cA, voffA); PG8_STAGE(PG8_SA(0, 1), cA + hstepA, voffA);
        if (wr == 1) PG8_BAR;
        PG8_WAIT_V(2); PG8_BAR;
        PG8_STAGE(PG8_SB(1, 0), cB + kstep, voffB); PG8_STAGE(PG8_SA(1, 0), cA + kstep, voffA); PG8_STAGE(PG8_SB(1, 1), cB + hstepB + kstep, voffB);
        PG8_WAIT_V(6); PG8_BAR;
    } else {
        PG8_STAGE(PG8_SB(0, 0), cB, voffB); PG8_STAGE(PG8_SA(0, 0), cA, voffA); PG8_STAGE(PG8_SB(0, 1), cB + hstepB, voffB); PG8_STAGE(PG8_SA(0, 1), cA + hstepA, voffA);
        if (wr == 1) PG8_BAR;
        PG8_WAIT_V(4); PG8_BAR;
        PG8_STAGE(PG8_SB(1, 0), cB + kstep, voffB); PG8_STAGE(PG8_SA(1, 0), cA + kstep, voffA); PG8_STAGE(PG8_SB(1, 1), cB + hstepB + kstep, voffB);
        PG8_WAIT_V(6); PG8_BAR;
    }
    for (;;) {
        const bool has_next = S.next(ui + 1, nxt);
        const char* nA = has_next ? S.a_ptr(g, nxt) : cA; const char* nB = has_next ? S.b_ptr(g, nxt) : cB;
        for (int t = 0; t < nt; t += 2) {
            const bool last = (t == nt - 2);
            const char* a1 = cA + (size_t)(t + 1) * kstep;
            const char* a2 = last ? nA : cA + (size_t)(t + 2) * kstep; const char* b2 = last ? nB : cB + (size_t)(t + 2) * kstep;
            const char* a3 = a2 + kstep; const char* b3 = b2 + kstep;
            if (last && has_next) S.a_ready(nxt);
            if constexpr (SP2) {
            PG8_LDB(B0, 0, 0); PG8_LDB(B1, 0, 1); PG8_SCHED; PG8_LDA(At, 0, 0); PG8_STAGE(PG8_SA(1, 1), a1 + hstepA, voffA);
            PG8_WAIT_V(8); PG8_WAIT_L(0); PG8_BAR; PG8_MMA(0, 0, At, B0); PG8_MMA(0, 1, At, B1); PG8_BAR; PG8_SCHED;
            PG8_LDA(At, 0, 1); PG8_STAGE(PG8_SB(0, 0), b2, voffB); PG8_STAGE(PG8_SB(0, 1), b2 + hstepB, voffB); PG8_STAGE(PG8_SA(0, 0), a2, voffA);
            PG8_WAIT_V(8); PG8_WAIT_L(0); PG8_BAR; PG8_MMA(1, 0, At, B0); PG8_MMA(1, 1, At, B1); PG8_BAR; PG8_SCHED;
            PG8_LDB(B0, 1, 0); PG8_LDB(B1, 1, 1); PG8_SCHED; PG8_LDA(At, 1, 0); PG8_STAGE(PG8_SA(0, 1), a2 + hstepA, voffA);
            PG8_WAIT_V(8); PG8_WAIT_L(0); PG8_BAR; PG8_MMA(0, 0, At, B0); PG8_MMA(0, 1, At, B1); PG8_BAR; PG8_SCHED;
            PG8_LDA(At, 1, 1); PG8_STAGE(PG8_SB(1, 0), b3, voffB); PG8_STAGE(PG8_SB(1, 1), b3 + hstepB, voffB); PG8_STAGE(PG8_SA(1, 0), a3, voffA);
            PG8_WAIT_V(8); PG8_WAIT_L(0); PG8_BAR; PG8_MMA(1, 0, At, B0); PG8_MMA(1, 1, At, B1); PG8_BAR; PG8_SCHED;
            } else {
            PG8_LDB(B0, 0, 0); PG8_SCHED; PG8_LDA(At, 0, 0); PG8_STAGE(PG8_SA(1, 1), a1 + hstepA, voffA);
            PG8_WAIT_L(8); PG8_BAR; PG8_WAIT_L(0); PG8_MMA(0, 0, At, B0); PG8_BAR; PG8_SCHED;
            PG8_LDB(B1, 0, 1); PG8_STAGE(PG8_SB(0, 0), b2, voffB);
            PG8_BAR; PG8_WAIT_L(0); PG8_MMA(0, 1, At, B1); PG8_BAR;
            PG8_LDA(At, 0, 1); PG8_STAGE(PG8_SA(0, 0), a2, voffA);
            PG8_BAR; PG8_WAIT_L(0); PG8_MMA(1, 0, At, B0); PG8_BAR; PG8_SCHED;
            PG8_STAGE(PG8_SB(0, 1), b2 + hstepB, voffB);
            PG8_WAIT_V(6); PG8_BAR; PG8_MMA(1, 1, At, B1); PG8_BAR;
            PG8_LDB(B0, 1, 0); PG8_SCHED; PG8_LDA(At, 1, 0); PG8_STAGE(PG8_SA(0, 1), a2 + hstepA, voffA);
            PG8_WAIT_L(8); PG8_BAR; PG8_WAIT_L(0); PG8_MMA(0, 0, At, B0); PG8_BAR; PG8_SCHED;
            PG8_LDB(B1, 1, 1); PG8_STAGE(PG8_SB(1, 0), b3, voffB);
            PG8_BAR; PG8_WAIT_L(0); PG8_MMA(0, 1, At, B1); PG8_BAR;
            PG8_LDA(At, 1, 1); PG8_STAGE(PG8_SA(1, 0), a3, voffA);
            PG8_BAR; PG8_WAIT_L(0); PG8_MMA(1, 0, At, B0); PG8_BAR; PG8_SCHED;
            PG8_STAGE(PG8_SB(1, 1), b3 + hstepB, voffB);
            PG8_WAIT_V(6); PG8_BAR; PG8_MMA(1, 1, At, B1); PG8_BAR;
            }
        }
        if constexpr (ALIGN_EPI) { if (wr == 0) PG8_BAR; }
        if constexpr (!Epi::AFTER_DRAIN) { const int l2 = make_tid(0); E(acc, cur, wr, wc, l2 & 15, l2 >> 4); S.done(cur); }
        if (!has_next) break;
#pragma unroll
        for (int a = 0; a < 2; ++a)
#pragma unroll
            for (int b = 0; b < 2; ++b)
#pragma unroll
                for (int m = 0; m < 4; ++m)
#pragma unroll
                    for (int n = 0; n < 2; ++n) acc[a][b][m][n] = (f32x4){0.f, 0.f, 0.f, 0.f};
        cur = nxt; cA = nA; cB = nB; ++ui;
        if constexpr (ALIGN_EPI) { if (wr == 1) PG8_BAR; }
    }
    PG8_WAIT_V(0);
    if constexpr (!ALIGN_EPI) { if (wr == 0) PG8_BAR; }
    PG8_BAR;
    if constexpr (Epi::AFTER_DRAIN) { E.fused(acc, cur, wr, wc, fr, fq, lds, wid, lane); S.done(cur); }
#undef PG8_SA
#undef PG8_SB
#undef PG8_STAGE
#undef PG8_LDA
#undef PG8_LDB
#undef PG8_MMA
#undef PG8_WAIT_V
#undef PG8_WAIT_L
#undef PG8_BAR
#undef PG8_SCHED
}
}


struct GemmDesc {
    const bf16_t* A; int lda; long sAb, sAh;
    const void* B; int ldb; long sBb, sBh;
    int Mm, Nn, Kk, nbatch, nh;
};
template <int BMODE  , class EP>
__device__ void gemm_simple(const GemmDesc g, EP epi, unsigned char* smem, int bid, int nblk) {
    bf16_t* sA = (bf16_t*)smem;
    bf16_t* sB = sA + 128 * 40;
    const int tid = threadIdx.x, lane = tid & 63, wid = tid >> 6, wr = wid >> 2, wc = wid & 3, fr = lane & 15, fq = lane >> 4;
    const int tM = g.Mm / 128, tN = g.Nn / 128, ntile = tM * tN * g.nbatch;
    for (int t = bid; t < ntile; t += nblk) {
        const int bi = t / (tM * tN), tt = t % (tM * tN), tm = tt / tN, tn = tt % tN;
        const bf16_t* A = g.A + (long)(bi / g.nh) * g.sAb + (long)(bi % g.nh) * g.sAh + (long)tm * 128 * g.lda;
        const long boff = (long)(bi / g.nh) * g.sBb + (long)(bi % g.nh) * g.sBh;
        f32x4 acc[4][2];
#pragma unroll
        for (int i = 0; i < 4; ++i)
#pragma unroll
            for (int j = 0; j < 2; ++j) acc[i][j] = (f32x4){0.f, 0.f, 0.f, 0.f};
        for (int k0 = 0; k0 < g.Kk; k0 += 32) {
            __syncthreads();
            {
                const int r = tid >> 2, c = (tid & 3) * 8;
                const u32x4 v = *(const u32x4*)(A + (long)r * g.lda + k0 + c);
                *(u32x4*)(sA + r * 40 + c) = v;
            }
            if (BMODE == 2) {
                const bf16_t* B = (const bf16_t*)g.B + boff + (long)tn * 128 * g.ldb;
                const int r = tid >> 2, c = (tid & 3) * 8;
                const u32x4 v = *(const u32x4*)(B + (long)r * g.ldb + k0 + c);
                *(u32x4*)(sB + r * 40 + c) = v;
            } else if (BMODE == 0) {
                const float* B = (const float*)g.B + boff + (long)tn * 128;
                const int k = tid >> 4, n = (tid & 15) * 8;
                const f32x4 v0 = *(const f32x4*)(B + (long)(k0 + k) * g.ldb + n), v1 = *(const f32x4*)(B + (long)(k0 + k) * g.ldb + n + 4);
#pragma unroll
                for (int j = 0; j < 4; ++j) { sB[(n + j) * 40 + k] = f2bf(v0[j]); sB[(n + 4 + j) * 40 + k] = f2bf(v1[j]); }
            } else {
                const bf16_t* B = (const bf16_t*)g.B + boff + (long)tn * 128;
                const int k = tid >> 4, n = (tid & 15) * 8;
                const u32x4 v = *(const u32x4*)(B + (long)(k0 + k) * g.ldb + n);
                const bf16_t* e = (const bf16_t*)&v;
#pragma unroll
                for (int j = 0; j < 8; ++j) sB[(n + j) * 40 + k] = e[j];
            }
            __syncthreads();
            bf16x8 af[4], bfr[2];
#pragma unroll
            for (int i = 0; i < 4; ++i) af[i] = *(const bf16x8*)(sA + (wr * 64 + i * 16 + fr) * 40 + fq * 8);
#pragma unroll
            for (int j = 0; j < 2; ++j) bfr[j] = *(const bf16x8*)(sB + (wc * 32 + j * 16 + fr) * 40 + fq * 8);
#pragma unroll
            for (int i = 0; i < 4; ++i)
#pragma unroll
                for (int j = 0; j < 2; ++j) acc[i][j] = __builtin_amdgcn_mfma_f32_16x16x32_bf16(af[i], bfr[j], acc[i][j], 0, 0, 0);
        }
#pragma unroll
        for (int i = 0; i < 4; ++i)
#pragma unroll
            for (int j = 0; j < 2; ++j)
#pragma unroll
                for (int e = 0; e < 4; ++e) epi(bi, tm * 128 + wr * 64 + i * 16 + fq * 4 + e, tn * 128 + wc * 32 + j * 16 + fr, acc[i][j][e]);
    }
}

__device__ void norm_rows_bf16(const float* in, const float* gain, bf16_t* outb, int nrows, int gw, int ngw, int lane) {
    for (int r = gw; r < nrows; r += ngw) {
        const f32x4* xr = (const f32x4*)(in + (long)r * DM) + lane;
        f32x4 v[4]; float s = 0.f;
#pragma unroll
        for (int j = 0; j < 4; ++j) { v[j] = xr[64 * j]; s += v[j].x * v[j].x + v[j].y * v[j].y + v[j].z * v[j].z + v[j].w * v[j].w; }
        const float rstd = rsqrtf(wave_sum(s) * (1.f / DM) + NORM_EPS);
        unsigned long long* o8 = (unsigned long long*)(outb + (long)r * DM) + lane;
#pragma unroll
        for (int j = 0; j < 4; ++j) { const f32x4 gg = gain ? ((const f32x4*)gain)[lane + 64 * j] : (f32x4){1.f, 1.f, 1.f, 1.f};
            o8[64 * j] = (unsigned long long)pk2(v[j].x * rstd * gg.x, v[j].y * rstd * gg.y) | ((unsigned long long)pk2(v[j].z * rstd * gg.z, v[j].w * rstd * gg.w) << 32); }
    }
}
__device__ void resid_norm_rows(const float* base, const bf16_t* y, const float* g_post, float* xo, bf16_t* xn, int gw, int ngw, int lane) {
    for (int r = gw; r < M; r += ngw) {
        const unsigned long long* yr = (const unsigned long long*)(y + (long)r * DM) + lane; const f32x4* br = (const f32x4*)(base + (long)r * DM) + lane;
        f32x4 v[4], b[4]; float s = 0.f;
#pragma unroll
        for (int j = 0; j < 4; ++j) { const unsigned long long w = yr[64 * j]; const unsigned lo = (unsigned)w, hi = (unsigned)(w >> 32);
            v[j].x = __uint_as_float(lo << 16); v[j].y = __uint_as_float(lo & 0xffff0000u); v[j].z = __uint_as_float(hi << 16); v[j].w = __uint_as_float(hi & 0xffff0000u);
            b[j] = br[64 * j]; s += v[j].x * v[j].x + v[j].y * v[j].y + v[j].z * v[j].z + v[j].w * v[j].w; }
        const float rstd = rsqrtf(wave_sum(s) * (1.f / DM) + NORM_EPS);
        float s2 = 0.f;
#pragma unroll
        for (int j = 0; j < 4; ++j) { const f32x4 gg = ((const f32x4*)g_post)[lane + 64 * j];
            v[j].x = b[j].x + v[j].x * rstd * gg.x; v[j].y = b[j].y + v[j].y * rstd * gg.y; v[j].z = b[j].z + v[j].z * rstd * gg.z; v[j].w = b[j].w + v[j].w * rstd * gg.w;
            s2 += v[j].x * v[j].x + v[j].y * v[j].y + v[j].z * v[j].z + v[j].w * v[j].w; }
        f32x4* orow = (f32x4*)(xo + (long)r * DM) + lane;
#pragma unroll
        for (int j = 0; j < 4; ++j) orow[64 * j] = v[j];
        if (xn) {
            const float rstd2 = rsqrtf(wave_sum(s2) * (1.f / DM) + NORM_EPS);
            unsigned long long* o8 = (unsigned long long*)(xn + (long)r * DM) + lane;
#pragma unroll
            for (int j = 0; j < 4; ++j)
                o8[64 * j] = (unsigned long long)pk2(v[j].x * rstd2, v[j].y * rstd2) | ((unsigned long long)pk2(v[j].z * rstd2, v[j].w * rstd2) << 32);
        }
    }
}
__device__ __forceinline__ void transpose_item(const float* W, int N, const float* gain, bf16_t* WT, int ldk, float* scr, int item, int lane) {
    const int nblk = N / 32, kb = item / nblk, nb = item % nblk, k0 = 64 * kb, n0 = 32 * nb;
#pragma unroll 8
    for (int i = 0; i < 32; ++i) { const int kk = 2 * i + (lane >> 5); const float gg = gain ? gain[k0 + kk] : 1.f; scr[kk * 33 + (lane & 31)] = W[(size_t)(k0 + kk) * N + n0 + (lane & 31)] * gg; }
    asm volatile("s_waitcnt lgkmcnt(0)" ::: "memory");
    const int c = lane & 7;
#pragma unroll
    for (int j = 0; j < 4; ++j) { const int n = (lane >> 3) + 8 * j; const float* sp = scr + (8 * c) * 33 + n;
        u32x4 o; o.x = pk2(sp[0 * 33], sp[1 * 33]); o.y = pk2(sp[2 * 33], sp[3 * 33]); o.z = pk2(sp[4 * 33], sp[5 * 33]); o.w = pk2(sp[6 * 33], sp[7 * 33]);
        *(u32x4*)(WT + (size_t)(n0 + n) * ldk + k0 + 8 * c) = o; }
    asm volatile("s_waitcnt lgkmcnt(0)" ::: "memory");
}
struct TrJob { const float* W; int K, N; const float* gain; bf16_t* WT; int ldk; };
__device__ void prologue_weights(const Params& p, unsigned char* smem, int gw, int ngw, int wid, int lane) {
    unsigned char* ws = p.ws;
    float* scr = (float*)smem + wid * (64 * 33);
    const TrJob jobs[9] = {
        {p.w_in, DM, D_IN, p.norm_mix_pre, (bf16_t*)(ws + WS_WIN), DM},
        {p.w_out, DM, DM, nullptr, (bf16_t*)(ws + WS_WOUT), DM},
        {p.mem_wq, DM, DM, p.norm_mem_pre, (bf16_t*)(ws + WS_WQ), DM},
        {p.mem_wo, DM, DM, nullptr, (bf16_t*)(ws + WS_WO), DM},
        {p.mlp_w1, DM, DFF, p.norm_mlp_pre, (bf16_t*)(ws + WS_W1), DM},
        {p.mlp_w2, DFF, DM, nullptr, (bf16_t*)(ws + WS_W2), DFF},
        {p.mem_wkv, DM, 2048, p.norm_memtok, (bf16_t*)(ws + WS_WKV), DM},
        {p.mla_w_uq, 256, 768, p.mla_q_norm, (bf16_t*)(ws + WS_WUQ), 256},
        {p.mla_w_ukv, 128, 1024, p.mla_kv_norm, (bf16_t*)(ws + WS_WUKV), 256}};
    int base = 0;
#pragma unroll
    for (int j = 0; j < 9; ++j) {
        const int items = (jobs[j].K / 64) * (jobs[j].N / 32);
        int first = gw - base; first = ((first % ngw) + ngw) % ngw;
        for (int it = first; it < items; it += ngw) transpose_item(jobs[j].W, jobs[j].N, jobs[j].gain, jobs[j].WT, jobs[j].ldk, scr, it, lane);
        base += items;
    }
    { bf16_t* wt = (bf16_t*)(ws + WS_WUKV);
      for (int i = gw * 64 + lane; i < 1024 * 16; i += ngw * 64) *(u32x4*)(wt + (size_t)(i >> 4) * 256 + 128 + (i & 15) * 8) = (u32x4){0u, 0u, 0u, 0u}; }
    { bf16_t* wt = (bf16_t*)(ws + WS_WLG);
      for (int i = gw * 64 + lane; i < 2560 * 32; i += ngw * 64) {
          const int n = i >> 5, k0 = (i & 31) * 8;
          float v[8];
#pragma unroll
          for (int e = 0; e < 8; ++e) { const int k = k0 + e; float x = 0.f;
              if (n < 1024) { const int d = n >> 9, c = n & 511; if (k >= 32 * d && k < 32 * d + 32) x = p.rwkv_w2[((long)d * 32 + (k - 32 * d)) * RC + c]; }
              else if (n < 2048) { const int d = (n - 1024) >> 9, c = n & 511; if (k >= 64 + 32 * d && k < 96 + 32 * d) x = p.rwkv_a2[((long)d * 32 + (k - 64 - 32 * d)) * RC + c]; }
              else { const int c = n - 2048; if (k >= 128 && k < 224) x = p.rwkv_g2[(long)(k - 128) * RC + c]; }
              v[e] = x; }
          u32x4 o; o.x = pk2(v[0], v[1]); o.y = pk2(v[2], v[3]); o.z = pk2(v[4], v[5]); o.w = pk2(v[6], v[7]);
          *(u32x4*)(wt + (size_t)n * 256 + k0) = o; } }
    { u32x4* z = (u32x4*)((bf16_t*)(ws + WS_WIN) + (size_t)D_IN * DM); const int n16 = (ZLD - D_IN) * DM * 2 / 16;
      for (int i = gw * 64 + lane; i < n16; i += ngw * 64) z[i] = (u32x4){0u, 0u, 0u, 0u}; }
}

__device__ void mla_prep_rows(const Params& p, int gw, int ngw, int lane) {
    const bf16_t* Z = (const bf16_t*)(p.ws + WS_Z);
    bf16_t* CQ = (bf16_t*)(p.ws + WS_CQ); bf16_t* CKV = (bf16_t*)(p.ws + WS_CKV); bf16_t* KR = (bf16_t*)(p.ws + WS_KR);
    for (int r = gw; r < M; r += ngw) {
        const bf16_t* zr = Z + (long)r * ZLD;
        float q[4]; float s = 0.f;
        { const unsigned long long w = *(const unsigned long long*)(zr + ZC_CQ + 4 * lane); const unsigned lo = (unsigned)w, hi = (unsigned)(w >> 32);
          q[0] = __uint_as_float(lo << 16); q[1] = __uint_as_float(lo & 0xffff0000u); q[2] = __uint_as_float(hi << 16); q[3] = __uint_as_float(hi & 0xffff0000u); }
#pragma unroll
        for (int j = 0; j < 4; ++j) s += q[j] * q[j];
        const float rq = rsqrtf(wave_sum(s) * (1.f / 256.f) + NORM_EPS);
        *(unsigned long long*)(CQ + (long)r * 256 + 4 * lane) = (unsigned long long)pk2(q[0] * rq, q[1] * rq) | ((unsigned long long)pk2(q[2] * rq, q[3] * rq) << 32);
        float c[2]; s = 0.f;
        { const unsigned w = *(const unsigned*)(zr + ZC_CKV + 2 * lane); c[0] = __uint_as_float(w << 16); c[1] = __uint_as_float(w & 0xffff0000u); }
        s = c[0] * c[0] + c[1] * c[1];
        const float rk = rsqrtf(wave_sum(s) * (1.f / 128.f) + NORM_EPS);
        *(unsigned*)(CKV + (long)r * 256 + 2 * lane) = pk2(c[0] * rk, c[1] * rk);
        *(unsigned*)(CKV + (long)r * 256 + 128 + 2 * lane) = 0u;
        if (lane < 16) {
            const float x1 = bf2f(zr[ZC_KR + lane]), x2 = bf2f(zr[ZC_KR + 16 + lane]);
            const float inv_freq = powf(10000.f, -(float)(2 * lane) / 32.f);
            const float ang = (float)p.pos[r] * inv_freq; float sn, cs; sincosf(ang, &sn, &cs);
            KR[(long)r * 32 + lane] = f2bf(x1 * cs - x2 * sn); KR[(long)r * 32 + 16 + lane] = f2bf(x2 * cs + x1 * sn);
        }
    }
}

__device__ void rwkv_prep_rows(const Params& p, int gw, int ngw, int lane) {
    const bf16_t* Z = (const bf16_t*)(p.ws + WS_Z);
    bf16_t* RK = (bf16_t*)p.out;
    bf16_t* LIN = (bf16_t*)(p.ws + WS_LIN);
    for (int r = gw; r < M; r += ngw) {
        const int s = r % SEQ; const bool hp = s > 0, hn = s < SEQ - 1;
        const bf16_t* zc = Z + (long)r * ZLD;
        float val[3][8];
#pragma unroll
        for (int sec = 0; sec < 3; ++sec) {
            const int c0 = sec * 512 + 8 * lane;
#pragma unroll
            for (int j = 0; j < 8; ++j) {
                const int c = c0 + j;
                float a = p.conv_rwkv[RWKV_COLS + c] * bf2f(zc[c]);
                if (hp) a += p.conv_rwkv[c] * bf2f(zc[c - ZLD]);
                if (hn) a += p.conv_rwkv[2 * RWKV_COLS + c] * bf2f(zc[c + ZLD]);
                val[sec][j] = a;
            }
        }
        float kk[8]; float ss = 0.f;
#pragma unroll
        for (int j = 0; j < 8; ++j) { kk[j] = val[1][j] * p.rwkv_k_k[8 * lane + j]; ss += kk[j] * kk[j]; }
        ss = oct_sum(ss);
        const float rn = rsqrtf(fmaxf(ss, 1e-24f));
#pragma unroll
        for (int j = 0; j < 8; ++j) {
            RK[(long)0 * M * RC + (long)r * RC + 8 * lane + j] = f2bf(val[0][j]);
            RK[(long)1 * M * RC + (long)r * RC + 8 * lane + j] = f2bf(val[1][j]);
            RK[(long)2 * M * RC + (long)r * RC + 8 * lane + j] = f2bf(val[2][j]);
            RK[(long)3 * M * RC + (long)r * RC + 8 * lane + j] = f2bf(kk[j] * rn);
        }
        if (lane < 56) {
#pragma unroll
            for (int j = 0; j < 4; ++j) {
                const int c = 1536 + 4 * lane + j;
                float a = p.conv_rwkv[RWKV_COLS + c] * bf2f(zc[c]);
                if (hp) a += p.conv_rwkv[c] * bf2f(zc[c - ZLD]);
                if (hn) a += p.conv_rwkv[2 * RWKV_COLS + c] * bf2f(zc[c + ZLD]);
                float o;
                if (c < ZC_XA) o = tanhf(a); else if (c < ZC_XG) o = a; else o = sigmoidf_(a);
                LIN[(long)r * 256 + 4 * lane + j] = f2bf(o);
            }
        } else {
#pragma unroll
            for (int j = 0; j < 4; ++j) LIN[(long)r * 256 + 4 * lane + j] = 0;
        }
    }
}

constexpr int SC_TB = 32;
constexpr int SC_VEC = SC_TB * 64 * 4;
constexpr int SC_BUF = 6 * SC_VEC + SC_TB * 32 * 4;
__device__ __forceinline__ void rwkv_scan_block(const Params& p, unsigned char* smem, int job  , const int tid) {
    const int lane = tid & 63, wid = tid >> 6, q = lane & 15, rho = lane >> 4;
    const int chain = job >> 1, half = job & 1;
    const int d = chain / (BATCH * RH), b = (chain / RH) % BATCH, h = chain % RH;
    const bf16_t* RK = (const bf16_t*)p.out;
    const bf16_t* Rr = RK, *Kk = RK + (long)M * RC, *Vv = RK + 2L * M * RC, *KK = RK + 3L * M * RC;
    const bf16_t* LW = (const bf16_t*)(p.ws + WS_LW) + (long)d * M * RC;
    const bf16_t* AA = (const bf16_t*)(p.ws + WS_AA) + (long)d * M * RC;
    float* O = (float*)(p.ws + WS_O01) + (long)d * M * RC;
    const int ps = tid >> 4, pc = (tid & 15) * 4;
    const f32x4 ka4 = *(const f32x4*)(p.rwkv_k_a + h * RN + pc);
    const f32x4 w04 = *(const f32x4*)(p.rwkv_w0 + d * RC + h * RN + pc), a04 = *(const f32x4*)(p.rwkv_a0 + d * RC + h * RN + pc);
    const int row_l = wid * 4 + rho;
    const int row_g = half * 32 + row_l;
    unsigned long long raw[6];
    auto load_raw = [&](int batch) {
        const int t = batch * SC_TB + ps, sidx = d ? (SEQ - 1 - t) : t;
        const long off = ((long)(b * SEQ + sidx)) * RC + h * RN + pc;
        raw[0] = *(const unsigned long long*)(Rr + off); raw[1] = *(const unsigned long long*)(Kk + off); raw[2] = *(const unsigned long long*)(Vv + off);
        raw[3] = *(const unsigned long long*)(KK + off); raw[4] = *(const unsigned long long*)(LW + off); raw[5] = *(const unsigned long long*)(AA + off);
    };
    auto un4 = [](unsigned long long w) { f32x4 v; const unsigned lo = (unsigned)w, hi = (unsigned)(w >> 32);
        v.x = __uint_as_float(lo << 16); v.y = __uint_as_float(lo & 0xffff0000u); v.z = __uint_as_float(hi << 16); v.w = __uint_as_float(hi & 0xffff0000u); return v; };
    auto store_batch = [&](unsigned char* buf) {
        const f32x4 r4 = un4(raw[0]), k4 = un4(raw[1]), v4 = un4(raw[2]), kk4 = un4(raw[3]), lw4 = un4(raw[4]), ar4 = un4(raw[5]);
        f32x4 w4, an, bn, kd;
#pragma unroll
        for (int e = 0; e < 4; ++e) {
            const float xx = -(w04[e] + lw4[e]);
            const float sp = fmaxf(xx, 0.f) + log1pf(__expf(-fabsf(xx)));
            w4[e] = __expf(-__expf(-sp - 0.5f));
            const float ae = sigmoidf_(a04[e] + ar4[e]);
            an[e] = -kk4[e]; bn[e] = kk4[e] * ae; kd[e] = k4[e] * (1.f + (ae - 1.f) * ka4[e]); }
        const int o = (ps * 64 + pc) * 4;
        *(f32x4*)(buf + 0 * SC_VEC + o) = w4; *(f32x4*)(buf + 1 * SC_VEC + o) = an; *(f32x4*)(buf + 2 * SC_VEC + o) = bn;
        *(f32x4*)(buf + 3 * SC_VEC + o) = kd; *(f32x4*)(buf + 4 * SC_VEC + o) = r4; *(f32x4*)(buf + 5 * SC_VEC + o) = v4;
    };
    float S0 = 0.f, S1 = 0.f, S2 = 0.f, S3 = 0.f;
    constexpr int NB = SEQ / SC_TB;
    __syncthreads();
    load_raw(0); store_batch(smem);
    __syncthreads();
    for (int bt = 0; bt < NB; ++bt) {
        unsigned char* cur = smem + (bt & 1) * SC_BUF; unsigned char* nxt = smem + ((bt + 1) & 1) * SC_BUF;
        if (bt + 1 < NB) load_raw(bt + 1);
        float* otile = (float*)(cur + 6 * SC_VEC);
#pragma unroll 4
        for (int s = 0; s < SC_TB; ++s) {
            const int vo = (s * 64 + 4 * q) * 4;
            const f32x4 w4 = *(const f32x4*)(cur + 0 * SC_VEC + vo), an = *(const f32x4*)(cur + 1 * SC_VEC + vo), bn = *(const f32x4*)(cur + 2 * SC_VEC + vo);
            const f32x4 kd = *(const f32x4*)(cur + 3 * SC_VEC + vo), r4 = *(const f32x4*)(cur + 4 * SC_VEC + vo);
            const float vv = *(const float*)(cur + 5 * SC_VEC + (s * 64 + row_g) * 4);
            float sa = (S0 * an.x + S1 * an.y) + (S2 * an.z + S3 * an.w);
            const float t0 = fmaf(vv, kd.x, S0 * w4.x), t1 = fmaf(vv, kd.y, S1 * w4.y), t2 = fmaf(vv, kd.z, S2 * w4.z), t3 = fmaf(vv, kd.w, S3 * w4.w);
            sa = row16_sum(sa);
            S0 = fmaf(sa, bn.x, t0); S1 = fmaf(sa, bn.y, t1); S2 = fmaf(sa, bn.z, t2); S3 = fmaf(sa, bn.w, t3);
            float o = (S0 * r4.x + S1 * r4.y) + (S2 * r4.z + S3 * r4.w);
            o = row16_sum(o);
            if (q == 0) otile[s * 32 + row_l] = o;
        }
        if (bt + 1 < NB) store_batch(nxt);
        __syncthreads();
        {
            const int t = bt * SC_TB + ps, sidx = d ? (SEQ - 1 - t) : t;
            const float2 ov = *(const float2*)(otile + ps * 32 + 2 * (tid & 15));
            *(float2*)(O + ((long)(b * SEQ + sidx)) * RC + h * RN + half * 32 + 2 * (tid & 15)) = ov;
        }
    }
}

__device__ void rwkv_combine_rows(const Params& p, int gw, int ngw, int lane) {
    const bf16_t* RK = (const bf16_t*)p.out;
    const bf16_t* Rr = RK, *Kk = RK + (long)M * RC, *Vv = RK + 2L * M * RC;
    const bf16_t* AA = (const bf16_t*)(p.ws + WS_AA); const bf16_t* G = (const bf16_t*)(p.ws + WS_G);
    const float* O = (const float*)(p.ws + WS_O01);
    bf16_t* YC = (bf16_t*)(p.ws + WS_YCAT);
    for (int r = gw; r < M; r += ngw) {
        const long off = (long)r * RC + 8 * lane;
        float o[8]; float s = 0.f;
#pragma unroll
        for (int j = 0; j < 8; ++j) { o[j] = O[off + j] + O[(long)M * RC + off + j]; s += o[j]; }
        s = oct_sum(s);
        const float mu = s * (1.f / 64.f); float q = 0.f;
#pragma unroll
        for (int j = 0; j < 8; ++j) { o[j] -= mu; q += o[j] * o[j]; }
        q = oct_sum(q);
        const float rstd = rsqrtf(q * (1.f / 64.f) + LNX_EPS);
        float bon = 0.f; float vv[8];
#pragma unroll
        for (int j = 0; j < 8; ++j) {
            const int c = 8 * lane + j;
            const float r_ = bf2f(Rr[off + j]), k_ = bf2f(Kk[off + j]); vv[j] = bf2f(Vv[off + j]);
            const float a0 = sigmoidf_(p.rwkv_a0[c] + bf2f(AA[off + j])), a1 = sigmoidf_(p.rwkv_a0[RC + c] + bf2f(AA[(long)M * RC + off + j])); const float ka = p.rwkv_k_a[c];
            const float kd = k_ * (1.f + (a0 - 1.f) * ka) + k_ * (1.f + (a1 - 1.f) * ka);
            bon += r_ * kd * p.rwkv_r_k[c];
        }
        bon = oct_sum(bon);
#pragma unroll
        for (int j = 0; j < 8; ++j) {
            const int c = 8 * lane + j;
            const float y = (o[j] * rstd * p.rwkv_lnx_w[c] + p.rwkv_lnx_b[c] + bon * vv[j]) * bf2f(G[off + j]);
            YC[(long)r * DM + c] = f2bf(y);
        }
    }
}

typedef float f32x16 __attribute__((ext_vector_type(16)));
typedef short v4i16_t __attribute__((ext_vector_type(4)));
#define LDSAS __attribute__((address_space(3)))
constexpr int ATT_KROW = 208;
constexpr int ATT_KBUF = 64 * ATT_KROW;
constexpr int ATT_VBUF = 8192;
constexpr int ATT_V0 = 2 * ATT_KBUF;
__device__ __forceinline__ unsigned cvtpk(float lo, float hi) { unsigned r; asm volatile("v_cvt_pk_bf16_f32 %0, %1, %2" : "=v"(r) : "v"(lo), "v"(hi)); return r; }
__device__ __forceinline__ void mla_attn_unit(const Params& p, unsigned char* smem, int unit, const int tid) {
    const int lane = tid & 63, wid = tid >> 6, r32 = lane & 31, hi = lane >> 5;
    const int b = unit / 64, hd = (unit / 8) % 8, qb = unit % 8;
    const bf16_t* Q = (const bf16_t*)(p.ws + WS_Q); const bf16_t* KV = (const bf16_t*)(p.ws + WS_KV); const bf16_t* KR = (const bf16_t*)(p.ws + WS_KR);
    bf16_t* YC = (bf16_t*)(p.ws + WS_YCAT);
    const long rowbase = (long)b * SEQ;
    const long qrow = rowbase + qb * 256 + wid * 32 + r32;
    bf16x8 qf[6];
    {
        float qv[6][8];
#pragma unroll
        for (int s6 = 0; s6 < 6; ++s6) { const u32x4 w = *(const u32x4*)(Q + qrow * 768 + hd * 96 + 16 * s6 + 8 * hi);
#pragma unroll
            for (int e = 0; e < 4; ++e) { qv[s6][2 * e] = __uint_as_float(w[e] << 16); qv[s6][2 * e + 1] = __uint_as_float(w[e] & 0xffff0000u); } }
        const float pos = (float)p.pos[qrow];
#pragma unroll
        for (int j = 0; j < 8; ++j) { const int i = 8 * hi + j; const float inv_freq = powf(10000.f, -(float)(2 * i) / 32.f); float sn, cs; sincosf(pos * inv_freq, &sn, &cs);
            const float x1 = qv[4][j], x2 = qv[5][j]; qv[4][j] = x1 * cs - x2 * sn; qv[5][j] = x2 * cs + x1 * sn; }
        const float sc = 0.10206207261596575f * 1.4426950408889634f;
#pragma unroll
        for (int s6 = 0; s6 < 6; ++s6) { u32x4 w;
#pragma unroll
            for (int e = 0; e < 4; ++e) w[e] = cvtpk(qv[s6][2 * e] * sc, qv[s6][2 * e + 1] * sc);
            qf[s6] = __builtin_bit_cast(bf16x8, w); }
    }
    const int srow = tid >> 3, sc8 = tid & 7;
    const int rrow = (tid & 255) >> 2, rc4 = tid & 3;
    const bf16_t* gK = KV + (rowbase + srow) * 1024 + hd * 128 + sc8 * 8;
    const bf16_t* gV = gK + 64;
    const bf16_t* gR = KR + (rowbase + rrow) * 32 + rc4 * 8;
    const int dK = srow * ATT_KROW + sc8 * 16;
    const int dV = (sc8 >> 2) * 4096 + (srow >> 3) * 512 + (srow & 7) * 64 + (sc8 & 3) * 16;
    const int dR = rrow * ATT_KROW + 128 + rc4 * 16;
    u32x4 stK, stV, stR;
    stK = *(const u32x4*)gK; stV = *(const u32x4*)gV; if (tid < 256) stR = *(const u32x4*)gR;
    __syncthreads();
    *(u32x4*)(smem + dK) = stK; *(u32x4*)(smem + ATT_V0 + dV) = stV; if (tid < 256) *(u32x4*)(smem + dR) = stR;
    __syncthreads();
    const int kbase = r32 * ATT_KROW + hi * 16;
    const int vbase = ATT_V0 + ((lane >> 4) & 1) * 32 + (lane & 3) * 8 + (4 * hi + ((lane & 15) >> 2)) * 64;
    f32x16 ot[2]; ot[0] = f32x16{}; ot[1] = f32x16{};
    float m = -1e30f, l = 0.f;
    constexpr int NT = SEQ / 64;
    for (int j = 0; j < NT; ++j) {
        const int cur = j & 1;
        if (j + 1 < NT) { const long o = (long)(j + 1) * 64; stK = *(const u32x4*)(gK + o * 1024); stV = *(const u32x4*)(gV + o * 1024); if (tid < 256) stR = *(const u32x4*)(gR + o * 32); }
        const unsigned char* Kb = smem + cur * ATT_KBUF;
        f32x16 p0 = f32x16{}, p1 = f32x16{};
#pragma unroll
        for (int s6 = 0; s6 < 6; ++s6) {
            const bf16x8 k0 = *(const bf16x8*)(Kb + kbase + s6 * 32);
            const bf16x8 k1 = *(const bf16x8*)(Kb + kbase + 32 * ATT_KROW + s6 * 32);
            p0 = __builtin_amdgcn_mfma_f32_32x32x16_bf16(k0, qf[s6], p0, 0, 0, 0);
            p1 = __builtin_amdgcn_mfma_f32_32x32x16_bf16(k1, qf[s6], p1, 0, 0, 0);
        }
        float mx = fmaxf(p0[0], p1[0]);
#pragma unroll
        for (int r = 1; r < 16; ++r) mx = fmaxf(mx, fmaxf(p0[r], p1[r]));
        mx = half_max32(mx);
        const float mn = fmaxf(m, mx), alpha = __builtin_amdgcn_exp2f(m - mn);
        m = mn;
        float sum = 0.f;
#pragma unroll
        for (int r = 0; r < 16; ++r) { p0[r] = __builtin_amdgcn_exp2f(p0[r] - mn); p1[r] = __builtin_amdgcn_exp2f(p1[r] - mn); sum += p0[r] + p1[r]; }
        l = l * alpha + sum;
#pragma unroll
        for (int r = 0; r < 16; ++r) { ot[0][r] *= alpha; ot[1][r] *= alpha; }
        bf16x8 pw[4];
#pragma unroll
        for (int s2 = 0; s2 < 2; ++s2) {
            u32x4 w0, w1;
#pragma unroll
            for (int e = 0; e < 4; ++e) { w0[e] = cvtpk(p0[8 * s2 + 2 * e], p0[8 * s2 + 2 * e + 1]); w1[e] = cvtpk(p1[8 * s2 + 2 * e], p1[8 * s2 + 2 * e + 1]); }
            pw[s2] = __builtin_bit_cast(bf16x8, w0); pw[2 + s2] = __builtin_bit_cast(bf16x8, w1);
        }
        const LDSAS unsigned char* Vb = (const LDSAS unsigned char*)(smem) + vbase + cur * ATT_VBUF;
#pragma unroll
        for (int d0 = 0; d0 < 2; ++d0)
#pragma unroll
            for (int ks = 0; ks < 4; ++ks) {
                const v4i16_t lo = __builtin_amdgcn_ds_read_tr16_b64_v4i16((LDSAS v4i16_t*)(Vb + d0 * 4096 + ks * 1024));
                const v4i16_t hh = __builtin_amdgcn_ds_read_tr16_b64_v4i16((LDSAS v4i16_t*)(Vb + d0 * 4096 + ks * 1024 + 512));
                const bf16x8 vf = (bf16x8){lo[0], lo[1], lo[2], lo[3], hh[0], hh[1], hh[2], hh[3]};
                ot[d0] = __builtin_amdgcn_mfma_f32_32x32x16_bf16(vf, pw[ks], ot[d0], 0, 0, 0);
            }
        if (j + 1 < NT) {
            const int nb = cur ^ 1;
            *(u32x4*)(smem + nb * ATT_KBUF + dK) = stK; *(u32x4*)(smem + ATT_V0 + nb * ATT_VBUF + dV) = stV; if (tid < 256) *(u32x4*)(smem + nb * ATT_KBUF + dR) = stR;
        }
        __syncthreads();
    }
    l = half_sum32(l);
    const float il = 1.f / l;
    bf16_t* orow = YC + qrow * DM + 512 + hd * 64 + 4 * hi;
#pragma unroll
    for (int d0 = 0; d0 < 2; ++d0)
#pragma unroll
        for (int g = 0; g < 4; ++g) {
            const unsigned lo = cvtpk(ot[d0][4 * g] * il, ot[d0][4 * g + 1] * il), hh = cvtpk(ot[d0][4 * g + 2] * il, ot[d0][4 * g + 3] * il);
            *(unsigned long long*)(orow + 32 * d0 + 8 * g) = (unsigned long long)lo | ((unsigned long long)hh << 32);
        }
}

__device__ void softmax_rows(const Params& p, int gw, int ngw, int lane) {
    const float* SC = (const float*)(p.ws + WS_SC); bf16_t* P = (bf16_t*)(p.ws + WS_P);
    for (int r = gw; r < 32 * SEQ; r += ngw) {
        const f32x4 v = ((const f32x4*)(SC + (long)r * 256))[lane];
        float mx = fmaxf(fmaxf(v.x, v.y), fmaxf(v.z, v.w));
        mx = wave_max(mx);
        const float e0 = __expf(v.x - mx), e1 = __expf(v.y - mx), e2 = __expf(v.z - mx), e3 = __expf(v.w - mx);
        const float inv = 1.f / wave_sum(e0 + e1 + e2 + e3);
        ((unsigned long long*)(P + (long)r * 256))[lane] = (unsigned long long)pk2(e0 * inv, e1 * inv) | ((unsigned long long)pk2(e2 * inv, e3 * inv) << 32);
    }
}

#define LAS __attribute__((address_space(3)))
#define XB_TMO      128
#define XB_XCNT(j)  (256  + 64 * (j))
#define XB_XSUB(j)  (1280 + 64 * (j))
#define XB_XGEN(j)  (2304 + 64 * (j))
#define XB_TOP      3328
#define XB_TOPGEN   3392
#define XCD_BAR_WORDS 3456
#define XB_SPIN_CAP (1u << 18)

__device__ __forceinline__ unsigned xb_ld(unsigned* p)              { return __hip_atomic_load(p, __ATOMIC_RELAXED, __HIP_MEMORY_SCOPE_AGENT); }
__device__ __forceinline__ unsigned xb_add(unsigned* p, unsigned v) { return __hip_atomic_fetch_add(p, v, __ATOMIC_RELAXED, __HIP_MEMORY_SCOPE_AGENT); }
__device__ __forceinline__ unsigned xb_xcc_id() { return (unsigned)__builtin_amdgcn_s_getreg((3 << 11) | 20) & 0xFu; }
#define XB_SPIN(cond, bar) do { unsigned _sp = 0; while (cond) { __builtin_amdgcn_s_sleep(1); \
    if ((++_sp & 255u) == 0u) { if (xb_ld(&(bar)[XB_TMO])) break; if (_sp > XB_SPIN_CAP) { atomicAdd(&(bar)[XB_TMO], 1u); break; } } } } while (0)

struct XcdBarrier {
    unsigned* bar; unsigned x;
    volatile LAS unsigned* st;
};

__device__ __forceinline__ XcdBarrier xcd_barrier_post(unsigned* bar, volatile LAS unsigned* st) {
    XcdBarrier b; b.bar = bar; b.x = xb_xcc_id(); b.st = st;
    if (threadIdx.x == 0) (void)xb_add(&bar[XB_XCNT(b.x)], 1u);
    return b;
}
__device__ __forceinline__ void xcd_barrier_complete(unsigned* bar, unsigned x, unsigned& nloc, unsigned& nx) {
    const unsigned G = gridDim.x * gridDim.y * gridDim.z;
    unsigned sum, cnt, mine, sp = 0u;
    for (;;) {
        sum = 0u; cnt = 0u; mine = 0u;
#pragma unroll
        for (unsigned j = 0; j < 16; ++j) { const unsigned c = xb_ld(&bar[XB_XCNT(j)]); sum += c; cnt += (c > 0u) ? 1u : 0u; mine = (j == x) ? c : mine; }
        if (sum == G) break;
        __builtin_amdgcn_s_sleep(1);
        if ((++sp & 255u) == 0u) { if (xb_ld(&bar[XB_TMO])) break; if (sp > XB_SPIN_CAP) { atomicAdd(&bar[XB_TMO], 1u); break; } }
    }
    nloc = mine > 0u ? mine : 1u; nx = cnt > 0u ? cnt : 1u;
}

__device__ __forceinline__ void xcd_barrier(const XcdBarrier& b) {
    asm volatile("s_waitcnt vmcnt(0)" ::: "memory");
    __syncthreads();
    if (threadIdx.x == 0) {
        unsigned* bar = b.bar;
        __builtin_amdgcn_s_waitcnt(0);
        unsigned nloc = b.st[0], nx = b.st[1];
        if (nloc == 0u) { xcd_barrier_complete(bar, b.x, nloc, nx); b.st[0] = nloc; b.st[1] = nx; }
        const unsigned old = xb_add(&bar[XB_XSUB(b.x)], 1u);
        const unsigned gen = old / nloc;
        if (old + 1u == (gen + 1u) * nloc) {
            __builtin_amdgcn_fence(__ATOMIC_RELEASE, "agent");
            asm volatile("s_waitcnt vmcnt(0)" ::: "memory");
            const unsigned og = xb_add(&bar[XB_TOP], 1u);
            const unsigned tg = og / nx;
            if (og + 1u == (tg + 1u) * nx) xb_add(&bar[XB_TOPGEN], 1u);
            else XB_SPIN(xb_ld(&bar[XB_TOPGEN]) == tg, bar);
            __builtin_amdgcn_fence(__ATOMIC_ACQUIRE, "agent");
            xb_add(&bar[XB_XGEN(b.x)], 1u);
            asm volatile("s_waitcnt vmcnt(0)" ::: "memory");
        } else {
            XB_SPIN(xb_ld(&bar[XB_XGEN(b.x)]) == gen, bar);
            __builtin_amdgcn_fence(__ATOMIC_ACQUIRE, "agent");
            asm volatile("s_waitcnt vmcnt(0)" ::: "memory");
        }
    }
    __syncthreads();
}

constexpr size_t WS_CTL = 252 * MiB;
constexpr int MISC_OFF = 140 * 1024;

constexpr int NTHREADS = 512;
constexpr int LDS_BYTES = 147456;

template <class Pol>
__device__ __forceinline__ void big_gemm(const int tid, unsigned char* smem, const bf16_t* A, int lda, const bf16_t* Bt, int ldb, int Mm, int Nn, int K, const Pol pol) {
    pg8::Gemm g{A, Bt, lda, ldb, K}; pg8::StaticOrder S; S.init(Mm, Nn, (int)gridDim.x, (int)blockIdx.x);
    pg8::EpiStore8<Pol> E{pol};
    pg8::gemm_phase<pg8::EpiStore8<Pol>, pg8::StaticOrder, true, true>((PG8_LAS unsigned char*)smem, g, S, E, tid);
}

template <class Pol>
__device__ __forceinline__ void batch_gemm(const int tid, unsigned char* smem, const bf16_t* A, int lda, long sAb, long sAh, const bf16_t* Bt, int ldb, long sBb, long sBh, int Mm, int Nn, int K, int nb, int nh, const Pol pol) {
    pg8::Gemm g{A, Bt, lda, ldb, K}; pg8::BatchOrder S{Mm / 256, Nn / 256, nb, nh, (int)gridDim.x, (int)blockIdx.x, sAb, sAh, sBb, sBh};
    pg8::EpiStore8<Pol> E{pol};
    pg8::gemm_phase<pg8::EpiStore8<Pol>, pg8::BatchOrder, true, true>((PG8_LAS unsigned char*)smem, g, S, E, tid);
}

template <int PH>
__device__ __forceinline__ void run_phase(const Params& p, unsigned char* smem, int bid, int nblk, const int wid_s) {
    const int tid = make_tid(wid_s), lane = tid & 63, wid = wid_s;
    const int gw = bid * (NTHREADS / 64) + wid, ngw = nblk * (NTHREADS / 64);
    unsigned char* ws = p.ws;
    if constexpr (PH == 0) {
        prologue_weights(p, smem, gw, ngw, wid, lane);
        norm_rows_bf16(p.x, nullptr, (bf16_t*)(ws + WS_XN), M, gw, ngw, lane);
    } else if constexpr (PH == 1) {
        big_gemm(tid, smem, (const bf16_t*)(ws + WS_XN), DM, (const bf16_t*)(ws + WS_WIN), DM, M, ZLD, DM, pg8::StBf16{(bf16_t*)(ws + WS_Z), ZLD});
    } else if constexpr (PH == 2) {
        mla_prep_rows(p, gw, ngw, lane);
    } else if constexpr (PH == 3) {
        big_gemm(tid, smem, (const bf16_t*)(ws + WS_CQ), 256, (const bf16_t*)(ws + WS_WUQ), 256, M, 768, 256, pg8::StBf16{(bf16_t*)(ws + WS_Q), 768});
        big_gemm(tid, smem, (const bf16_t*)(ws + WS_CKV), 256, (const bf16_t*)(ws + WS_WUKV), 256, M, 1024, 256, pg8::StBf16{(bf16_t*)(ws + WS_KV), 1024});
    } else if constexpr (PH == 4) {
        { const int vcu = (nblk % 8 == 0) ? (bid % 8) * (nblk / 8) + bid / 8 : bid;
          for (int u = vcu * 2; u < 512; u += nblk * 2) { mla_attn_unit(p, smem, u, tid); if (u + 1 < 512) mla_attn_unit(p, smem, u + 1, tid); } }
    } else if constexpr (PH == 5) {
        rwkv_prep_rows(p, gw, ngw, lane);
    } else if constexpr (PH == 6) {
        big_gemm(tid, smem, (const bf16_t*)(ws + WS_LIN), 256, (const bf16_t*)(ws + WS_WLG), 256, M, 2560, 256,
                 pg8::StLora{(bf16_t*)(ws + WS_LW), (bf16_t*)(ws + WS_AA), (bf16_t*)(ws + WS_G), M});
    } else if constexpr (PH == 7) {
        for (int j = bid; j < 2 * 2 * BATCH * RH; j += nblk) rwkv_scan_block(p, smem, j, tid);
    } else if constexpr (PH == 8) {
        rwkv_combine_rows(p, gw, ngw, lane);
    } else if constexpr (PH == 9) {
        big_gemm(tid, smem, (const bf16_t*)(ws + WS_YCAT), DM, (const bf16_t*)(ws + WS_WOUT), DM, M, DM, DM, pg8::StBf16{(bf16_t*)(ws + WS_Y), DM});
    } else if constexpr (PH == 10) {
        resid_norm_rows(p.x, (const bf16_t*)(ws + WS_Y), p.norm_mix_post, p.out, (bf16_t*)(ws + WS_XN), gw, ngw, lane);
        norm_rows_bf16(p.mem, nullptr, (bf16_t*)(ws + WS_MN), BATCH * MEMT, gw, ngw, lane);
    } else if constexpr (PH == 11) {
        big_gemm(tid, smem, (const bf16_t*)(ws + WS_XN), DM, (const bf16_t*)(ws + WS_WQ), DM, M, DM, DM, pg8::StBf16{(bf16_t*)(ws + WS_QM), DM});
        big_gemm(tid, smem, (const bf16_t*)(ws + WS_MN), DM, (const bf16_t*)(ws + WS_WKV), DM, BATCH * MEMT, 1024, DM, pg8::StBf16{(bf16_t*)(ws + WS_KVM), 1024});
        big_gemm(tid, smem, (const bf16_t*)(ws + WS_WKV) + (size_t)1024 * DM, DM, (const bf16_t*)(ws + WS_MN), DM, 1024, BATCH * MEMT, DM, pg8::StBf16{(bf16_t*)(ws + WS_KVM) + (size_t)2048 * 1024, 2048});
    } else if constexpr (PH == 12) {
        batch_gemm(tid, smem, (const bf16_t*)(ws + WS_QM), DM, (long)SEQ * DM, MEMD, (const bf16_t*)(ws + WS_KVM), 1024, (long)MEMT * 1024, MEMD, SEQ, MEMT, MEMD, BATCH * MEMH, MEMH,
                   pg8::StScoreF32{(float*)(ws + WS_SC), SEQ, MEMT, 0.0625f});
    } else if constexpr (PH == 13) {
        softmax_rows(p, gw, ngw, lane);
    } else if constexpr (PH == 14) {
        batch_gemm(tid, smem, (const bf16_t*)(ws + WS_P), MEMT, (long)MEMH * SEQ * MEMT, (long)SEQ * MEMT, (const bf16_t*)(ws + WS_KVM) + (size_t)2048 * 1024, 2048, (long)MEMT, (long)MEMD * 2048, SEQ, MEMD, MEMT, BATCH * MEMH, MEMH,
                   pg8::StBatchBf16{(bf16_t*)(ws + WS_OM), SEQ, MEMD, MEMH, DM});
    } else if constexpr (PH == 15) {
        big_gemm(tid, smem, (const bf16_t*)(ws + WS_OM), DM, (const bf16_t*)(ws + WS_WO), DM, M, DM, DM, pg8::StBf16{(bf16_t*)(ws + WS_Y), DM});
    } else if constexpr (PH == 16) {
        resid_norm_rows(p.out, (const bf16_t*)(ws + WS_Y), p.norm_mem_post, p.out, (bf16_t*)(ws + WS_XN), gw, ngw, lane);
    } else if constexpr (PH == 17) {
        big_gemm(tid, smem, (const bf16_t*)(ws + WS_XN), DM, (const bf16_t*)(ws + WS_W1), DM, M, DFF, DM, pg8::StRelu2{(bf16_t*)(ws + WS_HID), DFF});
    } else if constexpr (PH == 18) {
        big_gemm(tid, smem, (const bf16_t*)(ws + WS_HID), DFF, (const bf16_t*)(ws + WS_W2), DFF, M, DM, DFF, pg8::StBf16{(bf16_t*)(ws + WS_Y), DM});
    } else if constexpr (PH == 19) {
        resid_norm_rows(p.out, (const bf16_t*)(ws + WS_Y), p.norm_mlp_post, p.out, nullptr, gw, ngw, lane);
    }
}

template <int PH> __device__ __forceinline__ void run_all(const Params& p, unsigned char* smem, const XcdBarrier& bar, const int wid_s) {
    run_phase<PH>(p, smem, blockIdx.x, gridDim.x, wid_s);
    if constexpr (PH + 1 < 20) { xcd_barrier(bar); run_all<PH + 1>(p, smem, bar, wid_s); }
}
__global__ void __launch_bounds__(NTHREADS, 2) mega_kernel(Params p) {
    extern __shared__ __attribute__((aligned(16))) unsigned char smem[];
    cg::grid_group grid = cg::this_grid();
    const int wid_s = __builtin_amdgcn_readfirstlane((int)(threadIdx.x >> 6));
    unsigned* barw = (unsigned*)(p.ws + WS_CTL);
    volatile LAS unsigned* st = (volatile LAS unsigned*)((LAS unsigned char*)smem + MISC_OFF);
    if (threadIdx.x < 2) st[threadIdx.x] = 0u;
    if (blockIdx.x == 0) for (int i = threadIdx.x; i < XCD_BAR_WORDS; i += NTHREADS) barw[i] = 0u;
    run_phase<0>(p, smem, blockIdx.x, gridDim.x, wid_s);
    grid.sync();
    const XcdBarrier bar = xcd_barrier_post(barw, st);
    run_all<1>(p, smem, bar, wid_s);
}

extern "C" void kernel_launch(void* const* d_in, const int* in_sizes, int n_in, void* d_out, int out_size, void* d_ws, size_t ws_size, hipStream_t stream) {
    static int grid_blocks = 0;
    if (!grid_blocks) {
        int dev = 0, cus = 0, per_cu = 0;
        (void)hipFuncSetAttribute((const void*)mega_kernel, hipFuncAttributeMaxDynamicSharedMemorySize, LDS_BYTES);
        (void)hipGetDevice(&dev);
        (void)hipDeviceGetAttribute(&cus, hipDeviceAttributeMultiprocessorCount, dev);
        (void)hipOccupancyMaxActiveBlocksPerMultiprocessor(&per_cu, mega_kernel, NTHREADS, LDS_BYTES);
        if (per_cu < 1) per_cu = 1;
        grid_blocks = cus * per_cu;
        fprintf(stderr, "kernel_launch: cus=%d per_cu=%d grid=%d\n", cus, per_cu, grid_blocks);
    }
    Params p{};
    p.x = (const float*)d_in[0]; p.mem = (const float*)d_in[1]; p.pos = (const int*)d_in[2];
    const float** f = &p.norm_mix_pre;
    for (int i = 0; i < 29; ++i) f[i] = (const float*)d_in[3 + i];
    p.out = (float*)d_out; p.ws = (unsigned char*)d_ws;
    void* args[] = {&p};
    hipError_t e = hipLaunchCooperativeKernel((void*)mega_kernel, dim3(grid_blocks), dim3(NTHREADS), args, LDS_BYTES, stream);
    if (e != hipSuccess) fprintf(stderr, "cooperative launch failed: %s (grid %d)\n", hipGetErrorString(e), grid_blocks);
}
```

```cpp
#include <hip/hip_runtime.h>
#include <hip/hip_cooperative_groups.h>
namespace cg = cooperative_groups;
#include <cstdio>
#include <cstdint>

typedef unsigned short bf16_t;
typedef short bf16x8 __attribute__((ext_vector_type(8)));
typedef float f32x4 __attribute__((ext_vector_type(4)));
typedef unsigned u32x4 __attribute__((ext_vector_type(4)));

constexpr int BATCH = 8, SEQ = 2048, DM = 1024, M = BATCH * SEQ;
constexpr int RH = 8, RN = 64, RC = 512;
constexpr int RWKV_COLS = 1760, MLA_COLS = 416, D_IN = 2176;
constexpr int ZC_XW = 1536, ZC_XA = 1600, ZC_XG = 1664;
constexpr int ZC_CQ = 1760, ZC_CKV = 2016, ZC_KR = 2144;
constexpr int MH = 8, NOPE = 64, ROPE = 32, VD = 64, QKD = 96;
constexpr int MEMT = 256, MEMH = 4, MEMD = 256;
constexpr int DFF = 4096;
constexpr float NORM_EPS = 1e-6f, LNX_EPS = 64e-5f;

constexpr size_t MiB = 1u << 20;
constexpr int ZLD = 2304;
constexpr size_t WS_WIN  = 0;
constexpr size_t WS_WOUT = 5 * MiB;
constexpr size_t WS_WQ   = 7 * MiB;
constexpr size_t WS_WKV  = 9 * MiB;
constexpr size_t WS_WO   = 13 * MiB;
constexpr size_t WS_W1   = 15 * MiB;
constexpr size_t WS_W2   = 23 * MiB;
constexpr size_t WS_WUQ  = 31 * MiB;
constexpr size_t WS_WUKV = 31 * MiB + 512 * 1024;
constexpr size_t WS_WLG  = 32 * MiB;
constexpr size_t WS_XN   = 34 * MiB;
constexpr size_t WS_Z    = 66 * MiB;
constexpr size_t WS_YCAT = 138 * MiB;
constexpr size_t WS_CQ   = 170 * MiB;
constexpr size_t WS_CKV  = 178 * MiB;
constexpr size_t WS_KR   = 186 * MiB;
constexpr size_t WS_Q    = 188 * MiB;
constexpr size_t WS_KV   = 212 * MiB;
constexpr size_t WS_LIN  = 170 * MiB;
constexpr size_t WS_LW   = 178 * MiB;
constexpr size_t WS_AA   = 210 * MiB;
constexpr size_t WS_G    = 34 * MiB;
constexpr size_t WS_O01  = 66 * MiB;
constexpr size_t WS_Y    = 66 * MiB;
constexpr size_t WS_QM   = 98 * MiB;
constexpr size_t WS_MN   = 130 * MiB;
constexpr size_t WS_KVM  = 134 * MiB;
constexpr size_t WS_SC   = 142 * MiB;
constexpr size_t WS_P    = 206 * MiB;
constexpr size_t WS_OM   = 98 * MiB;
constexpr size_t WS_HID  = 98 * MiB;

struct Params {
    const float* x; const float* mem; const int* pos;
    const float *norm_mix_pre, *w_in, *conv_rwkv, *rwkv_w0, *rwkv_w2, *rwkv_a0, *rwkv_a2, *rwkv_g2, *rwkv_k_k, *rwkv_k_a, *rwkv_r_k,
                *rwkv_lnx_w, *rwkv_lnx_b, *mla_q_norm, *mla_w_uq, *mla_kv_norm, *mla_w_ukv, *w_out, *norm_mix_post, *norm_mem_pre,
                *norm_memtok, *mem_wq, *mem_wkv, *mem_wo, *norm_mem_post, *norm_mlp_pre, *mlp_w1, *mlp_w2, *norm_mlp_post;
    float* out; unsigned char* ws;
};

__device__ __forceinline__ float bf2f(bf16_t v) { return __uint_as_float((unsigned)v << 16); }
__device__ __forceinline__ bf16_t f2bf(float f) { unsigned u = __float_as_uint(f); return (bf16_t)((u + 0x7fffu + ((u >> 16) & 1u)) >> 16); }
__device__ __forceinline__ unsigned pk2(float lo, float hi) { return (unsigned)f2bf(lo) | ((unsigned)f2bf(hi) << 16); }
template <int CTRL> __device__ __forceinline__ float dpp_f(float v) { return __uint_as_float((unsigned)__builtin_amdgcn_update_dpp(0, (int)__float_as_uint(v), CTRL, 0xf, 0xf, true)); }
__device__ __forceinline__ float row16_sum(float x) {
    x += dpp_f<0x128>(x); x += dpp_f<0x124>(x); x += dpp_f<0x122>(x); x += dpp_f<0x121>(x); return x;
}
__device__ __forceinline__ float row16_max(float x) {
    x = fmaxf(x, dpp_f<0x128>(x)); x = fmaxf(x, dpp_f<0x124>(x)); x = fmaxf(x, dpp_f<0x122>(x)); x = fmaxf(x, dpp_f<0x121>(x)); return x;
}
__device__ __forceinline__ float wave_sum(float v) {
    v = row16_sum(v);
    { auto r = __builtin_amdgcn_permlane16_swap(__float_as_uint(v), __float_as_uint(v), false, false); v = __uint_as_float(r[0]) + __uint_as_float(r[1]); }
    { auto r = __builtin_amdgcn_permlane32_swap(__float_as_uint(v), __float_as_uint(v), false, false); v = __uint_as_float(r[0]) + __uint_as_float(r[1]); }
    return v;
}
__device__ __forceinline__ float wave_max(float v) {
    v = row16_max(v);
    { auto r = __builtin_amdgcn_permlane16_swap(__float_as_uint(v), __float_as_uint(v), false, false); v = fmaxf(__uint_as_float(r[0]), __uint_as_float(r[1])); }
    { auto r = __builtin_amdgcn_permlane32_swap(__float_as_uint(v), __float_as_uint(v), false, false); v = fmaxf(__uint_as_float(r[0]), __uint_as_float(r[1])); }
    return v;
}
__device__ __forceinline__ float oct_sum(float x) {
    x += dpp_f<0xB1>(x); x += dpp_f<0x4E>(x); x += dpp_f<0x141>(x); return x;
}
__device__ __forceinline__ float half_sum32(float v) { auto r = __builtin_amdgcn_permlane32_swap(__float_as_uint(v), __float_as_uint(v), false, false); return __uint_as_float(r[0]) + __uint_as_float(r[1]); }
__device__ __forceinline__ float half_max32(float v) { auto r = __builtin_amdgcn_permlane32_swap(__float_as_uint(v), __float_as_uint(v), false, false); return fmaxf(__uint_as_float(r[0]), __uint_as_float(r[1])); }
__device__ __forceinline__ int make_tid(int wid_s) { int l; asm volatile("v_mbcnt_lo_u32_b32 %0, -1, 0\n\tv_mbcnt_hi_u32_b32 %0, -1, %0" : "=v"(l)); return wid_s * 64 + l; }
__device__ __forceinline__ float sigmoidf_(float x) { return 1.f / (1.f + __expf(-x)); }
__device__ __forceinline__ float rdlane(float v, int k) { return __uint_as_float((unsigned)__builtin_amdgcn_readlane((int)__float_as_uint(v), k)); }

namespace pg8 {
#define PG8_LAS __attribute__((address_space(3)))
typedef unsigned short bf16_t;
typedef short bf16x8 __attribute__((ext_vector_type(8)));
typedef float f32x4 __attribute__((ext_vector_type(4)));
typedef unsigned u32x4 __attribute__((ext_vector_type(4)));
constexpr int BM = 256, BK = 64, HALF = 128, HTB = HALF * BK * 2  , STAGE_BYTES = 8 * HTB, NXCD = 8, WGM = 8;

__host__ __device__ __forceinline__ int lds_byte(int r, int c) { const int st = (r >> 4) * 2 + (c >> 5), rr = r & 15, cc = c & 31, ob = rr * 64 + cc * 2; return st * 1024 + (ob ^ (((ob >> 9) & 1) << 5)); }
__host__ __device__ __forceinline__ void stage_rc(int b, int& R, int& C) { const int st = b / 1024, sb = b % 1024, swz = sb ^ (((sb >> 9) & 1) << 5); R = (st >> 1) * 16 + swz / 64; C = (st & 1) * 32 + (swz % 64) / 2; }
__host__ __device__ __forceinline__ int perm32(int rho) { const int n = rho >> 4, i = rho & 15; return 8 * (i >> 2) + 4 * n + (i & 3); }

struct Unit { int pm, pn, bi; };
struct Gemm { const bf16_t* A; const bf16_t* Bt; int lda, ldb, K; };

struct StaticOrder {
    int nM, nN, nwg, G, c;
    __host__ __device__ void init(int M, int N, int G_, int c_) { nM = M / BM; nN = N / BM; nwg = nM * nN; G = G_; c = c_; }
    __host__ __device__ bool next(int i, Unit& u) const {
        const long L = (long)i * G + c; if (L >= nwg) return false;
        int wgid = (int)L; { const int q = nwg / NXCD, r = nwg % NXCD, xcd = wgid % NXCD, off = wgid / NXCD; wgid = (xcd < r ? xcd * (q + 1) : r * (q + 1) + (xcd - r) * q) + off; }
        const int nig = WGM * nN, gid = wgid / nig, fm = gid * WGM, gsz = (nM - fm) < WGM ? (nM - fm) : WGM;
        u.pm = fm + ((wgid % nig) % gsz); u.pn = (wgid % nig) / gsz; u.bi = 0; return true;
    }
    __device__ __forceinline__ const char* a_ptr(const Gemm& g, const Unit& u) const { return (const char*)(g.A + (size_t)u.pm * BM * g.lda); }
    __device__ __forceinline__ const char* b_ptr(const Gemm& g, const Unit& u) const { return (const char*)(g.Bt + (size_t)u.pn * BM * g.ldb); }
    __device__ __forceinline__ void a_ready(const Unit&) const {}
    __device__ __forceinline__ void done(const Unit&) const {}
};

__device__ __forceinline__ unsigned cvt_pk_bf16(float lo, float hi) { unsigned r; asm volatile("v_cvt_pk_bf16_f32 %0, %1, %2" : "=v"(r) : "v"(lo), "v"(hi)); return r; }
typedef float f32x2 __attribute__((ext_vector_type(2)));


template <class P> struct EpiStore8 {
    static constexpr bool PERM = true, AFTER_DRAIN = false;
    P pol;
    __device__ __forceinline__ void operator()(const f32x4 (&acc)[2][2][4][2], const Unit& u, int wr, int wc, int fr, int fq) const {
        const int row0 = u.pm * BM + wr * 64 + fr, col0 = u.pn * BM + wc * 32 + 8 * fq;
#pragma unroll
        for (int ai = 0; ai < 2; ++ai)
#pragma unroll
            for (int m = 0; m < 4; ++m)
#pragma unroll
                for (int bj = 0; bj < 2; ++bj) pol.store8(u, row0 + ai * HALF + m * 16, col0 + bj * HALF, acc[ai][bj][m][0], acc[ai][bj][m][1]);
    }
};
__device__ __forceinline__ u32x4 pack8(const f32x4& v0, const f32x4& v1) { u32x4 w; w.x = cvt_pk_bf16(v0[0], v0[1]); w.y = cvt_pk_bf16(v0[2], v0[3]); w.z = cvt_pk_bf16(v1[0], v1[1]); w.w = cvt_pk_bf16(v1[2], v1[3]); return w; }
struct StBf16 { bf16_t* O; int ldc;
    __device__ __forceinline__ void store8(const Unit&, int row, int col, const f32x4& v0, const f32x4& v1) const { *(u32x4*)(O + (size_t)row * ldc + col) = pack8(v0, v1); } };
struct StRelu2 { bf16_t* O; int ldc;
    __device__ __forceinline__ void store8(const Unit&, int row, int col, f32x4 v0, f32x4 v1) const {
#pragma unroll
        for (int e = 0; e < 4; ++e) { const float a = fmaxf(v0[e], 0.f), b = fmaxf(v1[e], 0.f); v0[e] = a * a; v1[e] = b * b; }
        *(u32x4*)(O + (size_t)row * ldc + col) = pack8(v0, v1); } };
struct BatchOrder {
    int nM, nN, nb, nh, G, c; long sAb, sAh, sBb, sBh;
    __device__ __forceinline__ bool next(int i, Unit& u) const {
        const long L = (long)i * G + c; if (L >= (long)nM * nN * nb) return false;
        const int per = nM * nN; u.bi = (int)(L / per); const int r = (int)(L % per); u.pn = r / nM; u.pm = r % nM; return true;
    }
    __device__ __forceinline__ const char* a_ptr(const Gemm& g, const Unit& u) const { return (const char*)(g.A + (size_t)(u.bi / nh) * sAb + (size_t)(u.bi % nh) * sAh + (size_t)u.pm * BM * g.lda); }
    __device__ __forceinline__ const char* b_ptr(const Gemm& g, const Unit& u) const { return (const char*)(g.Bt + (size_t)(u.bi / nh) * sBb + (size_t)(u.bi % nh) * sBh + (size_t)u.pn * BM * g.ldb); }
    __device__ __forceinline__ void a_ready(const Unit&) const {}
    __device__ __forceinline__ void done(const Unit&) const {}
};
struct StLora { bf16_t* LW; bf16_t* AA; bf16_t* G; int Mrows;
    __device__ __forceinline__ void store8(const Unit&, int row, int col, const f32x4& v0, const f32x4& v1) const {
        bf16_t* dst = (col < 1024) ? LW + ((size_t)(col >> 9) * Mrows + row) * 512 + (col & 511)
                    : (col < 2048) ? AA + ((size_t)((col - 1024) >> 9) * Mrows + row) * 512 + (col & 511)
                                   : G + (size_t)row * 512 + (col - 2048);
        *(u32x4*)dst = pack8(v0, v1);
    } };
struct StScoreF32 { float* SC; int rows, cols; float scale;
    __device__ __forceinline__ void store8(const Unit& u, int row, int col, const f32x4& v0, const f32x4& v1) const {
        float* o = SC + ((size_t)u.bi * rows + row) * cols + col; *(f32x4*)o = v0 * scale; *(f32x4*)(o + 4) = v1 * scale; } };
struct StBatchBf16 { bf16_t* O; int rows, cols, nh, ldc;
    __device__ __forceinline__ void store8(const Unit& u, int row, int col, const f32x4& v0, const f32x4& v1) const {
        *(u32x4*)(O + ((size_t)(u.bi / nh) * rows + row) * ldc + (u.bi % nh) * cols + col) = pack8(v0, v1); } };
template <class Epi, class Sched, bool ALIGN_EPI = false, bool SP2 = false>
__device__ __forceinline__ void gemm_phase(PG8_LAS unsigned char* lds, const Gemm g, const Sched& S, const Epi& E, const int tid) {
    const int wid = __builtin_amdgcn_readfirstlane(tid >> 6), lane = tid & 63, wr = wid >> 2, wc = wid & 3, fr = lane & 15, fq = lane >> 4;
    const int K = g.K, nt = K / BK;
    unsigned voffA[2], voffB[2];
#pragma unroll
    for (int i = 0; i < 2; ++i) { int R, C; stage_rc(tid * 16 + i * 8192, R, C); const int Rb = Epi::PERM ? ((R & ~31) + perm32(R & 31)) : R;
        voffA[i] = (unsigned)(R * g.lda + C) * 2u; voffB[i] = (unsigned)(Rb * g.ldb + C) * 2u; }
    const size_t kstep = (size_t)(BK * 2);
    const size_t hstepA = (size_t)HALF * g.lda * 2, hstepB = (size_t)HALF * g.ldb * 2;
    const unsigned ldsw = (unsigned)wid * 1024u;
    const int aoff = lds_byte(wr * 64 + fr, fq * 8), boff = lds_byte(wc * 32 + fr, fq * 8);
#define PG8_SA(b, h) (((b) * 2 + (h)) * HTB)
#define PG8_SB(b, h) ((4 + (b) * 2 + (h)) * HTB)
#define PG8_STAGE(bufoff, gbase, voff) do { _Pragma("unroll") for (int _i = 0; _i < 2; ++_i) \
        __builtin_amdgcn_global_load_lds((const unsigned*)((const char*)(gbase) + (voff)[_i]), (PG8_LAS unsigned*)(lds + (bufoff) + ldsw + _i * 8192), 16, 0, 0); } while (0)
#define PG8_LDA(dst, b, h) do { _Pragma("unroll") for (int m = 0; m < 4; ++m) _Pragma("unroll") for (int k = 0; k < 2; ++k) dst[m][k] = *(const PG8_LAS bf16x8*)(lds + PG8_SA(b, h) + aoff + m * 2048 + k * 1024); } while (0)
#define PG8_LDB(dst, b, h) do { _Pragma("unroll") for (int n = 0; n < 2; ++n) _Pragma("unroll") for (int k = 0; k < 2; ++k) dst[n][k] = *(const PG8_LAS bf16x8*)(lds + PG8_SB(b, h) + boff + n * 2048 + k * 1024); } while (0)
#define PG8_MMA(ai, bj, At, Bt) do { __builtin_amdgcn_s_setprio(1); _Pragma("unroll") for (int m = 0; m < 4; ++m) _Pragma("unroll") for (int n = 0; n < 2; ++n) _Pragma("unroll") for (int k = 0; k < 2; ++k) \
        acc[ai][bj][m][n] = __builtin_amdgcn_mfma_f32_16x16x32_bf16(Bt[n][k], At[m][k], acc[ai][bj][m][n], 0, 0, 0); __builtin_amdgcn_s_setprio(0); } while (0)
#define PG8_WAIT_V(n) asm volatile("s_waitcnt vmcnt(" #n ")" ::: "memory")
#define PG8_WAIT_L(n) asm volatile("s_waitcnt lgkmcnt(" #n ")" ::: "memory")
#define PG8_BAR __builtin_amdgcn_s_barrier()
#define PG8_SCHED __builtin_amdgcn_sched_barrier(0)
    Unit cur, nxt; int ui = 0;
    if (!S.next(0, cur)) return;
    f32x4 acc[2][2][4][2];
#pragma unroll
    for (int a = 0; a < 2; ++a)
#pragma unroll
        for (int b = 0; b < 2; ++b)
#pragma unroll
            for (int m = 0; m < 4; ++m)
#pragma unroll
                for (int n = 0; n < 2; ++n) acc[a][b][m][n] = (f32x4){0.f, 0.f, 0.f, 0.f};
    bf16x8 At[4][2], B0[2][2], B1[2][2];
    const char* cA = S.a_ptr(g, cur); const char* cB = S.b_ptr(g, cur);
    S.a_ready(cur);
    if constexpr (SP2) {
        PG8_STAGE(PG8_SB(0, 0), cB, voffB); PG8_STAGE(PG8_SB(0, 1), cB + hstepB, voffB); PG8_STAGE(PG8_SA(0, 0), cA, voffA); PG8_STAGE(PG8_SA(0, 1), cA + hstepA, voffA);
        if (wr == 1) PG8_BAR;
        PG8_WAIT_V(2); PG8_BAR;
        PG8_STAGE(PG8_SB(1, 0), cB + kstep, voffB); PG8_STAGE(PG8_SA(1, 0), cA + kstep, voffA); PG8_STAGE(PG8_SB(1, 1), cB + hstepB + kstep, voffB);
        PG8_WAIT_V(6); PG8_BAR;
    } else {
        PG8_STAGE(PG8_SB(0, 0), cB, voffB); PG8_STAGE(PG8_SA(0, 0), cA, voffA); PG8_STAGE(PG8_SB(0, 1), cB + hstepB, voffB); PG8_STAGE(PG8_SA(0, 1), cA + hstepA, voffA);
        if (wr == 1) PG8_BAR;
        PG8_WAIT_V(4); PG8_BAR;
        PG8_STAGE(PG8_SB(1, 0), cB + kstep, voffB); PG8_STAGE(PG8_SA(1, 0), cA + kstep, voffA); PG8_STAGE(PG8_SB(1, 1), cB + hstepB + kstep, voffB);
        PG8_WAIT_V(6); PG8_BAR;
    }
    for (;;) {
        const bool has_next = S.next(ui + 1, nxt);
        const char* nA = has_next ? S.a_ptr(g, nxt) : cA; const char* nB = has_next ? S.b_ptr(g, nxt) : cB;
        for (int t = 0; t < nt; t += 2) {
            const bool last = (t == nt - 2);
            const char* a1 = cA + (size_t)(t + 1) * kstep;
            const char* a2 = last ? nA : cA + (size_t)(t + 2) * kstep; const char* b2 = last ? nB : cB + (size_t)(t + 2) * kstep;
            const char* a3 = a2 + kstep; const char* b3 = b2 + kstep;
            if (last && has_next) S.a_ready(nxt);
            if constexpr (SP2) {
            PG8_LDB(B0, 0, 0); PG8_LDB(B1, 0, 1); PG8_SCHED; PG8_LDA(At, 0, 0); PG8_STAGE(PG8_SA(1, 1), a1 + hstepA, voffA);
            PG8_WAIT_V(8); PG8_WAIT_L(0); PG8_BAR; PG8_MMA(0, 0, At, B0); PG8_MMA(0, 1, At, B1); PG8_BAR; PG8_SCHED;
            PG8_LDA(At, 0, 1); PG8_STAGE(PG8_SB(0, 0), b2, voffB); PG8_STAGE(PG8_SB(0, 1), b2 + hstepB, voffB); PG8_STAGE(PG8_SA(0, 0), a2, voffA);
            PG8_WAIT_V(8); PG8_WAIT_L(0); PG8_BAR; PG8_MMA(1, 0, At, B0); PG8_MMA(1, 1, At, B1); PG8_BAR; PG8_SCHED;
            PG8_LDB(B0, 1, 0); PG8_LDB(B1, 1, 1); PG8_SCHED; PG8_LDA(At, 1, 0); PG8_STAGE(PG8_SA(0, 1), a2 + hstepA, voffA);
            PG8_WAIT_V(8); PG8_WAIT_L(0); PG8_BAR; PG8_MMA(0, 0, At, B0); PG8_MMA(0, 1, At, B1); PG8_BAR; PG8_SCHED;
            PG8_LDA(At, 1, 1); PG8_STAGE(PG8_SB(1, 0), b3, voffB); PG8_STAGE(PG8_SB(1, 1), b3 + hstepB, voffB); PG8_STAGE(PG8_SA(1, 0), a3, voffA);
            PG8_WAIT_V(8); PG8_WAIT_L(0); PG8_BAR; PG8_MMA(1, 0, At, B0); PG8_MMA(1, 1, At, B1); PG8_BAR; PG8_SCHED;
            } else {
            PG8_LDB(B0, 0, 0); PG8_SCHED; PG8_LDA(At, 0, 0); PG8_STAGE(PG8_SA(1, 1), a1 + hstepA, voffA);
            PG8_WAIT_L(8); PG8_BAR; PG8_WAIT_L(0); PG8_MMA(0, 0, At, B0); PG8_BAR; PG8_SCHED;
            PG8_LDB(B1, 0, 1); PG8_STAGE(PG8_SB(0, 0), b2, voffB);
            PG8_BAR; PG8_WAIT_L(0); PG8_MMA(0, 1, At, B1); PG8_BAR;
            PG8_LDA(At, 0, 1); PG8_STAGE(PG8_SA(0, 0), a2, voffA);
            PG8_BAR; PG8_WAIT_L(0); PG8_MMA(1, 0, At, B0); PG8_BAR; PG8_SCHED;
            PG8_STAGE(PG8_SB(0, 1), b2 + hstepB, voffB);
            PG8_WAIT_V(6); PG8_BAR; PG8_MMA(1, 1, At, B1); PG8_BAR;
            PG8_LDB(B0, 1, 0); PG8_SCHED; PG8_LDA(At, 1, 0); PG8_STAGE(PG8_SA(0, 1), a2 + hstepA, voffA);
            PG8_WAIT_L(8); PG8_BAR; PG8_WAIT_L(0); PG8_MMA(0, 0, At, B0); PG8_BAR; PG8_SCHED;
            PG8_LDB(B1, 1, 1); PG8_STAGE(PG8_SB(1, 0), b3, voffB);
            PG8_BAR; PG8_WAIT_L(0); PG8_MMA(0, 1, At, B1); PG8_BAR;
            PG8_LDA(At, 1, 1); PG8_STAGE(PG8_SA(1, 0), a3, voffA);
            PG8_BAR; PG8_WAIT_L(0); PG8_MMA(1, 0, At, B0); PG8_BAR; PG8_SCHED;
            PG8_STAGE(PG8_SB(1, 1), b3 + hstepB, voffB);
            PG8_WAIT_V(6); PG8_BAR; PG8_MMA(1, 1, At, B1); PG8_BAR;
            }
        }
        if constexpr (ALIGN_EPI) { if (wr == 0) PG8_BAR; }
        if constexpr (!Epi::AFTER_DRAIN) { const int l2 = make_tid(0); E(acc, cur, wr, wc, l2 & 15, l2 >> 4); S.done(cur); }
        if (!has_next) break;
#pragma unroll
        for (int a = 0; a < 2; ++a)
#pragma unroll
            for (int b = 0; b < 2; ++b)
#pragma unroll
                for (int m = 0; m < 4; ++m)
#pragma unroll
                    for (int n = 0; n < 2; ++n) acc[a][b][m][n] = (f32x4){0.f, 0.f, 0.f, 0.f};
        cur = nxt; cA = nA; cB = nB; ++ui;
        if constexpr (ALIGN_EPI) { if (wr == 1) PG8_BAR; }
    }
    PG8_WAIT_V(0);
    if constexpr (!ALIGN_EPI) { if (wr == 0) PG8_BAR; }
    PG8_BAR;
    if constexpr (Epi::AFTER_DRAIN) { E.fused(acc, cur, wr, wc, fr, fq, lds, wid, lane); S.done(cur); }
#undef PG8_SA
#undef PG8_SB
#undef PG8_STAGE
#undef PG8_LDA
#undef PG8_LDB
#undef PG8_MMA
#undef PG8_WAIT_V
#undef PG8_WAIT_L
#undef PG8_BAR
#undef PG8_SCHED
}
}


struct GemmDesc {
    const bf16_t* A; int lda; long sAb, sAh;
    const void* B; int ldb; long sBb, sBh;
    int Mm, Nn, Kk, nbatch, nh;
};
template <int BMODE  , class EP>
__device__ void gemm_simple(const GemmDesc g, EP epi, unsigned char* smem, int bid, int nblk) {
    bf16_t* sA = (bf16_t*)smem;
    bf16_t* sB = sA + 128 * 40;
    const int tid = threadIdx.x, lane = tid & 63, wid = tid >> 6, wr = wid >> 2, wc = wid & 3, fr = lane & 15, fq = lane >> 4;
    const int tM = g.Mm / 128, tN = g.Nn / 128, ntile = tM * tN * g.nbatch;
    for (int t = bid; t < ntile; t += nblk) {
        const int bi = t / (tM * tN), tt = t % (tM * tN), tm = tt / tN, tn = tt % tN;
        const bf16_t* A = g.A + (long)(bi / g.nh) * g.sAb + (long)(bi % g.nh) * g.sAh + (long)tm * 128 * g.lda;
        const long boff = (long)(bi / g.nh) * g.sBb + (long)(bi % g.nh) * g.sBh;
        f32x4 acc[4][2];
#pragma unroll
        for (int i = 0; i < 4; ++i)
#pragma unroll
            for (int j = 0; j < 2; ++j) acc[i][j] = (f32x4){0.f, 0.f, 0.f, 0.f};
        for (int k0 = 0; k0 < g.Kk; k0 += 32) {
            __syncthreads();
            {
                const int r = tid >> 2, c = (tid & 3) * 8;
                const u32x4 v = *(const u32x4*)(A + (long)r * g.lda + k0 + c);
                *(u32x4*)(sA + r * 40 + c) = v;
            }
            if (BMODE == 2) {
                const bf16_t* B = (const bf16_t*)g.B + boff + (long)tn * 128 * g.ldb;
                const int r = tid >> 2, c = (tid & 3) * 8;
                const u32x4 v = *(const u32x4*)(B + (long)r * g.ldb + k0 + c);
                *(u32x4*)(sB + r * 40 + c) = v;
            } else if (BMODE == 0) {
                const float* B = (const float*)g.B + boff + (long)tn * 128;
                const int k = tid >> 4, n = (tid & 15) * 8;
                const f32x4 v0 = *(const f32x4*)(B + (long)(k0 + k) * g.ldb + n), v1 = *(const f32x4*)(B + (long)(k0 + k) * g.ldb + n + 4);
#pragma unroll
                for (int j = 0; j < 4; ++j) { sB[(n + j) * 40 + k] = f2bf(v0[j]); sB[(n + 4 + j) * 40 + k] = f2bf(v1[j]); }
            } else {
                const bf16_t* B = (const bf16_t*)g.B + boff + (long)tn * 128;
                const int k = tid >> 4, n = (tid & 15) * 8;
                const u32x4 v = *(const u32x4*)(B + (long)(k0 + k) * g.ldb + n);
                const bf16_t* e = (const bf16_t*)&v;
#pragma unroll
                for (int j = 0; j < 8; ++j) sB[(n + j) * 40 + k] = e[j];
            }
            __syncthreads();
            bf16x8 af[4], bfr[2];
#pragma unroll
            for (int i = 0; i < 4; ++i) af[i] = *(const bf16x8*)(sA + (wr * 64 + i * 16 + fr) * 40 + fq * 8);
#pragma unroll
            for (int j = 0; j < 2; ++j) bfr[j] = *(const bf16x8*)(sB + (wc * 32 + j * 16 + fr) * 40 + fq * 8);
#pragma unroll
            for (int i = 0; i < 4; ++i)
#pragma unroll
                for (int j = 0; j < 2; ++j) acc[i][j] = __builtin_amdgcn_mfma_f32_16x16x32_bf16(af[i], bfr[j], acc[i][j], 0, 0, 0);
        }
#pragma unroll
        for (int i = 0; i < 4; ++i)
#pragma unroll
            for (int j = 0; j < 2; ++j)
#pragma unroll
                for (int e = 0; e < 4; ++e) epi(bi, tm * 128 + wr * 64 + i * 16 + fq * 4 + e, tn * 128 + wc * 32 + j * 16 + fr, acc[i][j][e]);
    }
}

__device__ void norm_rows_bf16(const float* in, const float* gain, bf16_t* outb, int nrows, int gw, int ngw, int lane) {
    for (int r = gw; r < nrows; r += ngw) {
        const f32x4* xr = (const f32x4*)(in + (long)r * DM) + lane;
        f32x4 v[4]; float s = 0.f;
#pragma unroll
        for (int j = 0; j < 4; ++j) { v[j] = xr[64 * j]; s += v[j].x * v[j].x + v[j].y * v[j].y + v[j].z * v[j].z + v[j].w * v[j].w; }
        const float rstd = rsqrtf(wave_sum(s) * (1.f / DM) + NORM_EPS);
        unsigned long long* o8 = (unsigned long long*)(outb + (long)r * DM) + lane;
#pragma unroll
        for (int j = 0; j < 4; ++j) { const f32x4 gg = gain ? ((const f32x4*)gain)[lane + 64 * j] : (f32x4){1.f, 1.f, 1.f, 1.f};
            o8[64 * j] = (unsigned long long)pk2(v[j].x * rstd * gg.x, v[j].y * rstd * gg.y) | ((unsigned long long)pk2(v[j].z * rstd * gg.z, v[j].w * rstd * gg.w) << 32); }
    }
}
__device__ void resid_norm_rows(const float* base, const bf16_t* y, const float* g_post, float* xo, bf16_t* xn, int gw, int ngw, int lane) {
    for (int r = gw; r < M; r += ngw) {
        const unsigned long long* yr = (const unsigned long long*)(y + (long)r * DM) + lane; const f32x4* br = (const f32x4*)(base + (long)r * DM) + lane;
        f32x4 v[4], b[4]; float s = 0.f;
#pragma unroll
        for (int j = 0; j < 4; ++j) { const unsigned long long w = yr[64 * j]; const unsigned lo = (unsigned)w, hi = (unsigned)(w >> 32);
            v[j].x = __uint_as_float(lo << 16); v[j].y = __uint_as_float(lo & 0xffff0000u); v[j].z = __uint_as_float(hi << 16); v[j].w = __uint_as_float(hi & 0xffff0000u);
            b[j] = br[64 * j]; s += v[j].x * v[j].x + v[j].y * v[j].y + v[j].z * v[j].z + v[j].w * v[j].w; }
        const float rstd = rsqrtf(wave_sum(s) * (1.f / DM) + NORM_EPS);
        float s2 = 0.f;
#pragma unroll
        for (int j = 0; j < 4; ++j) { const f32x4 gg = ((const f32x4*)g_post)[lane + 64 * j];
            v[j].x = b[j].x + v[j].x * rstd * gg.x; v[j].y = b[j].y + v[j].y * rstd * gg.y; v[j].z = b[j].z + v[j].z * rstd * gg.z; v[j].w = b[j].w + v[j].w * rstd * gg.w;
            s2 += v[j].x * v[j].x + v[j].y * v[j].y + v[j].z * v[j].z + v[j].w * v[j].w; }
        f32x4* orow = (f32x4*)(xo + (long)r * DM) + lane;
#pragma unroll
        for (int j = 0; j < 4; ++j) orow[64 * j] = v[j];
        if (xn) {
            const float rstd2 = rsqrtf(wave_sum(s2) * (1.f / DM) + NORM_EPS);
            unsigned long long* o8 = (unsigned long long*)(xn + (long)r * DM) + lane;
#pragma unroll
            for (int j = 0; j < 4; ++j)
                o8[64 * j] = (unsigned long long)pk2(v[j].x * rstd2, v[j].y * rstd2) | ((unsigned long long)pk2(v[j].z * rstd2, v[j].w * rstd2) << 32);
        }
    }
}
__device__ __forceinline__ void transpose_item(const float* W, int N, const float* gain, bf16_t* WT, int ldk, float* scr, int item, int lane) {
    const int nblk = N / 32, kb = item / nblk, nb = item % nblk, k0 = 64 * kb, n0 = 32 * nb;
#pragma unroll 8
    for (int i = 0; i < 32; ++i) { const int kk = 2 * i + (lane >> 5); const float gg = gain ? gain[k0 + kk] : 1.f; scr[kk * 33 + (lane & 31)] = W[(size_t)(k0 + kk) * N + n0 + (lane & 31)] * gg; }
    asm volatile("s_waitcnt lgkmcnt(0)" ::: "memory");
    const int c = lane & 7;
#pragma unroll
    for (int j = 0; j < 4; ++j) { const int n = (lane >> 3) + 8 * j; const float* sp = scr + (8 * c) * 33 + n;
        u32x4 o; o.x = pk2(sp[0 * 33], sp[1 * 33]); o.y = pk2(sp[2 * 33], sp[3 * 33]); o.z = pk2(sp[4 * 33], sp[5 * 33]); o.w = pk2(sp[6 * 33], sp[7 * 33]);
        *(u32x4*)(WT + (size_t)(n0 + n) * ldk + k0 + 8 * c) = o; }
    asm volatile("s_waitcnt lgkmcnt(0)" ::: "memory");
}
struct TrJob { const float* W; int K, N; const float* gain; bf16_t* WT; int ldk; };
__device__ void prologue_weights(const Params& p, unsigned char* smem, int gw, int ngw, int wid, int lane) {
    unsigned char* ws = p.ws;
    float* scr = (float*)smem + wid * (64 * 33);
    const TrJob jobs[9] = {
        {p.w_in, DM, D_IN, p.norm_mix_pre, (bf16_t*)(ws + WS_WIN), DM},
        {p.w_out, DM, DM, nullptr, (bf16_t*)(ws + WS_WOUT), DM},
        {p.mem_wq, DM, DM, p.norm_mem_pre, (bf16_t*)(ws + WS_WQ), DM},
        {p.mem_wo, DM, DM, nullptr, (bf16_t*)(ws + WS_WO), DM},
        {p.mlp_w1, DM, DFF, p.norm_mlp_pre, (bf16_t*)(ws + WS_W1), DM},
        {p.mlp_w2, DFF, DM, nullptr, (bf16_t*)(ws + WS_W2), DFF},
        {p.mem_wkv, DM, 2048, p.norm_memtok, (bf16_t*)(ws + WS_WKV), DM},
        {p.mla_w_uq, 256, 768, p.mla_q_norm, (bf16_t*)(ws + WS_WUQ), 256},
        {p.mla_w_ukv, 128, 1024, p.mla_kv_norm, (bf16_t*)(ws + WS_WUKV), 256}};
    int base = 0;
#pragma unroll
    for (int j = 0; j < 9; ++j) {
        const int items = (jobs[j].K / 64) * (jobs[j].N / 32);
        int first = gw - base; first = ((first % ngw) + ngw) % ngw;
        for (int it = first; it < items; it += ngw) transpose_item(jobs[j].W, jobs[j].N, jobs[j].gain, jobs[j].WT, jobs[j].ldk, scr, it, lane);
        base += items;
    }
    { bf16_t* wt = (bf16_t*)(ws + WS_WUKV);
      for (int i = gw * 64 + lane; i < 1024 * 16; i += ngw * 64) *(u32x4*)(wt + (size_t)(i >> 4) * 256 + 128 + (i & 15) * 8) = (u32x4){0u, 0u, 0u, 0u}; }
    { bf16_t* wt = (bf16_t*)(ws + WS_WLG);
      for (int i = gw * 64 + lane; i < 2560 * 32; i += ngw * 64) {
          const int n = i >> 5, k0 = (i & 31) * 8;
          float v[8];
#pragma unroll
          for (int e = 0; e < 8; ++e) { const int k = k0 + e; float x = 0.f;
              if (n < 1024) { const int d = n >> 9, c = n & 511; if (k >= 32 * d && k < 32 * d + 32) x = p.rwkv_w2[((long)d * 32 + (k - 32 * d)) * RC + c]; }
              else if (n < 2048) { const int d = (n - 1024) >> 9, c = n & 511; if (k >= 64 + 32 * d && k < 96 + 32 * d) x = p.rwkv_a2[((long)d * 32 + (k - 64 - 32 * d)) * RC + c]; }
              else { const int c = n - 2048; if (k >= 128 && k < 224) x = p.rwkv_g2[(long)(k - 128) * RC + c]; }
              v[e] = x; }
          u32x4 o; o.x = pk2(v[0], v[1]); o.y = pk2(v[2], v[3]); o.z = pk2(v[4], v[5]); o.w = pk2(v[6], v[7]);
          *(u32x4*)(wt + (size_t)n * 256 + k0) = o; } }
    { u32x4* z = (u32x4*)((bf16_t*)(ws + WS_WIN) + (size_t)D_IN * DM); const int n16 = (ZLD - D_IN) * DM * 2 / 16;
      for (int i = gw * 64 + lane; i < n16; i += ngw * 64) z[i] = (u32x4){0u, 0u, 0u, 0u}; }
}

__device__ void mla_prep_rows(const Params& p, int gw, int ngw, int lane) {
    const bf16_t* Z = (const bf16_t*)(p.ws + WS_Z);
    bf16_t* CQ = (bf16_t*)(p.ws + WS_CQ); bf16_t* CKV = (bf16_t*)(p.ws + WS_CKV); bf16_t* KR = (bf16_t*)(p.ws + WS_KR);
    for (int r = gw; r < M; r += ngw) {
        const bf16_t* zr = Z + (long)r * ZLD;
        float q[4]; float s = 0.f;
        { const unsigned long long w = *(const unsigned long long*)(zr + ZC_CQ + 4 * lane); const unsigned lo = (unsigned)w, hi = (unsigned)(w >> 32);
          q[0] = __uint_as_float(lo << 16); q[1] = __uint_as_float(lo & 0xffff0000u); q[2] = __uint_as_float(hi << 16); q[3] = __uint_as_float(hi & 0xffff0000u); }
#pragma unroll
        for (int j = 0; j < 4; ++j) s += q[j] * q[j];
        const float rq = rsqrtf(wave_sum(s) * (1.f / 256.f) + NORM_EPS);
        *(unsigned long long*)(CQ + (long)r * 256 + 4 * lane) = (unsigned long long)pk2(q[0] * rq, q[1] * rq) | ((unsigned long long)pk2(q[2] * rq, q[3] * rq) << 32);
        float c[2]; s = 0.f;
        { const unsigned w = *(const unsigned*)(zr + ZC_CKV + 2 * lane); c[0] = __uint_as_float(w << 16); c[1] = __uint_as_float(w & 0xffff0000u); }
        s = c[0] * c[0] + c[1] * c[1];
        const float rk = rsqrtf(wave_sum(s) * (1.f / 128.f) + NORM_EPS);
        *(unsigned*)(CKV + (long)r * 256 + 2 * lane) = pk2(c[0] * rk, c[1] * rk);
        *(unsigned*)(CKV + (long)r * 256 + 128 + 2 * lane) = 0u;
        if (lane < 16) {
            const float x1 = bf2f(zr[ZC_KR + lane]), x2 = bf2f(zr[ZC_KR + 16 + lane]);
            const float inv_freq = powf(10000.f, -(float)(2 * lane) / 32.f);
            const float ang = (float)p.pos[r] * inv_freq; float sn, cs; sincosf(ang, &sn, &cs);
            KR[(long)r * 32 + lane] = f2bf(x1 * cs - x2 * sn); KR[(long)r * 32 + 16 + lane] = f2bf(x2 * cs + x1 * sn);
        }
    }
}

__device__ __forceinline__ void unpack8(const u32x4& w, float (&f)[8]) {
#pragma unroll
    for (int e = 0; e < 4; ++e) { f[2 * e] = __uint_as_float(w[e] << 16); f[2 * e + 1] = __uint_as_float(w[e] & 0xffff0000u); }
}
__device__ void rwkv_prep_rows(const Params& p, int gw, int ngw, int lane) {
    const bf16_t* Z = (const bf16_t*)(p.ws + WS_Z);
    bf16_t* RK = (bf16_t*)p.out;
    bf16_t* LIN = (bf16_t*)(p.ws + WS_LIN);
    for (int w = gw; w < M / 8; w += ngw) {
        const int t0 = w * 8, s0 = t0 % SEQ;
#pragma unroll
        for (int sec = 0; sec < 4; ++sec) {
            const bool act = (sec < 3) || (lane < 28);
            const int c0 = (sec < 3 ? sec * 512 : 1536) + 8 * (act ? lane : 0);
            float cw[3][8];
#pragma unroll
            for (int tap = 0; tap < 3; ++tap) { const f32x4 a = *(const f32x4*)(p.conv_rwkv + tap * RWKV_COLS + c0), b = *(const f32x4*)(p.conv_rwkv + tap * RWKV_COLS + c0 + 4);
#pragma unroll
                for (int j = 0; j < 4; ++j) { cw[tap][j] = a[j]; cw[tap][4 + j] = b[j]; } }
            float kkw[8];
            if (sec == 1) {
#pragma unroll
                for (int j = 0; j < 8; ++j) kkw[j] = p.rwkv_k_k[8 * lane + j];
            }
            const bf16_t* zp = Z + (long)t0 * ZLD + c0;
            float prev[8], cur[8], nxt[8];
            if (s0 > 0) unpack8(*(const u32x4*)(zp - ZLD), prev); else {
#pragma unroll
                for (int j = 0; j < 8; ++j) prev[j] = 0.f; }
            unpack8(*(const u32x4*)zp, cur);
#pragma unroll
            for (int i = 0; i < 8; ++i) {
                if (s0 + i + 1 < SEQ) unpack8(*(const u32x4*)(zp + (long)(i + 1) * ZLD), nxt); else {
#pragma unroll
                    for (int j = 0; j < 8; ++j) nxt[j] = 0.f; }
                float val[8];
#pragma unroll
                for (int j = 0; j < 8; ++j) val[j] = cw[0][j] * prev[j] + cw[1][j] * cur[j] + cw[2][j] * nxt[j];
                const long r = t0 + i;
                if (sec < 3) {
                    u32x4 o; o.x = pk2(val[0], val[1]); o.y = pk2(val[2], val[3]); o.z = pk2(val[4], val[5]); o.w = pk2(val[6], val[7]);
                    *(u32x4*)(RK + (long)sec * M * RC + r * RC + 8 * lane) = o;
                    if (sec == 1) {
                        float kk[8]; float ss = 0.f;
#pragma unroll
                        for (int j = 0; j < 8; ++j) { kk[j] = val[j] * kkw[j]; ss += kk[j] * kk[j]; }
                        ss = oct_sum(ss);
                        const float rn = rsqrtf(fmaxf(ss, 1e-24f));
                        u32x4 o2; o2.x = pk2(kk[0] * rn, kk[1] * rn); o2.y = pk2(kk[2] * rn, kk[3] * rn); o2.z = pk2(kk[4] * rn, kk[5] * rn); o2.w = pk2(kk[6] * rn, kk[7] * rn);
                        *(u32x4*)(RK + 3L * M * RC + r * RC + 8 * lane) = o2;
                    }
                } else if (lane < 32) {
                    u32x4 o = (u32x4){0u, 0u, 0u, 0u};
                    if (lane < 28) {
#pragma unroll
                        for (int j = 0; j < 8; ++j) { const float a = val[j]; val[j] = (lane < 8) ? tanhf(a) : (lane < 16) ? a : sigmoidf_(a); }
                        o.x = pk2(val[0], val[1]); o.y = pk2(val[2], val[3]); o.z = pk2(val[4], val[5]); o.w = pk2(val[6], val[7]);
                    }
                    *(u32x4*)(LIN + r * 256 + 8 * lane) = o;
                }
#pragma unroll
                for (int j = 0; j < 8; ++j) { prev[j] = cur[j]; cur[j] = nxt[j]; }
            }
        }
    }
}

constexpr int SC_TB = 32;
constexpr int SC_VEC = SC_TB * 64 * 4;
constexpr int SC_BUF = 6 * SC_VEC + SC_TB * 32 * 4;
__device__ __forceinline__ void rwkv_scan_block(const Params& p, unsigned char* smem, int job  , const int tid) {
    const int lane = tid & 63, wid = tid >> 6, q = lane & 15, rho = lane >> 4;
    const int chain = job >> 1, half = job & 1;
    const int d = chain / (BATCH * RH), b = (chain / RH) % BATCH, h = chain % RH;
    const bf16_t* RK = (const bf16_t*)p.out;
    const bf16_t* Rr = RK, *Kk = RK + (long)M * RC, *Vv = RK + 2L * M * RC, *KK = RK + 3L * M * RC;
    const bf16_t* LW = (const bf16_t*)(p.ws + WS_LW) + (long)d * M * RC;
    const bf16_t* AA = (const bf16_t*)(p.ws + WS_AA) + (long)d * M * RC;
    float* O = (float*)(p.ws + WS_O01) + (long)d * M * RC;
    const int ps = tid >> 4, pc = (tid & 15) * 4;
    const f32x4 ka4 = *(const f32x4*)(p.rwkv_k_a + h * RN + pc);
    const f32x4 w04 = *(const f32x4*)(p.rwkv_w0 + d * RC + h * RN + pc), a04 = *(const f32x4*)(p.rwkv_a0 + d * RC + h * RN + pc);
    const int row_l = wid * 4 + rho;
    const int row_g = half * 32 + row_l;
    unsigned long long raw[6];
    auto load_raw = [&](int batch) {
        const int t = batch * SC_TB + ps, sidx = d ? (SEQ - 1 - t) : t;
        const long off = ((long)(b * SEQ + sidx)) * RC + h * RN + pc;
        raw[0] = *(const unsigned long long*)(Rr + off); raw[1] = *(const unsigned long long*)(Kk + off); raw[2] = *(const unsigned long long*)(Vv + off);
        raw[3] = *(const unsigned long long*)(KK + off); raw[4] = *(const unsigned long long*)(LW + off); raw[5] = *(const unsigned long long*)(AA + off);
    };
    auto un4 = [](unsigned long long w) { f32x4 v; const unsigned lo = (unsigned)w, hi = (unsigned)(w >> 32);
        v.x = __uint_as_float(lo << 16); v.y = __uint_as_float(lo & 0xffff0000u); v.z = __uint_as_float(hi << 16); v.w = __uint_as_float(hi & 0xffff0000u); return v; };
    auto store_batch = [&](unsigned char* buf) {
        const f32x4 r4 = un4(raw[0]), k4 = un4(raw[1]), v4 = un4(raw[2]), kk4 = un4(raw[3]), lw4 = un4(raw[4]), ar4 = un4(raw[5]);
        f32x4 w4, an, bn, kd;
#pragma unroll
        for (int e = 0; e < 4; ++e) {
            const float xx = -(w04[e] + lw4[e]);
            const float sp = fmaxf(xx, 0.f) + log1pf(__expf(-fabsf(xx)));
            w4[e] = __expf(-__expf(-sp - 0.5f));
            const float ae = sigmoidf_(a04[e] + ar4[e]);
            an[e] = -kk4[e]; bn[e] = kk4[e] * ae; kd[e] = k4[e] * (1.f + (ae - 1.f) * ka4[e]); }
        const int o = (ps * 64 + pc) * 4;
        *(f32x4*)(buf + 0 * SC_VEC + o) = w4; *(f32x4*)(buf + 1 * SC_VEC + o) = an; *(f32x4*)(buf + 2 * SC_VEC + o) = bn;
        *(f32x4*)(buf + 3 * SC_VEC + o) = kd; *(f32x4*)(buf + 4 * SC_VEC + o) = r4; *(f32x4*)(buf + 5 * SC_VEC + o) = v4;
    };
    float S0 = 0.f, S1 = 0.f, S2 = 0.f, S3 = 0.f;
    constexpr int NB = SEQ / SC_TB;
    const bool b3 = (q & 8) != 0, b2 = (q & 4) != 0, b1 = (q & 2) != 0, b0 = (q & 1) != 0;
    __syncthreads();
    load_raw(0); store_batch(smem);
    __syncthreads();
    for (int bt = 0; bt < NB; ++bt) {
        unsigned char* cur = smem + (bt & 1) * SC_BUF; unsigned char* nxt = smem + ((bt + 1) & 1) * SC_BUF;
        if (bt + 1 < NB) load_raw(bt + 1);
        float* otile = (float*)(cur + 6 * SC_VEC);
        const unsigned char* vb = cur + 16 * q;
        const unsigned char* vv_p = cur + 5 * SC_VEC + row_g * 4;
        f32x4 w4 = *(const f32x4*)(vb + 0 * SC_VEC), an = *(const f32x4*)(vb + 1 * SC_VEC), bn = *(const f32x4*)(vb + 2 * SC_VEC);
        f32x4 kd = *(const f32x4*)(vb + 3 * SC_VEC), r4 = *(const f32x4*)(vb + 4 * SC_VEC); float vv = *(const float*)vv_p;
#pragma unroll
        for (int g = 0; g < SC_TB / 16; ++g) {
            float op[16];
#pragma unroll
            for (int s16 = 0; s16 < 16; ++s16) {
                const int s = g * 16 + s16, sn = (s + 1 < SC_TB) ? s + 1 : s;
                const f32x4 w4n = *(const f32x4*)(vb + 0 * SC_VEC + sn * 256), ann = *(const f32x4*)(vb + 1 * SC_VEC + sn * 256), bnn = *(const f32x4*)(vb + 2 * SC_VEC + sn * 256);
                const f32x4 kdn = *(const f32x4*)(vb + 3 * SC_VEC + sn * 256), r4n = *(const f32x4*)(vb + 4 * SC_VEC + sn * 256); const float vvn = *(const float*)(vv_p + sn * 256);
                float sa = (S0 * an.x + S1 * an.y) + (S2 * an.z + S3 * an.w);
                const float t0 = fmaf(vv, kd.x, S0 * w4.x), t1 = fmaf(vv, kd.y, S1 * w4.y), t2 = fmaf(vv, kd.z, S2 * w4.z), t3 = fmaf(vv, kd.w, S3 * w4.w);
                sa = row16_sum(sa);
                S0 = fmaf(sa, bn.x, t0); S1 = fmaf(sa, bn.y, t1); S2 = fmaf(sa, bn.z, t2); S3 = fmaf(sa, bn.w, t3);
                op[s16] = (S0 * r4.x + S1 * r4.y) + (S2 * r4.z + S3 * r4.w);
                w4 = w4n; an = ann; bn = bnn; kd = kdn; r4 = r4n; vv = vvn;
            }
#pragma unroll
            for (int i = 0; i < 8; ++i) { const float keep = b3 ? op[i + 8] : op[i], send = b3 ? op[i] : op[i + 8]; op[i] = keep + dpp_f<0x128>(send); }
#pragma unroll
            for (int i = 0; i < 4; ++i) { const float keep = b2 ? op[i + 4] : op[i], send = b2 ? op[i] : op[i + 4]; op[i] = keep + dpp_f<0x141>(send); }
#pragma unroll
            for (int i = 0; i < 2; ++i) { const float keep = b1 ? op[i + 2] : op[i], send = b1 ? op[i] : op[i + 2]; op[i] = keep + dpp_f<0x4E>(send); }
            { const float keep = b0 ? op[1] : op[0], send = b0 ? op[0] : op[1]; op[0] = keep + dpp_f<0xB1>(send); }
            otile[(g * 16 + q) * 32 + row_l] = op[0];
        }
        if (bt + 1 < NB) store_batch(nxt);
        __syncthreads();
        {
            const int t = bt * SC_TB + ps, sidx = d ? (SEQ - 1 - t) : t;
            const float2 ov = *(const float2*)(otile + ps * 32 + 2 * (tid & 15));
            *(float2*)(O + ((long)(b * SEQ + sidx)) * RC + h * RN + half * 32 + 2 * (tid & 15)) = ov;
        }
    }
}

__device__ void rwkv_combine_rows(const Params& p, int gw, int ngw, int lane) {
    const bf16_t* RK = (const bf16_t*)p.out;
    const bf16_t* Rr = RK, *Kk = RK + (long)M * RC, *Vv = RK + 2L * M * RC;
    const bf16_t* AA = (const bf16_t*)(p.ws + WS_AA); const bf16_t* G = (const bf16_t*)(p.ws + WS_G);
    const float* O = (const float*)(p.ws + WS_O01);
    bf16_t* YC = (bf16_t*)(p.ws + WS_YCAT);
    for (int r = gw; r < M; r += ngw) {
        const long off = (long)r * RC + 8 * lane;
        float o[8]; float s = 0.f;
#pragma unroll
        for (int j = 0; j < 8; ++j) { o[j] = O[off + j] + O[(long)M * RC + off + j]; s += o[j]; }
        s = oct_sum(s);
        const float mu = s * (1.f / 64.f); float q = 0.f;
#pragma unroll
        for (int j = 0; j < 8; ++j) { o[j] -= mu; q += o[j] * o[j]; }
        q = oct_sum(q);
        const float rstd = rsqrtf(q * (1.f / 64.f) + LNX_EPS);
        float bon = 0.f; float vv[8];
#pragma unroll
        for (int j = 0; j < 8; ++j) {
            const int c = 8 * lane + j;
            const float r_ = bf2f(Rr[off + j]), k_ = bf2f(Kk[off + j]); vv[j] = bf2f(Vv[off + j]);
            const float a0 = sigmoidf_(p.rwkv_a0[c] + bf2f(AA[off + j])), a1 = sigmoidf_(p.rwkv_a0[RC + c] + bf2f(AA[(long)M * RC + off + j])); const float ka = p.rwkv_k_a[c];
            const float kd = k_ * (1.f + (a0 - 1.f) * ka) + k_ * (1.f + (a1 - 1.f) * ka);
            bon += r_ * kd * p.rwkv_r_k[c];
        }
        bon = oct_sum(bon);
#pragma unroll
        for (int j = 0; j < 8; ++j) {
            const int c = 8 * lane + j;
            const float y = (o[j] * rstd * p.rwkv_lnx_w[c] + p.rwkv_lnx_b[c] + bon * vv[j]) * bf2f(G[off + j]);
            YC[(long)r * DM + c] = f2bf(y);
        }
    }
}

typedef float f32x16 __attribute__((ext_vector_type(16)));
typedef short v4i16_t __attribute__((ext_vector_type(4)));
#define LDSAS __attribute__((address_space(3)))
constexpr int ATT_KROW = 208;
constexpr int ATT_KBUF = 64 * ATT_KROW;
constexpr int ATT_VBUF = 8192;
constexpr int ATT_V0 = 2 * ATT_KBUF;
__device__ __forceinline__ unsigned cvtpk(float lo, float hi) { unsigned r; asm volatile("v_cvt_pk_bf16_f32 %0, %1, %2" : "=v"(r) : "v"(lo), "v"(hi)); return r; }
__device__ __forceinline__ void mla_attn_unit(const Params& p, unsigned char* smem, int unit, const int tid) {
    const int lane = tid & 63, wid = tid >> 6, r32 = lane & 31, hi = lane >> 5;
    const int b = unit / 64, hd = (unit / 8) % 8, qb = unit % 8;
    const bf16_t* Q = (const bf16_t*)(p.ws + WS_Q); const bf16_t* KV = (const bf16_t*)(p.ws + WS_KV); const bf16_t* KR = (const bf16_t*)(p.ws + WS_KR);
    bf16_t* YC = (bf16_t*)(p.ws + WS_YCAT);
    const long rowbase = (long)b * SEQ;
    const long qrow = rowbase + qb * 256 + wid * 32 + r32;
    bf16x8 qf[6];
    {
        float qv[6][8];
#pragma unroll
        for (int s6 = 0; s6 < 6; ++s6) { const u32x4 w = *(const u32x4*)(Q + qrow * 768 + hd * 96 + 16 * s6 + 8 * hi);
#pragma unroll
            for (int e = 0; e < 4; ++e) { qv[s6][2 * e] = __uint_as_float(w[e] << 16); qv[s6][2 * e + 1] = __uint_as_float(w[e] & 0xffff0000u); } }
        const float pos = (float)p.pos[qrow];
#pragma unroll
        for (int j = 0; j < 8; ++j) { const int i = 8 * hi + j; const float inv_freq = powf(10000.f, -(float)(2 * i) / 32.f); float sn, cs; sincosf(pos * inv_freq, &sn, &cs);
            const float x1 = qv[4][j], x2 = qv[5][j]; qv[4][j] = x1 * cs - x2 * sn; qv[5][j] = x2 * cs + x1 * sn; }
        const float sc = 0.10206207261596575f * 1.4426950408889634f;
#pragma unroll
        for (int s6 = 0; s6 < 6; ++s6) { u32x4 w;
#pragma unroll
            for (int e = 0; e < 4; ++e) w[e] = cvtpk(qv[s6][2 * e] * sc, qv[s6][2 * e + 1] * sc);
            qf[s6] = __builtin_bit_cast(bf16x8, w); }
    }
    const int srow = tid >> 3, sc8 = tid & 7;
    const int rrow = (tid & 255) >> 2, rc4 = tid & 3;
    const bf16_t* gK = KV + (rowbase + srow) * 1024 + hd * 128 + sc8 * 8;
    const bf16_t* gV = gK + 64;
    const bf16_t* gR = KR + (rowbase + rrow) * 32 + rc4 * 8;
    const int dK = srow * ATT_KROW + sc8 * 16;
    const int dV = (sc8 >> 2) * 4096 + (srow >> 3) * 512 + (srow & 7) * 64 + (sc8 & 3) * 16;
    const int dR = rrow * ATT_KROW + 128 + rc4 * 16;
    u32x4 stK, stV, stR;
    stK = *(const u32x4*)gK; stV = *(const u32x4*)gV; if (tid < 256) stR = *(const u32x4*)gR;
    __syncthreads();
    *(u32x4*)(smem + dK) = stK; *(u32x4*)(smem + ATT_V0 + dV) = stV; if (tid < 256) *(u32x4*)(smem + dR) = stR;
    __syncthreads();
    const int kbase = r32 * ATT_KROW + hi * 16;
    const int vbase = ATT_V0 + ((lane >> 4) & 1) * 32 + (lane & 3) * 8 + (4 * hi + ((lane & 15) >> 2)) * 64;
    f32x16 ot[2]; ot[0] = f32x16{}; ot[1] = f32x16{};
    float m = -1e30f, l = 0.f;
    constexpr int NT = SEQ / 64;
    for (int j = 0; j < NT; ++j) {
        const int cur = j & 1;
        if (j + 1 < NT) { const long o = (long)(j + 1) * 64; stK = *(const u32x4*)(gK + o * 1024); stV = *(const u32x4*)(gV + o * 1024); if (tid < 256) stR = *(const u32x4*)(gR + o * 32); }
        const unsigned char* Kb = smem + cur * ATT_KBUF;
        f32x16 p0 = f32x16{}, p1 = f32x16{};
#pragma unroll
        for (int s6 = 0; s6 < 6; ++s6) {
            const bf16x8 k0 = *(const bf16x8*)(Kb + kbase + s6 * 32);
            const bf16x8 k1 = *(const bf16x8*)(Kb + kbase + 32 * ATT_KROW + s6 * 32);
            p0 = __builtin_amdgcn_mfma_f32_32x32x16_bf16(k0, qf[s6], p0, 0, 0, 0);
            p1 = __builtin_amdgcn_mfma_f32_32x32x16_bf16(k1, qf[s6], p1, 0, 0, 0);
        }
        float mx = fmaxf(p0[0], p1[0]);
#pragma unroll
        for (int r = 1; r < 16; ++r) mx = fmaxf(mx, fmaxf(p0[r], p1[r]));
        mx = half_max32(mx);
        const float mn = fmaxf(m, mx), alpha = __builtin_amdgcn_exp2f(m - mn);
        m = mn;
        float sum = 0.f;
#pragma unroll
        for (int r = 0; r < 16; ++r) { p0[r] = __builtin_amdgcn_exp2f(p0[r] - mn); p1[r] = __builtin_amdgcn_exp2f(p1[r] - mn); sum += p0[r] + p1[r]; }
        l = l * alpha + sum;
#pragma unroll
        for (int r = 0; r < 16; ++r) { ot[0][r] *= alpha; ot[1][r] *= alpha; }
        bf16x8 pw[4];
#pragma unroll
        for (int s2 = 0; s2 < 2; ++s2) {
            u32x4 w0, w1;
#pragma unroll
            for (int e = 0; e < 4; ++e) { w0[e] = cvtpk(p0[8 * s2 + 2 * e], p0[8 * s2 + 2 * e + 1]); w1[e] = cvtpk(p1[8 * s2 + 2 * e], p1[8 * s2 + 2 * e + 1]); }
            pw[s2] = __builtin_bit_cast(bf16x8, w0); pw[2 + s2] = __builtin_bit_cast(bf16x8, w1);
        }
        const LDSAS unsigned char* Vb = (const LDSAS unsigned char*)(smem) + vbase + cur * ATT_VBUF;
#pragma unroll
        for (int d0 = 0; d0 < 2; ++d0)
#pragma unroll
            for (int ks = 0; ks < 4; ++ks) {
                const v4i16_t lo = __builtin_amdgcn_ds_read_tr16_b64_v4i16((LDSAS v4i16_t*)(Vb + d0 * 4096 + ks * 1024));
                const v4i16_t hh = __builtin_amdgcn_ds_read_tr16_b64_v4i16((LDSAS v4i16_t*)(Vb + d0 * 4096 + ks * 1024 + 512));
                const bf16x8 vf = (bf16x8){lo[0], lo[1], lo[2], lo[3], hh[0], hh[1], hh[2], hh[3]};
                ot[d0] = __builtin_amdgcn_mfma_f32_32x32x16_bf16(vf, pw[ks], ot[d0], 0, 0, 0);
            }
        if (j + 1 < NT) {
            const int nb = cur ^ 1;
            *(u32x4*)(smem + nb * ATT_KBUF + dK) = stK; *(u32x4*)(smem + ATT_V0 + nb * ATT_VBUF + dV) = stV; if (tid < 256) *(u32x4*)(smem + nb * ATT_KBUF + dR) = stR;
        }
        __syncthreads();
    }
    l = half_sum32(l);
    const float il = 1.f / l;
    bf16_t* orow = YC + qrow * DM + 512 + hd * 64 + 4 * hi;
#pragma unroll
    for (int d0 = 0; d0 < 2; ++d0)
#pragma unroll
        for (int g = 0; g < 4; ++g) {
            const unsigned lo = cvtpk(ot[d0][4 * g] * il, ot[d0][4 * g + 1] * il), hh = cvtpk(ot[d0][4 * g + 2] * il, ot[d0][4 * g + 3] * il);
            *(unsigned long long*)(orow + 32 * d0 + 8 * g) = (unsigned long long)lo | ((unsigned long long)hh << 32);
        }
}

__device__ void softmax_rows(const Params& p, int gw, int ngw, int lane) {
    const float* SC = (const float*)(p.ws + WS_SC); bf16_t* P = (bf16_t*)(p.ws + WS_P);
    for (int r = gw; r < 32 * SEQ; r += ngw) {
        const f32x4 v = ((const f32x4*)(SC + (long)r * 256))[lane];
        float mx = fmaxf(fmaxf(v.x, v.y), fmaxf(v.z, v.w));
        mx = wave_max(mx);
        const float e0 = __expf(v.x - mx), e1 = __expf(v.y - mx), e2 = __expf(v.z - mx), e3 = __expf(v.w - mx);
        const float inv = 1.f / wave_sum(e0 + e1 + e2 + e3);
        ((unsigned long long*)(P + (long)r * 256))[lane] = (unsigned long long)pk2(e0 * inv, e1 * inv) | ((unsigned long long)pk2(e2 * inv, e3 * inv) << 32);
    }
}

#define LAS __attribute__((address_space(3)))
#define XB_TMO      128
#define XB_XCNT(j)  (256  + 64 * (j))
#define XB_XSUB(j)  (1280 + 64 * (j))
#define XB_XGEN(j)  (2304 + 64 * (j))
#define XB_TOP      3328
#define XB_TOPGEN   3392
#define XCD_BAR_WORDS 3456
#define XB_SPIN_CAP (1u << 18)

__device__ __forceinline__ unsigned xb_ld(unsigned* p)              { return __hip_atomic_load(p, __ATOMIC_RELAXED, __HIP_MEMORY_SCOPE_AGENT); }
__device__ __forceinline__ unsigned xb_add(unsigned* p, unsigned v) { return __hip_atomic_fetch_add(p, v, __ATOMIC_RELAXED, __HIP_MEMORY_SCOPE_AGENT); }
__device__ __forceinline__ unsigned xb_xcc_id() { return (unsigned)__builtin_amdgcn_s_getreg((3 << 11) | 20) & 0xFu; }
#define XB_SPIN(cond, bar) do { unsigned _sp = 0; while (cond) { __builtin_amdgcn_s_sleep(1); \
    if ((++_sp & 255u) == 0u) { if (xb_ld(&(bar)[XB_TMO])) break; if (_sp > XB_SPIN_CAP) { atomicAdd(&(bar)[XB_TMO], 1u); break; } } } } while (0)

struct XcdBarrier {
    unsigned* bar; unsigned x;
    volatile LAS unsigned* st;
};

__device__ __forceinline__ XcdBarrier xcd_barrier_post(unsigned* bar, volatile LAS unsigned* st) {
    XcdBarrier b; b.bar = bar; b.x = xb_xcc_id(); b.st = st;
    if (threadIdx.x == 0) (void)xb_add(&bar[XB_XCNT(b.x)], 1u);
    return b;
}
__device__ __forceinline__ void xcd_barrier_complete(unsigned* bar, unsigned x, unsigned& nloc, unsigned& nx) {
    const unsigned G = gridDim.x * gridDim.y * gridDim.z;
    unsigned sum, cnt, mine, sp = 0u;
    for (;;) {
        sum = 0u; cnt = 0u; mine = 0u;
#pragma unroll
        for (unsigned j = 0; j < 16; ++j) { const unsigned c = xb_ld(&bar[XB_XCNT(j)]); sum += c; cnt += (c > 0u) ? 1u : 0u; mine = (j == x) ? c : mine; }
        if (sum == G) break;
        __builtin_amdgcn_s_sleep(1);
        if ((++sp & 255u) == 0u) { if (xb_ld(&bar[XB_TMO])) break; if (sp > XB_SPIN_CAP) { atomicAdd(&bar[XB_TMO], 1u); break; } }
    }
    nloc = mine > 0u ? mine : 1u; nx = cnt > 0u ? cnt : 1u;
}

__device__ __forceinline__ void xcd_barrier(const XcdBarrier& b) {
    asm volatile("s_waitcnt vmcnt(0)" ::: "memory");
    __syncthreads();
    if (threadIdx.x == 0) {
        unsigned* bar = b.bar;
        __builtin_amdgcn_s_waitcnt(0);
        unsigned nloc = b.st[0], nx = b.st[1];
        if (nloc == 0u) { xcd_barrier_complete(bar, b.x, nloc, nx); b.st[0] = nloc; b.st[1] = nx; }
        const unsigned old = xb_add(&bar[XB_XSUB(b.x)], 1u);
        const unsigned gen = old / nloc;
        if (old + 1u == (gen + 1u) * nloc) {
            __builtin_amdgcn_fence(__ATOMIC_RELEASE, "agent");
            asm volatile("s_waitcnt vmcnt(0)" ::: "memory");
            const unsigned og = xb_add(&bar[XB_TOP], 1u);
            const unsigned tg = og / nx;
            if (og + 1u == (tg + 1u) * nx) xb_add(&bar[XB_TOPGEN], 1u);
            else XB_SPIN(xb_ld(&bar[XB_TOPGEN]) == tg, bar);
            __builtin_amdgcn_fence(__ATOMIC_ACQUIRE, "agent");
            xb_add(&bar[XB_XGEN(b.x)], 1u);
            asm volatile("s_waitcnt vmcnt(0)" ::: "memory");
        } else {
            XB_SPIN(xb_ld(&bar[XB_XGEN(b.x)]) == gen, bar);
            __builtin_amdgcn_fence(__ATOMIC_ACQUIRE, "agent");
            asm volatile("s_waitcnt vmcnt(0)" ::: "memory");
        }
    }
    __syncthreads();
}

constexpr size_t WS_CTL = 252 * MiB;
constexpr int MISC_OFF = 140 * 1024;

constexpr int NTHREADS = 512;
constexpr int LDS_BYTES = 147456;

template <class Pol>
__device__ __forceinline__ void big_gemm(const int tid, unsigned char* smem, const bf16_t* A, int lda, const bf16_t* Bt, int ldb, int Mm, int Nn, int K, const Pol pol) {
    pg8::Gemm g{A, Bt, lda, ldb, K}; pg8::StaticOrder S; S.init(Mm, Nn, (int)gridDim.x, (int)blockIdx.x);
    pg8::EpiStore8<Pol> E{pol};
    pg8::gemm_phase<pg8::EpiStore8<Pol>, pg8::StaticOrder, true, true>((PG8_LAS unsigned char*)smem, g, S, E, tid);
}

template <class Pol>
__device__ __forceinline__ void batch_gemm(const int tid, unsigned char* smem, const bf16_t* A, int lda, long sAb, long sAh, const bf16_t* Bt, int ldb, long sBb, long sBh, int Mm, int Nn, int K, int nb, int nh, const Pol pol) {
    pg8::Gemm g{A, Bt, lda, ldb, K}; pg8::BatchOrder S{Mm / 256, Nn / 256, nb, nh, (int)gridDim.x, (int)blockIdx.x, sAb, sAh, sBb, sBh};
    pg8::EpiStore8<Pol> E{pol};
    pg8::gemm_phase<pg8::EpiStore8<Pol>, pg8::BatchOrder, true, true>((PG8_LAS unsigned char*)smem, g, S, E, tid);
}

template <int PH>
__device__ __forceinline__ void run_phase(const Params& p, unsigned char* smem, int bid, int nblk, const int wid_s) {
    const int tid = make_tid(wid_s), lane = tid & 63, wid = wid_s;
    const int gw = bid * (NTHREADS / 64) + wid, ngw = nblk * (NTHREADS / 64);
    unsigned char* ws = p.ws;
    if constexpr (PH == 0) {
        prologue_weights(p, smem, gw, ngw, wid, lane);
        norm_rows_bf16(p.x, nullptr, (bf16_t*)(ws + WS_XN), M, gw, ngw, lane);
    } else if constexpr (PH == 1) {
        big_gemm(tid, smem, (const bf16_t*)(ws + WS_XN), DM, (const bf16_t*)(ws + WS_WIN), DM, M, ZLD, DM, pg8::StBf16{(bf16_t*)(ws + WS_Z), ZLD});
    } else if constexpr (PH == 2) {
        mla_prep_rows(p, gw, ngw, lane);
    } else if constexpr (PH == 3) {
        big_gemm(tid, smem, (const bf16_t*)(ws + WS_CQ), 256, (const bf16_t*)(ws + WS_WUQ), 256, M, 768, 256, pg8::StBf16{(bf16_t*)(ws + WS_Q), 768});
        big_gemm(tid, smem, (const bf16_t*)(ws + WS_CKV), 256, (const bf16_t*)(ws + WS_WUKV), 256, M, 1024, 256, pg8::StBf16{(bf16_t*)(ws + WS_KV), 1024});
    } else if constexpr (PH == 4) {
        { const int vcu = (nblk % 8 == 0) ? (bid % 8) * (nblk / 8) + bid / 8 : bid;
          for (int u = vcu * 2; u < 512; u += nblk * 2) { mla_attn_unit(p, smem, u, tid); if (u + 1 < 512) mla_attn_unit(p, smem, u + 1, tid); } }
    } else if constexpr (PH == 5) {
        rwkv_prep_rows(p, gw, ngw, lane);
    } else if constexpr (PH == 6) {
        big_gemm(tid, smem, (const bf16_t*)(ws + WS_LIN), 256, (const bf16_t*)(ws + WS_WLG), 256, M, 2560, 256,
                 pg8::StLora{(bf16_t*)(ws + WS_LW), (bf16_t*)(ws + WS_AA), (bf16_t*)(ws + WS_G), M});
    } else if constexpr (PH == 7) {
        for (int j = bid; j < 2 * 2 * BATCH * RH; j += nblk) rwkv_scan_block(p, smem, j, tid);
    } else if constexpr (PH == 8) {
        rwkv_combine_rows(p, gw, ngw, lane);
    } else if constexpr (PH == 9) {
        big_gemm(tid, smem, (const bf16_t*)(ws + WS_YCAT), DM, (const bf16_t*)(ws + WS_WOUT), DM, M, DM, DM, pg8::StBf16{(bf16_t*)(ws + WS_Y), DM});
    } else if constexpr (PH == 10) {
        resid_norm_rows(p.x, (const bf16_t*)(ws + WS_Y), p.norm_mix_post, p.out, (bf16_t*)(ws + WS_XN), gw, ngw, lane);
        norm_rows_bf16(p.mem, nullptr, (bf16_t*)(ws + WS_MN), BATCH * MEMT, gw, ngw, lane);
    } else if constexpr (PH == 11) {
        big_gemm(tid, smem, (const bf16_t*)(ws + WS_XN), DM, (const bf16_t*)(ws + WS_WQ), DM, M, DM, DM, pg8::StBf16{(bf16_t*)(ws + WS_QM), DM});
        big_gemm(tid, smem, (const bf16_t*)(ws + WS_MN), DM, (const bf16_t*)(ws + WS_WKV), DM, BATCH * MEMT, 1024, DM, pg8::StBf16{(bf16_t*)(ws + WS_KVM), 1024});
        big_gemm(tid, smem, (const bf16_t*)(ws + WS_WKV) + (size_t)1024 * DM, DM, (const bf16_t*)(ws + WS_MN), DM, 1024, BATCH * MEMT, DM, pg8::StBf16{(bf16_t*)(ws + WS_KVM) + (size_t)2048 * 1024, 2048});
    } else if constexpr (PH == 12) {
        batch_gemm(tid, smem, (const bf16_t*)(ws + WS_QM), DM, (long)SEQ * DM, MEMD, (const bf16_t*)(ws + WS_KVM), 1024, (long)MEMT * 1024, MEMD, SEQ, MEMT, MEMD, BATCH * MEMH, MEMH,
                   pg8::StScoreF32{(float*)(ws + WS_SC), SEQ, MEMT, 0.0625f});
    } else if constexpr (PH == 13) {
        softmax_rows(p, gw, ngw, lane);
    } else if constexpr (PH == 14) {
        batch_gemm(tid, smem, (const bf16_t*)(ws + WS_P), MEMT, (long)MEMH * SEQ * MEMT, (long)SEQ * MEMT, (const bf16_t*)(ws + WS_KVM) + (size_t)2048 * 1024, 2048, (long)MEMT, (long)MEMD * 2048, SEQ, MEMD, MEMT, BATCH * MEMH, MEMH,
                   pg8::StBatchBf16{(bf16_t*)(ws + WS_OM), SEQ, MEMD, MEMH, DM});
    } else if constexpr (PH == 15) {
        big_gemm(tid, smem, (const bf16_t*)(ws + WS_OM), DM, (const bf16_t*)(ws + WS_WO), DM, M, DM, DM, pg8::StBf16{(bf16_t*)(ws + WS_Y), DM});
    } else if constexpr (PH == 16) {
        resid_norm_rows(p.out, (const bf16_t*)(ws + WS_Y), p.norm_mem_post, p.out, (bf16_t*)(ws + WS_XN), gw, ngw, lane);
    } else if constexpr (PH == 17) {
        big_gemm(tid, smem, (const bf16_t*)(ws + WS_XN), DM, (const bf16_t*)(ws + WS_W1), DM, M, DFF, DM, pg8::StRelu2{(bf16_t*)(ws + WS_HID), DFF});
    } else if constexpr (PH == 18) {
        big_gemm(tid, smem, (const bf16_t*)(ws + WS_HID), DFF, (const bf16_t*)(ws + WS_W2), DFF, M, DM, DFF, pg8::StBf16{(bf16_t*)(ws + WS_Y), DM});
    } else if constexpr (PH == 19) {
        resid_norm_rows(p.out, (const bf16_t*)(ws + WS_Y), p.norm_mlp_post, p.out, nullptr, gw, ngw, lane);
    }
}

template <int PH> __device__ __forceinline__ void run_all(const Params& p, unsigned char* smem, const XcdBarrier& bar, const int wid_s) {
    run_phase<PH>(p, smem, blockIdx.x, gridDim.x, wid_s);
    if constexpr (PH + 1 < 20) { xcd_barrier(bar); run_all<PH + 1>(p, smem, bar, wid_s); }
}
__global__ void __launch_bounds__(NTHREADS, 2) mega_kernel(Params p) {
    extern __shared__ __attribute__((aligned(16))) unsigned char smem[];
    cg::grid_group grid = cg::this_grid();
    const int wid_s = __builtin_amdgcn_readfirstlane((int)(threadIdx.x >> 6));
    unsigned* barw = (unsigned*)(p.ws + WS_CTL);
    volatile LAS unsigned* st = (volatile LAS unsigned*)((LAS unsigned char*)smem + MISC_OFF);
    if (threadIdx.x < 2) st[threadIdx.x] = 0u;
    if (blockIdx.x == 0) for (int i = threadIdx.x; i < XCD_BAR_WORDS; i += NTHREADS) barw[i] = 0u;
    run_phase<0>(p, smem, blockIdx.x, gridDim.x, wid_s);
    grid.sync();
    const XcdBarrier bar = xcd_barrier_post(barw, st);
    run_all<1>(p, smem, bar, wid_s);
}

extern "C" void kernel_launch(void* const* d_in, const int* in_sizes, int n_in, void* d_out, int out_size, void* d_ws, size_t ws_size, hipStream_t stream) {
    static int grid_blocks = 0;
    if (!grid_blocks) {
        int dev = 0, cus = 0, per_cu = 0;
        (void)hipFuncSetAttribute((const void*)mega_kernel, hipFuncAttributeMaxDynamicSharedMemorySize, LDS_BYTES);
        (void)hipGetDevice(&dev);
        (void)hipDeviceGetAttribute(&cus, hipDeviceAttributeMultiprocessorCount, dev);
        (void)hipOccupancyMaxActiveBlocksPerMultiprocessor(&per_cu, mega_kernel, NTHREADS, LDS_BYTES);
        if (per_cu < 1) per_cu = 1;
        grid_blocks = cus * per_cu;
        fprintf(stderr, "kernel_launch: cus=%d per_cu=%d grid=%d\n", cus, per_cu, grid_blocks);
    }
    Params p{};
    p.x = (const float*)d_in[0]; p.mem = (const float*)d_in[1]; p.pos = (const int*)d_in[2];
    const float** f = &p.norm_mix_pre;
    for (int i = 0; i < 29; ++i) f[i] = (const float*)d_in[3 + i];
    p.out = (float*)d_out; p.ws = (unsigned char*)d_ws;
    void* args[] = {&p};
    hipError_t e = hipLaunchCooperativeKernel((void*)mega_kernel, dim3(grid_blocks), dim3(NTHREADS), args, LDS_BYTES, stream);
    if (e != hipSuccess) fprintf(stderr, "cooperative launch failed: %s (grid %d)\n", hipGetErrorString(e), grid_blocks);
}
```

```cpp
#include <hip/hip_runtime.h>
#include <hip/hip_cooperative_groups.h>
namespace cg = cooperative_groups;
#include <cstdio>
#include <cstdint>

typedef unsigned short bf16_t;
typedef short bf16x8 __attribute__((ext_vector_type(8)));
typedef float f32x4 __attribute__((ext_vector_type(4)));
typedef unsigned u32x4 __attribute__((ext_vector_type(4)));

constexpr int BATCH = 8, SEQ = 2048, DM = 1024, M = BATCH * SEQ;
constexpr int RH = 8, RN = 64, RC = 512;
constexpr int RWKV_COLS = 1760, MLA_COLS = 416, D_IN = 2176;
constexpr int ZC_XW = 1536, ZC_XA = 1600, ZC_XG = 1664;
constexpr int ZC_CQ = 1760, ZC_CKV = 2016, ZC_KR = 2144;
constexpr int MH = 8, NOPE = 64, ROPE = 32, VD = 64, QKD = 96;
constexpr int MEMT = 256, MEMH = 4, MEMD = 256;
constexpr int DFF = 4096;
constexpr float NORM_EPS = 1e-6f, LNX_EPS = 64e-5f;

constexpr size_t MiB = 1u << 20;
constexpr int ZLD = 2304;
constexpr size_t WS_WIN  = 0;
constexpr size_t WS_WOUT = 5 * MiB;
constexpr size_t WS_WQ   = 7 * MiB;
constexpr size_t WS_WKV  = 9 * MiB;
constexpr size_t WS_WO   = 13 * MiB;
constexpr size_t WS_W1   = 15 * MiB;
constexpr size_t WS_W2   = 23 * MiB;
constexpr size_t WS_WUQ  = 31 * MiB;
constexpr size_t WS_WUKV = 31 * MiB + 512 * 1024;
constexpr size_t WS_WLG  = 32 * MiB;
constexpr size_t WS_XN   = 34 * MiB;
constexpr size_t WS_Z    = 66 * MiB;
constexpr size_t WS_YCAT = 138 * MiB;
constexpr size_t WS_CQ   = 170 * MiB;
constexpr size_t WS_CKV  = 178 * MiB;
constexpr size_t WS_KR   = 186 * MiB;
constexpr size_t WS_Q    = 188 * MiB;
constexpr size_t WS_KV   = 212 * MiB;
constexpr size_t WS_LIN  = 170 * MiB;
constexpr size_t WS_LW   = 178 * MiB;
constexpr size_t WS_AA   = 210 * MiB;
constexpr size_t WS_G    = 34 * MiB;
constexpr size_t WS_O01  = 66 * MiB;
constexpr size_t WS_Y    = 66 * MiB;
constexpr size_t WS_QM   = 98 * MiB;
constexpr size_t WS_MN   = 130 * MiB;
constexpr size_t WS_KVM  = 134 * MiB;
constexpr size_t WS_SC   = 142 * MiB;
constexpr size_t WS_P    = 206 * MiB;
constexpr size_t WS_OM   = 98 * MiB;
constexpr size_t WS_HID  = 98 * MiB;

struct Params {
    const float* x; const float* mem; const int* pos;
    const float *norm_mix_pre, *w_in, *conv_rwkv, *rwkv_w0, *rwkv_w2, *rwkv_a0, *rwkv_a2, *rwkv_g2, *rwkv_k_k, *rwkv_k_a, *rwkv_r_k,
                *rwkv_lnx_w, *rwkv_lnx_b, *mla_q_norm, *mla_w_uq, *mla_kv_norm, *mla_w_ukv, *w_out, *norm_mix_post, *norm_mem_pre,
                *norm_memtok, *mem_wq, *mem_wkv, *mem_wo, *norm_mem_post, *norm_mlp_pre, *mlp_w1, *mlp_w2, *norm_mlp_post;
    float* out; unsigned char* ws;
};

__device__ __forceinline__ float bf2f(bf16_t v) { return __uint_as_float((unsigned)v << 16); }
__device__ __forceinline__ bf16_t f2bf(float f) { unsigned u = __float_as_uint(f); return (bf16_t)((u + 0x7fffu + ((u >> 16) & 1u)) >> 16); }
__device__ __forceinline__ unsigned pk2(float lo, float hi) { return (unsigned)f2bf(lo) | ((unsigned)f2bf(hi) << 16); }
template <int CTRL> __device__ __forceinline__ float dpp_f(float v) { return __uint_as_float((unsigned)__builtin_amdgcn_update_dpp(0, (int)__float_as_uint(v), CTRL, 0xf, 0xf, true)); }
__device__ __forceinline__ float row16_sum(float x) {
    x += dpp_f<0x128>(x); x += dpp_f<0x124>(x); x += dpp_f<0x122>(x); x += dpp_f<0x121>(x); return x;
}
__device__ __forceinline__ float row16_max(float x) {
    x = fmaxf(x, dpp_f<0x128>(x)); x = fmaxf(x, dpp_f<0x124>(x)); x = fmaxf(x, dpp_f<0x122>(x)); x = fmaxf(x, dpp_f<0x121>(x)); return x;
}
__device__ __forceinline__ float wave_sum(float v) {
    v = row16_sum(v);
    { auto r = __builtin_amdgcn_permlane16_swap(__float_as_uint(v), __float_as_uint(v), false, false); v = __uint_as_float(r[0]) + __uint_as_float(r[1]); }
    { auto r = __builtin_amdgcn_permlane32_swap(__float_as_uint(v), __float_as_uint(v), false, false); v = __uint_as_float(r[0]) + __uint_as_float(r[1]); }
    return v;
}
__device__ __forceinline__ float wave_max(float v) {
    v = row16_max(v);
    { auto r = __builtin_amdgcn_permlane16_swap(__float_as_uint(v), __float_as_uint(v), false, false); v = fmaxf(__uint_as_float(r[0]), __uint_as_float(r[1])); }
    { auto r = __builtin_amdgcn_permlane32_swap(__float_as_uint(v), __float_as_uint(v), false, false); v = fmaxf(__uint_as_float(r[0]), __uint_as_float(r[1])); }
    return v;
}
__device__ __forceinline__ float oct_sum(float x) {
    x += dpp_f<0xB1>(x); x += dpp_f<0x4E>(x); x += dpp_f<0x141>(x); return x;
}
__device__ __forceinline__ float half_sum32(float v) { auto r = __builtin_amdgcn_permlane32_swap(__float_as_uint(v), __float_as_uint(v), false, false); return __uint_as_float(r[0]) + __uint_as_float(r[1]); }
__device__ __forceinline__ float half_max32(float v) { auto r = __builtin_amdgcn_permlane32_swap(__float_as_uint(v), __float_as_uint(v), false, false); return fmaxf(__uint_as_float(r[0]), __uint_as_float(r[1])); }
__device__ __forceinline__ int make_tid(int wid_s) { int l; asm volatile("v_mbcnt_lo_u32_b32 %0, -1, 0\n\tv_mbcnt_hi_u32_b32 %0, -1, %0" : "=v"(l)); return wid_s * 64 + l; }
__device__ __forceinline__ float sigmoidf_(float x) { return __builtin_amdgcn_rcpf(1.f + __expf(-x)); }
__device__ __forceinline__ float rdlane(float v, int k) { return __uint_as_float((unsigned)__builtin_amdgcn_readlane((int)__float_as_uint(v), k)); }

namespace pg8 {
#define PG8_LAS __attribute__((address_space(3)))
typedef unsigned short bf16_t;
typedef short bf16x8 __attribute__((ext_vector_type(8)));
typedef float f32x4 __attribute__((ext_vector_type(4)));
typedef unsigned u32x4 __attribute__((ext_vector_type(4)));
constexpr int BM = 256, BK = 64, HALF = 128, HTB = HALF * BK * 2  , STAGE_BYTES = 8 * HTB, NXCD = 8, WGM = 8;

__host__ __device__ __forceinline__ int lds_byte(int r, int c) { const int st = (r >> 4) * 2 + (c >> 5), rr = r & 15, cc = c & 31, ob = rr * 64 + cc * 2; return st * 1024 + (ob ^ (((ob >> 9) & 1) << 5)); }
__host__ __device__ __forceinline__ void stage_rc(int b, int& R, int& C) { const int st = b / 1024, sb = b % 1024, swz = sb ^ (((sb >> 9) & 1) << 5); R = (st >> 1) * 16 + swz / 64; C = (st & 1) * 32 + (swz % 64) / 2; }
__host__ __device__ __forceinline__ int perm32(int rho) { const int n = rho >> 4, i = rho & 15; return 8 * (i >> 2) + 4 * n + (i & 3); }

struct Unit { int pm, pn, bi; };
struct Gemm { const bf16_t* A; const bf16_t* Bt; int lda, ldb, K; };

struct StaticOrder {
    int nM, nN, nwg, G, c;
    __host__ __device__ void init(int M, int N, int G_, int c_) { nM = M / BM; nN = N / BM; nwg = nM * nN; G = G_; c = c_; }
    __host__ __device__ bool next(int i, Unit& u) const {
        const long L = (long)i * G + c; if (L >= nwg) return false;
        int wgid = (int)L; { const int q = nwg / NXCD, r = nwg % NXCD, xcd = wgid % NXCD, off = wgid / NXCD; wgid = (xcd < r ? xcd * (q + 1) : r * (q + 1) + (xcd - r) * q) + off; }
        const int nig = WGM * nN, gid = wgid / nig, fm = gid * WGM, gsz = (nM - fm) < WGM ? (nM - fm) : WGM;
        u.pm = fm + ((wgid % nig) % gsz); u.pn = (wgid % nig) / gsz; u.bi = 0; return true;
    }
    __device__ __forceinline__ const char* a_ptr(const Gemm& g, const Unit& u) const { return (const char*)(g.A + (size_t)u.pm * BM * g.lda); }
    __device__ __forceinline__ const char* b_ptr(const Gemm& g, const Unit& u) const { return (const char*)(g.Bt + (size_t)u.pn * BM * g.ldb); }
    __device__ __forceinline__ void a_ready(const Unit&) const {}
    __device__ __forceinline__ void done(const Unit&) const {}
};

__device__ __forceinline__ unsigned cvt_pk_bf16(float lo, float hi) { unsigned r; asm volatile("v_cvt_pk_bf16_f32 %0, %1, %2" : "=v"(r) : "v"(lo), "v"(hi)); return r; }
typedef float f32x2 __attribute__((ext_vector_type(2)));


template <class P> struct EpiStore8 {
    static constexpr bool PERM = true, AFTER_DRAIN = false;
    P pol;
    __device__ __forceinline__ void operator()(const f32x4 (&acc)[2][2][4][2], const Unit& u, int wr, int wc, int fr, int fq) const {
        const int row0 = u.pm * BM + wr * 64 + fr, col0 = u.pn * BM + wc * 32 + 8 * fq;
#pragma unroll
        for (int ai = 0; ai < 2; ++ai)
#pragma unroll
            for (int m = 0; m < 4; ++m)
#pragma unroll
                for (int bj = 0; bj < 2; ++bj) pol.store8(u, row0 + ai * HALF + m * 16, col0 + bj * HALF, acc[ai][bj][m][0], acc[ai][bj][m][1]);
    }
};
__device__ __forceinline__ u32x4 pack8(const f32x4& v0, const f32x4& v1) { u32x4 w; w.x = cvt_pk_bf16(v0[0], v0[1]); w.y = cvt_pk_bf16(v0[2], v0[3]); w.z = cvt_pk_bf16(v1[0], v1[1]); w.w = cvt_pk_bf16(v1[2], v1[3]); return w; }
struct StBf16 { bf16_t* O; int ldc;
    __device__ __forceinline__ void store8(const Unit&, int row, int col, const f32x4& v0, const f32x4& v1) const { *(u32x4*)(O + (size_t)row * ldc + col) = pack8(v0, v1); } };
struct StRelu2 { bf16_t* O; int ldc;
    __device__ __forceinline__ void store8(const Unit&, int row, int col, f32x4 v0, f32x4 v1) const {
#pragma unroll
        for (int e = 0; e < 4; ++e) { const float a = fmaxf(v0[e], 0.f), b = fmaxf(v1[e], 0.f); v0[e] = a * a; v1[e] = b * b; }
        *(u32x4*)(O + (size_t)row * ldc + col) = pack8(v0, v1); } };
struct BatchOrder {
    int nM, nN, nb, nh, G, c; long sAb, sAh, sBb, sBh;
    __device__ __forceinline__ bool next(int i, Unit& u) const {
        const long L = (long)i * G + c; if (L >= (long)nM * nN * nb) return false;
        const int per = nM * nN; u.bi = (int)(L / per); const int r = (int)(L % per); u.pn = r / nM; u.pm = r % nM; return true;
    }
    __device__ __forceinline__ const char* a_ptr(const Gemm& g, const Unit& u) const { return (const char*)(g.A + (size_t)(u.bi / nh) * sAb + (size_t)(u.bi % nh) * sAh + (size_t)u.pm * BM * g.lda); }
    __device__ __forceinline__ const char* b_ptr(const Gemm& g, const Unit& u) const { return (const char*)(g.Bt + (size_t)(u.bi / nh) * sBb + (size_t)(u.bi % nh) * sBh + (size_t)u.pn * BM * g.ldb); }
    __device__ __forceinline__ void a_ready(const Unit&) const {}
    __device__ __forceinline__ void done(const Unit&) const {}
};
struct StLora { bf16_t* LW; bf16_t* AA; bf16_t* G; int Mrows;
    __device__ __forceinline__ void store8(const Unit&, int row, int col, const f32x4& v0, const f32x4& v1) const {
        bf16_t* dst = (col < 1024) ? LW + ((size_t)(col >> 9) * Mrows + row) * 512 + (col & 511)
                    : (col < 2048) ? AA + ((size_t)((col - 1024) >> 9) * Mrows + row) * 512 + (col & 511)
                                   : G + (size_t)row * 512 + (col - 2048);
        *(u32x4*)dst = pack8(v0, v1);
    } };
struct StScoreF32 { float* SC; int rows, cols; float scale;
    __device__ __forceinline__ void store8(const Unit& u, int row, int col, const f32x4& v0, const f32x4& v1) const {
        float* o = SC + ((size_t)u.bi * rows + row) * cols + col; *(f32x4*)o = v0 * scale; *(f32x4*)(o + 4) = v1 * scale; } };
struct StBatchBf16 { bf16_t* O; int rows, cols, nh, ldc;
    __device__ __forceinline__ void store8(const Unit& u, int row, int col, const f32x4& v0, const f32x4& v1) const {
        *(u32x4*)(O + ((size_t)(u.bi / nh) * rows + row) * ldc + (u.bi % nh) * cols + col) = pack8(v0, v1); } };
template <class Epi, class Sched, bool ALIGN_EPI = false, bool SP2 = false>
__device__ __forceinline__ void gemm_phase(PG8_LAS unsigned char* lds, const Gemm g, const Sched& S, const Epi& E, const int tid) {
    const int wid = __builtin_amdgcn_readfirstlane(tid >> 6), lane = tid & 63, wr = wid >> 2, wc = wid & 3, fr = lane & 15, fq = lane >> 4;
    const int K = g.K, nt = K / BK;
    unsigned voffA[2], voffB[2];
#pragma unroll
    for (int i = 0; i < 2; ++i) { int R, C; stage_rc(tid * 16 + i * 8192, R, C); const int Rb = Epi::PERM ? ((R & ~31) + perm32(R & 31)) : R;
        voffA[i] = (unsigned)(R * g.lda + C) * 2u; voffB[i] = (unsigned)(Rb * g.ldb + C) * 2u; }
    const size_t kstep = (size_t)(BK * 2);
    const size_t hstepA = (size_t)HALF * g.lda * 2, hstepB = (size_t)HALF * g.ldb * 2;
    const unsigned ldsw = (unsigned)wid * 1024u;
    const int aoff = lds_byte(wr * 64 + fr, fq * 8), boff = lds_byte(wc * 32 + fr, fq * 8);
#define PG8_SA(b, h) (((b) * 2 + (h)) * HTB)
#define PG8_SB(b, h) ((4 + (b) * 2 + (h)) * HTB)
#define PG8_STAGE(bufoff, gbase, voff) do { _Pragma("unroll") for (int _i = 0; _i < 2; ++_i) \
        __builtin_amdgcn_global_load_lds((const unsigned*)((const char*)(gbase) + (voff)[_i]), (PG8_LAS unsigned*)(lds + (bufoff) + ldsw + _i * 8192), 16, 0, 0); } while (0)
#define PG8_LDA(dst, b, h) do { _Pragma("unroll") for (int m = 0; m < 4; ++m) _Pragma("unroll") for (int k = 0; k < 2; ++k) dst[m][k] = *(const PG8_LAS bf16x8*)(lds + PG8_SA(b, h) + aoff + m * 2048 + k * 1024); } while (0)
#define PG8_LDB(dst, b, h) do { _Pragma("unroll") for (int n = 0; n < 2; ++n) _Pragma("unroll") for (int k = 0; k < 2; ++k) dst[n][k] = *(const PG8_LAS bf16x8*)(lds + PG8_SB(b, h) + boff + n * 2048 + k * 1024); } while (0)
#define PG8_MMA(ai, bj, At, Bt) do { __builtin_amdgcn_s_setprio(1); _Pragma("unroll") for (int m = 0; m < 4; ++m) _Pragma("unroll") for (int n = 0; n < 2; ++n) _Pragma("unroll") for (int k = 0; k < 2; ++k) \
        acc[ai][bj][m][n] = __builtin_amdgcn_mfma_f32_16x16x32_bf16(Bt[n][k], At[m][k], acc[ai][bj][m][n], 0, 0, 0); __builtin_amdgcn_s_setprio(0); } while (0)
#define PG8_WAIT_V(n) asm volatile("s_waitcnt vmcnt(" #n ")" ::: "memory")
#define PG8_WAIT_L(n) asm volatile("s_waitcnt lgkmcnt(" #n ")" ::: "memory")
#define PG8_BAR __builtin_amdgcn_s_barrier()
#define PG8_SCHED __builtin_amdgcn_sched_barrier(0)
    Unit cur, nxt; int ui = 0;
    if (!S.next(0, cur)) return;
    f32x4 acc[2][2][4][2];
#pragma unroll
    for (int a = 0; a < 2; ++a)
#pragma unroll
        for (int b = 0; b < 2; ++b)
#pragma unroll
            for (int m = 0; m < 4; ++m)
#pragma unroll
                for (int n = 0; n < 2; ++n) acc[a][b][m][n] = (f32x4){0.f, 0.f, 0.f, 0.f};
    bf16x8 At[4][2], B0[2][2], B1[2][2];
    const char* cA = S.a_ptr(g, cur); const char* cB = S.b_ptr(g, cur);
    S.a_ready(cur);
    if constexpr (SP2) {
        PG8_STAGE(PG8_SB(0, 0), cB, voffB); PG8_STAGE(PG8_SB(0, 1), cB + hstepB, voffB); PG8_STAGE(PG8_SA(0, 0), cA, voffA); PG8_STAGE(PG8_SA(0, 1), cA + hstepA, voffA);
        if (wr == 1) PG8_BAR;
        PG8_WAIT_V(2); PG8_BAR;
        PG8_STAGE(PG8_SB(1, 0), cB + kstep, voffB); PG8_STAGE(PG8_SA(1, 0), cA + kstep, voffA); PG8_STAGE(PG8_SB(1, 1), cB + hstepB + kstep, voffB);
        PG8_WAIT_V(6); PG8_BAR;
    } else {
        PG8_STAGE(PG8_SB(0, 0), cB, voffB); PG8_STAGE(PG8_SA(0, 0), cA, voffA); PG8_STAGE(PG8_SB(0, 1), cB + hstepB, voffB); PG8_STAGE(PG8_SA(0, 1), cA + hstepA, voffA);
        if (wr == 1) PG8_BAR;
        PG8_WAIT_V(4); PG8_BAR;
        PG8_STAGE(PG8_SB(1, 0), cB + kstep, voffB); PG8_STAGE(PG8_SA(1, 0), cA + kstep, voffA); PG8_STAGE(PG8_SB(1, 1), cB + hstepB + kstep, voffB);
        PG8_WAIT_V(6); PG8_BAR;
    }
    for (;;) {
        const bool has_next = S.next(ui + 1, nxt);
        const char* nA = has_next ? S.a_ptr(g, nxt) : cA; const char* nB = has_next ? S.b_ptr(g, nxt) : cB;
        for (int t = 0; t < nt; t += 2) {
            const bool last = (t == nt - 2);
            const char* a1 = cA + (size_t)(t + 1) * kstep;
            const char* a2 = last ? nA : cA + (size_t)(t + 2) * kstep; const char* b2 = last ? nB : cB + (size_t)(t + 2) * kstep;
            const char* a3 = a2 + kstep; const char* b3 = b2 + kstep;
            if (last && has_next) S.a_ready(nxt);
            if constexpr (SP2) {
            PG8_LDB(B0, 0, 0); PG8_LDB(B1, 0, 1); PG8_SCHED; PG8_LDA(At, 0, 0); PG8_STAGE(PG8_SA(1, 1), a1 + hstepA, voffA);
            PG8_WAIT_V(8); PG8_WAIT_L(0); PG8_BAR; PG8_MMA(0, 0, At, B0); PG8_MMA(0, 1, At, B1); PG8_BAR; PG8_SCHED;
            PG8_LDA(At, 0, 1); PG8_STAGE(PG8_SB(0, 0), b2, voffB); PG8_STAGE(PG8_SB(0, 1), b2 + hstepB, voffB); PG8_STAGE(PG8_SA(0, 0), a2, voffA);
            PG8_WAIT_V(8); PG8_WAIT_L(0); PG8_BAR; PG8_MMA(1, 0, At, B0); PG8_MMA(1, 1, At, B1); PG8_BAR; PG8_SCHED;
            PG8_LDB(B0, 1, 0); PG8_LDB(B1, 1, 1); PG8_SCHED; PG8_LDA(At, 1, 0); PG8_STAGE(PG8_SA(0, 1), a2 + hstepA, voffA);
            PG8_WAIT_V(8); PG8_WAIT_L(0); PG8_BAR; PG8_MMA(0, 0, At, B0); PG8_MMA(0, 1, At, B1); PG8_BAR; PG8_SCHED;
            PG8_LDA(At, 1, 1); PG8_STAGE(PG8_SB(1, 0), b3, voffB); PG8_STAGE(PG8_SB(1, 1), b3 + hstepB, voffB); PG8_STAGE(PG8_SA(1, 0), a3, voffA);
            PG8_WAIT_V(8); PG8_WAIT_L(0); PG8_BAR; PG8_MMA(1, 0, At, B0); PG8_MMA(1, 1, At, B1); PG8_BAR; PG8_SCHED;
            } else {
            PG8_LDB(B0, 0, 0); PG8_SCHED; PG8_LDA(At, 0, 0); PG8_STAGE(PG8_SA(1, 1), a1 + hstepA, voffA);
            PG8_WAIT_L(8); PG8_BAR; PG8_WAIT_L(0); PG8_MMA(0, 0, At, B0); PG8_BAR; PG8_SCHED;
            PG8_LDB(B1, 0, 1); PG8_STAGE(PG8_SB(0, 0), b2, voffB);
            PG8_BAR; PG8_WAIT_L(0); PG8_MMA(0, 1, At, B1); PG8_BAR;
            PG8_LDA(At, 0, 1); PG8_STAGE(PG8_SA(0, 0), a2, voffA);
            PG8_BAR; PG8_WAIT_L(0); PG8_MMA(1, 0, At, B0); PG8_BAR; PG8_SCHED;
            PG8_STAGE(PG8_SB(0, 1), b2 + hstepB, voffB);
            PG8_WAIT_V(6); PG8_BAR; PG8_MMA(1, 1, At, B1); PG8_BAR;
            PG8_LDB(B0, 1, 0); PG8_SCHED; PG8_LDA(At, 1, 0); PG8_STAGE(PG8_SA(0, 1), a2 + hstepA, voffA);
            PG8_WAIT_L(8); PG8_BAR; PG8_WAIT_L(0); PG8_MMA(0, 0, At, B0); PG8_BAR; PG8_SCHED;
            PG8_LDB(B1, 1, 1); PG8_STAGE(PG8_SB(1, 0), b3, voffB);
            PG8_BAR; PG8_WAIT_L(0); PG8_MMA(0, 1, At, B1); PG8_BAR;
            PG8_LDA(At, 1, 1); PG8_STAGE(PG8_SA(1, 0), a3, voffA);
            PG8_BAR; PG8_WAIT_L(0); PG8_MMA(1, 0, At, B0); PG8_BAR; PG8_SCHED;
            PG8_STAGE(PG8_SB(1, 1), b3 + hstepB, voffB);
            PG8_WAIT_V(6); PG8_BAR; PG8_MMA(1, 1, At, B1); PG8_BAR;
            }
        }
        if constexpr (ALIGN_EPI) { if (wr == 0) PG8_BAR; }
        if constexpr (!Epi::AFTER_DRAIN) { const int l2 = make_tid(0); E(acc, cur, wr, wc, l2 & 15, l2 >> 4); S.done(cur); }
        if (!has_next) break;
#pragma unroll
        for (int a = 0; a < 2; ++a)
#pragma unroll
            for (int b = 0; b < 2; ++b)
#pragma unroll
                for (int m = 0; m < 4; ++m)
#pragma unroll
                    for (int n = 0; n < 2; ++n) acc[a][b][m][n] = (f32x4){0.f, 0.f, 0.f, 0.f};
        cur = nxt; cA = nA; cB = nB; ++ui;
        if constexpr (ALIGN_EPI) { if (wr == 1) PG8_BAR; }
    }
    PG8_WAIT_V(0);
    if constexpr (!ALIGN_EPI) { if (wr == 0) PG8_BAR; }
    PG8_BAR;
    if constexpr (Epi::AFTER_DRAIN) { E.fused(acc, cur, wr, wc, fr, fq, lds, wid, lane); S.done(cur); }
#undef PG8_SA
#undef PG8_SB
#undef PG8_STAGE
#undef PG8_LDA
#undef PG8_LDB
#undef PG8_MMA
#undef PG8_WAIT_V
#undef PG8_WAIT_L
#undef PG8_BAR
#undef PG8_SCHED
}
}


struct GemmDesc {
    const bf16_t* A; int lda; long sAb, sAh;
    const void* B; int ldb; long sBb, sBh;
    int Mm, Nn, Kk, nbatch, nh;
};
template <int BMODE  , class EP>
__device__ void gemm_simple(const GemmDesc g, EP epi, unsigned char* smem, int bid, int nblk) {
    bf16_t* sA = (bf16_t*)smem;
    bf16_t* sB = sA + 128 * 40;
    const int tid = threadIdx.x, lane = tid & 63, wid = tid >> 6, wr = wid >> 2, wc = wid & 3, fr = lane & 15, fq = lane >> 4;
    const int tM = g.Mm / 128, tN = g.Nn / 128, ntile = tM * tN * g.nbatch;
    for (int t = bid; t < ntile; t += nblk) {
        const int bi = t / (tM * tN), tt = t % (tM * tN), tm = tt / tN, tn = tt % tN;
        const bf16_t* A = g.A + (long)(bi / g.nh) * g.sAb + (long)(bi % g.nh) * g.sAh + (long)tm * 128 * g.lda;
        const long boff = (long)(bi / g.nh) * g.sBb + (long)(bi % g.nh) * g.sBh;
        f32x4 acc[4][2];
#pragma unroll
        for (int i = 0; i < 4; ++i)
#pragma unroll
            for (int j = 0; j < 2; ++j) acc[i][j] = (f32x4){0.f, 0.f, 0.f, 0.f};
        for (int k0 = 0; k0 < g.Kk; k0 += 32) {
            __syncthreads();
            {
                const int r = tid >> 2, c = (tid & 3) * 8;
                const u32x4 v = *(const u32x4*)(A + (long)r * g.lda + k0 + c);
                *(u32x4*)(sA + r * 40 + c) = v;
            }
            if (BMODE == 2) {
                const bf16_t* B = (const bf16_t*)g.B + boff + (long)tn * 128 * g.ldb;
                const int r = tid >> 2, c = (tid & 3) * 8;
                const u32x4 v = *(const u32x4*)(B + (long)r * g.ldb + k0 + c);
                *(u32x4*)(sB + r * 40 + c) = v;
            } else if (BMODE == 0) {
                const float* B = (const float*)g.B + boff + (long)tn * 128;
                const int k = tid >> 4, n = (tid & 15) * 8;
                const f32x4 v0 = *(const f32x4*)(B + (long)(k0 + k) * g.ldb + n), v1 = *(const f32x4*)(B + (long)(k0 + k) * g.ldb + n + 4);
#pragma unroll
                for (int j = 0; j < 4; ++j) { sB[(n + j) * 40 + k] = f2bf(v0[j]); sB[(n + 4 + j) * 40 + k] = f2bf(v1[j]); }
            } else {
                const bf16_t* B = (const bf16_t*)g.B + boff + (long)tn * 128;
                const int k = tid >> 4, n = (tid & 15) * 8;
                const u32x4 v = *(const u32x4*)(B + (long)(k0 + k) * g.ldb + n);
                const bf16_t* e = (const bf16_t*)&v;
#pragma unroll
                for (int j = 0; j < 8; ++j) sB[(n + j) * 40 + k] = e[j];
            }
            __syncthreads();
            bf16x8 af[4], bfr[2];
#pragma unroll
            for (int i = 0; i < 4; ++i) af[i] = *(const bf16x8*)(sA + (wr * 64 + i * 16 + fr) * 40 + fq * 8);
#pragma unroll
            for (int j = 0; j < 2; ++j) bfr[j] = *(const bf16x8*)(sB + (wc * 32 + j * 16 + fr) * 40 + fq * 8);
#pragma unroll
            for (int i = 0; i < 4; ++i)
#pragma unroll
                for (int j = 0; j < 2; ++j) acc[i][j] = __builtin_amdgcn_mfma_f32_16x16x32_bf16(af[i], bfr[j], acc[i][j], 0, 0, 0);
        }
#pragma unroll
        for (int i = 0; i < 4; ++i)
#pragma unroll
            for (int j = 0; j < 2; ++j)
#pragma unroll
                for (int e = 0; e < 4; ++e) epi(bi, tm * 128 + wr * 64 + i * 16 + fq * 4 + e, tn * 128 + wc * 32 + j * 16 + fr, acc[i][j][e]);
    }
}

__device__ void norm_rows_bf16(const float* in, const float* gain, bf16_t* outb, int nrows, int gw, int ngw, int lane) {
    for (int r = gw; r < nrows; r += ngw) {
        const f32x4* xr = (const f32x4*)(in + (long)r * DM) + lane;
        f32x4 v[4]; float s = 0.f;
#pragma unroll
        for (int j = 0; j < 4; ++j) { v[j] = xr[64 * j]; s += v[j].x * v[j].x + v[j].y * v[j].y + v[j].z * v[j].z + v[j].w * v[j].w; }
        const float rstd = rsqrtf(wave_sum(s) * (1.f / DM) + NORM_EPS);
        unsigned long long* o8 = (unsigned long long*)(outb + (long)r * DM) + lane;
#pragma unroll
        for (int j = 0; j < 4; ++j) { const f32x4 gg = gain ? ((const f32x4*)gain)[lane + 64 * j] : (f32x4){1.f, 1.f, 1.f, 1.f};
            o8[64 * j] = (unsigned long long)pk2(v[j].x * rstd * gg.x, v[j].y * rstd * gg.y) | ((unsigned long long)pk2(v[j].z * rstd * gg.z, v[j].w * rstd * gg.w) << 32); }
    }
}
__device__ void resid_norm_rows(const float* base, const bf16_t* y, const float* g_post, float* xo, bf16_t* xn, int gw, int ngw, int lane) {
    for (int r = gw; r < M; r += ngw) {
        const unsigned long long* yr = (const unsigned long long*)(y + (long)r * DM) + lane; const f32x4* br = (const f32x4*)(base + (long)r * DM) + lane;
        f32x4 v[4], b[4]; float s = 0.f;
#pragma unroll
        for (int j = 0; j < 4; ++j) { const unsigned long long w = yr[64 * j]; const unsigned lo = (unsigned)w, hi = (unsigned)(w >> 32);
            v[j].x = __uint_as_float(lo << 16); v[j].y = __uint_as_float(lo & 0xffff0000u); v[j].z = __uint_as_float(hi << 16); v[j].w = __uint_as_float(hi & 0xffff0000u);
            b[j] = br[64 * j]; s += v[j].x * v[j].x + v[j].y * v[j].y + v[j].z * v[j].z + v[j].w * v[j].w; }
        const float rstd = rsqrtf(wave_sum(s) * (1.f / DM) + NORM_EPS);
        float s2 = 0.f;
#pragma unroll
        for (int j = 0; j < 4; ++j) { const f32x4 gg = ((const f32x4*)g_post)[lane + 64 * j];
            v[j].x = b[j].x + v[j].x * rstd * gg.x; v[j].y = b[j].y + v[j].y * rstd * gg.y; v[j].z = b[j].z + v[j].z * rstd * gg.z; v[j].w = b[j].w + v[j].w * rstd * gg.w;
            s2 += v[j].x * v[j].x + v[j].y * v[j].y + v[j].z * v[j].z + v[j].w * v[j].w; }
        f32x4* orow = (f32x4*)(xo + (long)r * DM) + lane;
#pragma unroll
        for (int j = 0; j < 4; ++j) orow[64 * j] = v[j];
        if (xn) {
            const float rstd2 = rsqrtf(wave_sum(s2) * (1.f / DM) + NORM_EPS);
            unsigned long long* o8 = (unsigned long long*)(xn + (long)r * DM) + lane;
#pragma unroll
            for (int j = 0; j < 4; ++j)
                o8[64 * j] = (unsigned long long)pk2(v[j].x * rstd2, v[j].y * rstd2) | ((unsigned long long)pk2(v[j].z * rstd2, v[j].w * rstd2) << 32);
        }
    }
}
__device__ __forceinline__ void transpose_item(const float* W, int N, const float* gain, bf16_t* WT, int ldk, float* scr, int item, int lane) {
    const int nblk = N / 32, kb = item / nblk, nb = item % nblk, k0 = 64 * kb, n0 = 32 * nb;
#pragma unroll 8
    for (int i = 0; i < 32; ++i) { const int kk = 2 * i + (lane >> 5); const float gg = gain ? gain[k0 + kk] : 1.f; scr[kk * 33 + (lane & 31)] = W[(size_t)(k0 + kk) * N + n0 + (lane & 31)] * gg; }
    asm volatile("s_waitcnt lgkmcnt(0)" ::: "memory");
    const int c = lane & 7;
#pragma unroll
    for (int j = 0; j < 4; ++j) { const int n = (lane >> 3) + 8 * j; const float* sp = scr + (8 * c) * 33 + n;
        u32x4 o; o.x = pk2(sp[0 * 33], sp[1 * 33]); o.y = pk2(sp[2 * 33], sp[3 * 33]); o.z = pk2(sp[4 * 33], sp[5 * 33]); o.w = pk2(sp[6 * 33], sp[7 * 33]);
        *(u32x4*)(WT + (size_t)(n0 + n) * ldk + k0 + 8 * c) = o; }
    asm volatile("s_waitcnt lgkmcnt(0)" ::: "memory");
}
struct TrJob { const float* W; int K, N; const float* gain; bf16_t* WT; int ldk; };
__device__ void prologue_weights(const Params& p, unsigned char* smem, int gw, int ngw, int wid, int lane) {
    unsigned char* ws = p.ws;
    float* scr = (float*)smem + wid * (64 * 33);
    const TrJob jobs[9] = {
        {p.w_in, DM, D_IN, p.norm_mix_pre, (bf16_t*)(ws + WS_WIN), DM},
        {p.w_out, DM, DM, nullptr, (bf16_t*)(ws + WS_WOUT), DM},
        {p.mem_wq, DM, DM, p.norm_mem_pre, (bf16_t*)(ws + WS_WQ), DM},
        {p.mem_wo, DM, DM, nullptr, (bf16_t*)(ws + WS_WO), DM},
        {p.mlp_w1, DM, DFF, p.norm_mlp_pre, (bf16_t*)(ws + WS_W1), DM},
        {p.mlp_w2, DFF, DM, nullptr, (bf16_t*)(ws + WS_W2), DFF},
        {p.mem_wkv, DM, 2048, p.norm_memtok, (bf16_t*)(ws + WS_WKV), DM},
        {p.mla_w_uq, 256, 768, p.mla_q_norm, (bf16_t*)(ws + WS_WUQ), 256},
        {p.mla_w_ukv, 128, 1024, p.mla_kv_norm, (bf16_t*)(ws + WS_WUKV), 256}};
    int base = 0;
#pragma unroll
    for (int j = 0; j < 9; ++j) {
        const int items = (jobs[j].K / 64) * (jobs[j].N / 32);
        int first = gw - base; first = ((first % ngw) + ngw) % ngw;
        for (int it = first; it < items; it += ngw) transpose_item(jobs[j].W, jobs[j].N, jobs[j].gain, jobs[j].WT, jobs[j].ldk, scr, it, lane);
        base += items;
    }
    { bf16_t* wt = (bf16_t*)(ws + WS_WUKV);
      for (int i = gw * 64 + lane; i < 1024 * 16; i += ngw * 64) *(u32x4*)(wt + (size_t)(i >> 4) * 256 + 128 + (i & 15) * 8) = (u32x4){0u, 0u, 0u, 0u}; }
    { bf16_t* wt = (bf16_t*)(ws + WS_WLG);
      for (int i = gw * 64 + lane; i < 2560 * 32; i += ngw * 64) {
          const int n = i >> 5, k0 = (i & 31) * 8;
          float v[8];
#pragma unroll
          for (int e = 0; e < 8; ++e) { const int k = k0 + e; float x = 0.f;
              if (n < 1024) { const int d = n >> 9, c = n & 511; if (k >= 32 * d && k < 32 * d + 32) x = p.rwkv_w2[((long)d * 32 + (k - 32 * d)) * RC + c]; }
              else if (n < 2048) { const int d = (n - 1024) >> 9, c = n & 511; if (k >= 64 + 32 * d && k < 96 + 32 * d) x = p.rwkv_a2[((long)d * 32 + (k - 64 - 32 * d)) * RC + c]; }
              else { const int c = n - 2048; if (k >= 128 && k < 224) x = p.rwkv_g2[(long)(k - 128) * RC + c]; }
              v[e] = x; }
          u32x4 o; o.x = pk2(v[0], v[1]); o.y = pk2(v[2], v[3]); o.z = pk2(v[4], v[5]); o.w = pk2(v[6], v[7]);
          *(u32x4*)(wt + (size_t)n * 256 + k0) = o; } }
    { u32x4* z = (u32x4*)((bf16_t*)(ws + WS_WIN) + (size_t)D_IN * DM); const int n16 = (ZLD - D_IN) * DM * 2 / 16;
      for (int i = gw * 64 + lane; i < n16; i += ngw * 64) z[i] = (u32x4){0u, 0u, 0u, 0u}; }
}

__device__ void mla_prep_rows(const Params& p, int gw, int ngw, int lane) {
    const bf16_t* Z = (const bf16_t*)(p.ws + WS_Z);
    bf16_t* CQ = (bf16_t*)(p.ws + WS_CQ); bf16_t* CKV = (bf16_t*)(p.ws + WS_CKV); bf16_t* KR = (bf16_t*)(p.ws + WS_KR);
    for (int r = gw; r < M; r += ngw) {
        const bf16_t* zr = Z + (long)r * ZLD;
        float q[4]; float s = 0.f;
        { const unsigned long long w = *(const unsigned long long*)(zr + ZC_CQ + 4 * lane); const unsigned lo = (unsigned)w, hi = (unsigned)(w >> 32);
          q[0] = __uint_as_float(lo << 16); q[1] = __uint_as_float(lo & 0xffff0000u); q[2] = __uint_as_float(hi << 16); q[3] = __uint_as_float(hi & 0xffff0000u); }
#pragma unroll
        for (int j = 0; j < 4; ++j) s += q[j] * q[j];
        const float rq = rsqrtf(wave_sum(s) * (1.f / 256.f) + NORM_EPS);
        *(unsigned long long*)(CQ + (long)r * 256 + 4 * lane) = (unsigned long long)pk2(q[0] * rq, q[1] * rq) | ((unsigned long long)pk2(q[2] * rq, q[3] * rq) << 32);
        float c[2]; s = 0.f;
        { const unsigned w = *(const unsigned*)(zr + ZC_CKV + 2 * lane); c[0] = __uint_as_float(w << 16); c[1] = __uint_as_float(w & 0xffff0000u); }
        s = c[0] * c[0] + c[1] * c[1];
        const float rk = rsqrtf(wave_sum(s) * (1.f / 128.f) + NORM_EPS);
        *(unsigned*)(CKV + (long)r * 256 + 2 * lane) = pk2(c[0] * rk, c[1] * rk);
        *(unsigned*)(CKV + (long)r * 256 + 128 + 2 * lane) = 0u;
        if (lane < 16) {
            const float x1 = bf2f(zr[ZC_KR + lane]), x2 = bf2f(zr[ZC_KR + 16 + lane]);
            const float inv_freq = powf(10000.f, -(float)(2 * lane) / 32.f);
            const float ang = (float)p.pos[r] * inv_freq; float sn, cs; sincosf(ang, &sn, &cs);
            KR[(long)r * 32 + lane] = f2bf(x1 * cs - x2 * sn); KR[(long)r * 32 + 16 + lane] = f2bf(x2 * cs + x1 * sn);
        }
    }
}

__device__ __forceinline__ void unpack8(const u32x4& w, float (&f)[8]) {
#pragma unroll
    for (int e = 0; e < 4; ++e) { f[2 * e] = __uint_as_float(w[e] << 16); f[2 * e + 1] = __uint_as_float(w[e] & 0xffff0000u); }
}
__device__ void rwkv_prep_rows(const Params& p, int gw, int ngw, int lane) {
    const bf16_t* Z = (const bf16_t*)(p.ws + WS_Z);
    bf16_t* RK = (bf16_t*)p.out;
    bf16_t* LIN = (bf16_t*)(p.ws + WS_LIN);
    for (int w = gw; w < M / 8; w += ngw) {
        const int t0 = w * 8, s0 = t0 % SEQ;
#pragma unroll
        for (int sec = 0; sec < 4; ++sec) {
            const bool act = (sec < 3) || (lane < 28);
            const int c0 = (sec < 3 ? sec * 512 : 1536) + 8 * (act ? lane : 0);
            float cw[3][8];
#pragma unroll
            for (int tap = 0; tap < 3; ++tap) { const f32x4 a = *(const f32x4*)(p.conv_rwkv + tap * RWKV_COLS + c0), b = *(const f32x4*)(p.conv_rwkv + tap * RWKV_COLS + c0 + 4);
#pragma unroll
                for (int j = 0; j < 4; ++j) { cw[tap][j] = a[j]; cw[tap][4 + j] = b[j]; } }
            float kkw[8];
            if (sec == 1) {
#pragma unroll
                for (int j = 0; j < 8; ++j) kkw[j] = p.rwkv_k_k[8 * lane + j];
            }
            const bf16_t* zp = Z + (long)t0 * ZLD + c0;
            float prev[8], cur[8], nxt[8];
            if (s0 > 0) unpack8(*(const u32x4*)(zp - ZLD), prev); else {
#pragma unroll
                for (int j = 0; j < 8; ++j) prev[j] = 0.f; }
            unpack8(*(const u32x4*)zp, cur);
#pragma unroll
            for (int i = 0; i < 8; ++i) {
                if (s0 + i + 1 < SEQ) unpack8(*(const u32x4*)(zp + (long)(i + 1) * ZLD), nxt); else {
#pragma unroll
                    for (int j = 0; j < 8; ++j) nxt[j] = 0.f; }
                float val[8];
#pragma unroll
                for (int j = 0; j < 8; ++j) val[j] = cw[0][j] * prev[j] + cw[1][j] * cur[j] + cw[2][j] * nxt[j];
                const long r = t0 + i;
                if (sec < 3) {
                    u32x4 o; o.x = pk2(val[0], val[1]); o.y = pk2(val[2], val[3]); o.z = pk2(val[4], val[5]); o.w = pk2(val[6], val[7]);
                    *(u32x4*)(RK + (long)sec * M * RC + r * RC + 8 * lane) = o;
                    if (sec == 1) {
                        float kk[8]; float ss = 0.f;
#pragma unroll
                        for (int j = 0; j < 8; ++j) { kk[j] = val[j] * kkw[j]; ss += kk[j] * kk[j]; }
                        ss = oct_sum(ss);
                        const float rn = rsqrtf(fmaxf(ss, 1e-24f));
                        u32x4 o2; o2.x = pk2(kk[0] * rn, kk[1] * rn); o2.y = pk2(kk[2] * rn, kk[3] * rn); o2.z = pk2(kk[4] * rn, kk[5] * rn); o2.w = pk2(kk[6] * rn, kk[7] * rn);
                        *(u32x4*)(RK + 3L * M * RC + r * RC + 8 * lane) = o2;
                    }
                } else if (lane < 32) {
                    u32x4 o = (u32x4){0u, 0u, 0u, 0u};
                    if (lane < 28) {
#pragma unroll
                        for (int j = 0; j < 8; ++j) { const float a = val[j]; val[j] = (lane < 8) ? tanhf(a) : (lane < 16) ? a : sigmoidf_(a); }
                        o.x = pk2(val[0], val[1]); o.y = pk2(val[2], val[3]); o.z = pk2(val[4], val[5]); o.w = pk2(val[6], val[7]);
                    }
                    *(u32x4*)(LIN + r * 256 + 8 * lane) = o;
                }
#pragma unroll
                for (int j = 0; j < 8; ++j) { prev[j] = cur[j]; cur[j] = nxt[j]; }
            }
        }
    }
}

constexpr int SC_TB = 32;
constexpr int SC_VEC = SC_TB * 64 * 4;
constexpr int SC_BUF = 6 * SC_VEC + SC_TB * 32 * 4;
__device__ __forceinline__ void rwkv_scan_block(const Params& p, unsigned char* smem, int job  , const int tid) {
    const int lane = tid & 63, wid = tid >> 6, q = lane & 15, rho = lane >> 4;
    const int chain = job >> 1, half = job & 1;
    const int d = chain / (BATCH * RH), b = (chain / RH) % BATCH, h = chain % RH;
    const bf16_t* RK = (const bf16_t*)p.out;
    const bf16_t* Rr = RK, *Kk = RK + (long)M * RC, *Vv = RK + 2L * M * RC, *KK = RK + 3L * M * RC;
    const bf16_t* LW = (const bf16_t*)(p.ws + WS_LW) + (long)d * M * RC;
    const bf16_t* AA = (const bf16_t*)(p.ws + WS_AA) + (long)d * M * RC;
    float* O = (float*)(p.ws + WS_O01) + (long)d * M * RC;
    const int ps = tid >> 4, pc = (tid & 15) * 4;
    const f32x4 ka4 = *(const f32x4*)(p.rwkv_k_a + h * RN + pc);
    const f32x4 w04 = *(const f32x4*)(p.rwkv_w0 + d * RC + h * RN + pc), a04 = *(const f32x4*)(p.rwkv_a0 + d * RC + h * RN + pc);
    const int row_l = wid * 4 + rho;
    const int row_g = half * 32 + row_l;
    unsigned long long raw[6];
    auto load_raw = [&](int batch) {
        const int t = batch * SC_TB + ps, sidx = d ? (SEQ - 1 - t) : t;
        const long off = ((long)(b * SEQ + sidx)) * RC + h * RN + pc;
        raw[0] = *(const unsigned long long*)(Rr + off); raw[1] = *(const unsigned long long*)(Kk + off); raw[2] = *(const unsigned long long*)(Vv + off);
        raw[3] = *(const unsigned long long*)(KK + off); raw[4] = *(const unsigned long long*)(LW + off); raw[5] = *(const unsigned long long*)(AA + off);
    };
    auto un4 = [](unsigned long long w) { f32x4 v; const unsigned lo = (unsigned)w, hi = (unsigned)(w >> 32);
        v.x = __uint_as_float(lo << 16); v.y = __uint_as_float(lo & 0xffff0000u); v.z = __uint_as_float(hi << 16); v.w = __uint_as_float(hi & 0xffff0000u); return v; };
    auto store_batch = [&](unsigned char* buf) {
        const f32x4 r4 = un4(raw[0]), k4 = un4(raw[1]), v4 = un4(raw[2]), kk4 = un4(raw[3]), lw4 = un4(raw[4]), ar4 = un4(raw[5]);
        f32x4 w4, an, bn, kd;
#pragma unroll
        for (int e = 0; e < 4; ++e) {
            const float xx = -(w04[e] + lw4[e]);
            w4[e] = __expf(-0.6065306597126334f * __builtin_amdgcn_rcpf(1.f + __expf(xx)));
            const float ae = sigmoidf_(a04[e] + ar4[e]);
            an[e] = -kk4[e]; bn[e] = kk4[e] * ae; kd[e] = k4[e] * (1.f + (ae - 1.f) * ka4[e]); }
        const int o = (ps * 64 + pc) * 4;
        *(f32x4*)(buf + 0 * SC_VEC + o) = w4; *(f32x4*)(buf + 1 * SC_VEC + o) = an; *(f32x4*)(buf + 2 * SC_VEC + o) = bn;
        *(f32x4*)(buf + 3 * SC_VEC + o) = kd; *(f32x4*)(buf + 4 * SC_VEC + o) = r4; *(f32x4*)(buf + 5 * SC_VEC + o) = v4;
    };
    float S0 = 0.f, S1 = 0.f, S2 = 0.f, S3 = 0.f;
    constexpr int NB = SEQ / SC_TB;
    const bool b3 = (q & 8) != 0, b2 = (q & 4) != 0, b1 = (q & 2) != 0, b0 = (q & 1) != 0;
    __syncthreads();
    load_raw(0); store_batch(smem);
    __syncthreads();
    for (int bt = 0; bt < NB; ++bt) {
        unsigned char* cur = smem + (bt & 1) * SC_BUF; unsigned char* nxt = smem + ((bt + 1) & 1) * SC_BUF;
        if (bt + 1 < NB) load_raw(bt + 1);
        float* otile = (float*)(cur + 6 * SC_VEC);
        const unsigned char* vb = cur + 16 * q;
        const unsigned char* vv_p = cur + 5 * SC_VEC + row_g * 4;
        f32x4 w4 = *(const f32x4*)(vb + 0 * SC_VEC), an = *(const f32x4*)(vb + 1 * SC_VEC), bn = *(const f32x4*)(vb + 2 * SC_VEC);
        f32x4 kd = *(const f32x4*)(vb + 3 * SC_VEC), r4 = *(const f32x4*)(vb + 4 * SC_VEC); float vv = *(const float*)vv_p;
#pragma unroll
        for (int g = 0; g < SC_TB / 16; ++g) {
            float op[16];
#pragma unroll
            for (int s16 = 0; s16 < 16; ++s16) {
                const int s = g * 16 + s16, sn = (s + 1 < SC_TB) ? s + 1 : s;
                const f32x4 w4n = *(const f32x4*)(vb + 0 * SC_VEC + sn * 256), ann = *(const f32x4*)(vb + 1 * SC_VEC + sn * 256), bnn = *(const f32x4*)(vb + 2 * SC_VEC + sn * 256);
                const f32x4 kdn = *(const f32x4*)(vb + 3 * SC_VEC + sn * 256), r4n = *(const f32x4*)(vb + 4 * SC_VEC + sn * 256); const float vvn = *(const float*)(vv_p + sn * 256);
                float sa = (S0 * an.x + S1 * an.y) + (S2 * an.z + S3 * an.w);
                const float t0 = fmaf(vv, kd.x, S0 * w4.x), t1 = fmaf(vv, kd.y, S1 * w4.y), t2 = fmaf(vv, kd.z, S2 * w4.z), t3 = fmaf(vv, kd.w, S3 * w4.w);
                sa = row16_sum(sa);
                S0 = fmaf(sa, bn.x, t0); S1 = fmaf(sa, bn.y, t1); S2 = fmaf(sa, bn.z, t2); S3 = fmaf(sa, bn.w, t3);
                op[s16] = (S0 * r4.x + S1 * r4.y) + (S2 * r4.z + S3 * r4.w);
                w4 = w4n; an = ann; bn = bnn; kd = kdn; r4 = r4n; vv = vvn;
            }
#pragma unroll
            for (int i = 0; i < 8; ++i) { const float keep = b3 ? op[i + 8] : op[i], send = b3 ? op[i] : op[i + 8]; op[i] = keep + dpp_f<0x128>(send); }
#pragma unroll
            for (int i = 0; i < 4; ++i) { const float keep = b2 ? op[i + 4] : op[i], send = b2 ? op[i] : op[i + 4]; op[i] = keep + dpp_f<0x141>(send); }
#pragma unroll
            for (int i = 0; i < 2; ++i) { const float keep = b1 ? op[i + 2] : op[i], send = b1 ? op[i] : op[i + 2]; op[i] = keep + dpp_f<0x4E>(send); }
            { const float keep = b0 ? op[1] : op[0], send = b0 ? op[0] : op[1]; op[0] = keep + dpp_f<0xB1>(send); }
            otile[(g * 16 + q) * 32 + row_l] = op[0];
        }
        if (bt + 1 < NB) store_batch(nxt);
        __syncthreads();
        {
            const int t = bt * SC_TB + ps, sidx = d ? (SEQ - 1 - t) : t;
            const float2 ov = *(const float2*)(otile + ps * 32 + 2 * (tid & 15));
            *(float2*)(O + ((long)(b * SEQ + sidx)) * RC + h * RN + half * 32 + 2 * (tid & 15)) = ov;
        }
    }
}

__device__ void rwkv_combine_rows(const Params& p, int gw, int ngw, int lane) {
    const bf16_t* RK = (const bf16_t*)p.out;
    const bf16_t* Rr = RK, *Kk = RK + (long)M * RC, *Vv = RK + 2L * M * RC;
    const bf16_t* AA = (const bf16_t*)(p.ws + WS_AA); const bf16_t* G = (const bf16_t*)(p.ws + WS_G);
    const float* O = (const float*)(p.ws + WS_O01);
    bf16_t* YC = (bf16_t*)(p.ws + WS_YCAT);
    for (int r = gw; r < M; r += ngw) {
        const long off = (long)r * RC + 8 * lane;
        float o[8]; float s = 0.f;
#pragma unroll
        for (int j = 0; j < 8; ++j) { o[j] = O[off + j] + O[(long)M * RC + off + j]; s += o[j]; }
        s = oct_sum(s);
        const float mu = s * (1.f / 64.f); float q = 0.f;
#pragma unroll
        for (int j = 0; j < 8; ++j) { o[j] -= mu; q += o[j] * o[j]; }
        q = oct_sum(q);
        const float rstd = rsqrtf(q * (1.f / 64.f) + LNX_EPS);
        float bon = 0.f; float vv[8];
#pragma unroll
        for (int j = 0; j < 8; ++j) {
            const int c = 8 * lane + j;
            const float r_ = bf2f(Rr[off + j]), k_ = bf2f(Kk[off + j]); vv[j] = bf2f(Vv[off + j]);
            const float a0 = sigmoidf_(p.rwkv_a0[c] + bf2f(AA[off + j])), a1 = sigmoidf_(p.rwkv_a0[RC + c] + bf2f(AA[(long)M * RC + off + j])); const float ka = p.rwkv_k_a[c];
            const float kd = k_ * (1.f + (a0 - 1.f) * ka) + k_ * (1.f + (a1 - 1.f) * ka);
            bon += r_ * kd * p.rwkv_r_k[c];
        }
        bon = oct_sum(bon);
#pragma unroll
        for (int j = 0; j < 8; ++j) {
            const int c = 8 * lane + j;
            const float y = (o[j] * rstd * p.rwkv_lnx_w[c] + p.rwkv_lnx_b[c] + bon * vv[j]) * bf2f(G[off + j]);
            YC[(long)r * DM + c] = f2bf(y);
        }
    }
}

typedef float f32x16 __attribute__((ext_vector_type(16)));
typedef short v4i16_t __attribute__((ext_vector_type(4)));
#define LDSAS __attribute__((address_space(3)))
constexpr int ATT_KROW = 208;
constexpr int ATT_KBUF = 64 * ATT_KROW;
constexpr int ATT_VBUF = 8192;
constexpr int ATT_V0 = 2 * ATT_KBUF;
__device__ __forceinline__ unsigned cvtpk(float lo, float hi) { unsigned r; asm volatile("v_cvt_pk_bf16_f32 %0, %1, %2" : "=v"(r) : "v"(lo), "v"(hi)); return r; }
__device__ __forceinline__ void mla_attn_unit(const Params& p, unsigned char* smem, int unit, const int tid) {
    const int lane = tid & 63, wid = tid >> 6, r32 = lane & 31, hi = lane >> 5;
    const int b = unit / 64, hd = (unit / 8) % 8, qb = unit % 8;
    const bf16_t* Q = (const bf16_t*)(p.ws + WS_Q); const bf16_t* KV = (const bf16_t*)(p.ws + WS_KV); const bf16_t* KR = (const bf16_t*)(p.ws + WS_KR);
    bf16_t* YC = (bf16_t*)(p.ws + WS_YCAT);
    const long rowbase = (long)b * SEQ;
    const long qrow = rowbase + qb * 256 + wid * 32 + r32;
    bf16x8 qf[6];
    {
        float qv[6][8];
#pragma unroll
        for (int s6 = 0; s6 < 6; ++s6) { const u32x4 w = *(const u32x4*)(Q + qrow * 768 + hd * 96 + 16 * s6 + 8 * hi);
#pragma unroll
            for (int e = 0; e < 4; ++e) { qv[s6][2 * e] = __uint_as_float(w[e] << 16); qv[s6][2 * e + 1] = __uint_as_float(w[e] & 0xffff0000u); } }
        const float pos = (float)p.pos[qrow];
#pragma unroll
        for (int j = 0; j < 8; ++j) { const int i = 8 * hi + j; const float inv_freq = powf(10000.f, -(float)(2 * i) / 32.f); float sn, cs; sincosf(pos * inv_freq, &sn, &cs);
            const float x1 = qv[4][j], x2 = qv[5][j]; qv[4][j] = x1 * cs - x2 * sn; qv[5][j] = x2 * cs + x1 * sn; }
        const float sc = 0.10206207261596575f * 1.4426950408889634f;
#pragma unroll
        for (int s6 = 0; s6 < 6; ++s6) { u32x4 w;
#pragma unroll
            for (int e = 0; e < 4; ++e) w[e] = cvtpk(qv[s6][2 * e] * sc, qv[s6][2 * e + 1] * sc);
            qf[s6] = __builtin_bit_cast(bf16x8, w); }
    }
    const int srow = tid >> 3, sc8 = tid & 7;
    const int rrow = (tid & 255) >> 2, rc4 = tid & 3;
    const bf16_t* gK = KV + (rowbase + srow) * 1024 + hd * 128 + sc8 * 8;
    const bf16_t* gV = gK + 64;
    const bf16_t* gR = KR + (rowbase + rrow) * 32 + rc4 * 8;
    const int dK = srow * ATT_KROW + sc8 * 16;
    const int dV = (sc8 >> 2) * 4096 + (srow >> 3) * 512 + (srow & 7) * 64 + (sc8 & 3) * 16;
    const int dR = rrow * ATT_KROW + 128 + rc4 * 16;
    u32x4 stK, stV, stR;
    stK = *(const u32x4*)gK; stV = *(const u32x4*)gV; if (tid < 256) stR = *(const u32x4*)gR;
    __syncthreads();
    *(u32x4*)(smem + dK) = stK; *(u32x4*)(smem + ATT_V0 + dV) = stV; if (tid < 256) *(u32x4*)(smem + dR) = stR;
    __syncthreads();
    const int kbase = r32 * ATT_KROW + hi * 16;
    const int vbase = ATT_V0 + ((lane >> 4) & 1) * 32 + (lane & 3) * 8 + (4 * hi + ((lane & 15) >> 2)) * 64;
    f32x16 ot[2]; ot[0] = f32x16{}; ot[1] = f32x16{};
    float m = -1e30f, l = 0.f;
    constexpr int NT = SEQ / 64;
    for (int j = 0; j < NT; ++j) {
        const int cur = j & 1;
        if (j + 1 < NT) { const long o = (long)(j + 1) * 64; stK = *(const u32x4*)(gK + o * 1024); stV = *(const u32x4*)(gV + o * 1024); if (tid < 256) stR = *(const u32x4*)(gR + o * 32); }
        const unsigned char* Kb = smem + cur * ATT_KBUF;
        f32x16 p0 = f32x16{}, p1 = f32x16{};
#pragma unroll
        for (int s6 = 0; s6 < 6; ++s6) {
            const bf16x8 k0 = *(const bf16x8*)(Kb + kbase + s6 * 32);
            const bf16x8 k1 = *(const bf16x8*)(Kb + kbase + 32 * ATT_KROW + s6 * 32);
            p0 = __builtin_amdgcn_mfma_f32_32x32x16_bf16(k0, qf[s6], p0, 0, 0, 0);
            p1 = __builtin_amdgcn_mfma_f32_32x32x16_bf16(k1, qf[s6], p1, 0, 0, 0);
        }
        float mx = fmaxf(p0[0], p1[0]);
#pragma unroll
        for (int r = 1; r < 16; ++r) mx = fmaxf(mx, fmaxf(p0[r], p1[r]));
        mx = half_max32(mx);
        const float mn = fmaxf(m, mx), alpha = __builtin_amdgcn_exp2f(m - mn);
        m = mn;
        float sum = 0.f;
#pragma unroll
        for (int r = 0; r < 16; ++r) { p0[r] = __builtin_amdgcn_exp2f(p0[r] - mn); p1[r] = __builtin_amdgcn_exp2f(p1[r] - mn); sum += p0[r] + p1[r]; }
        l = l * alpha + sum;
#pragma unroll
        for (int r = 0; r < 16; ++r) { ot[0][r] *= alpha; ot[1][r] *= alpha; }
        bf16x8 pw[4];
#pragma unroll
        for (int s2 = 0; s2 < 2; ++s2) {
            u32x4 w0, w1;
#pragma unroll
            for (int e = 0; e < 4; ++e) { w0[e] = cvtpk(p0[8 * s2 + 2 * e], p0[8 * s2 + 2 * e + 1]); w1[e] = cvtpk(p1[8 * s2 + 2 * e], p1[8 * s2 + 2 * e + 1]); }
            pw[s2] = __builtin_bit_cast(bf16x8, w0); pw[2 + s2] = __builtin_bit_cast(bf16x8, w1);
        }
        const LDSAS unsigned char* Vb = (const LDSAS unsigned char*)(smem) + vbase + cur * ATT_VBUF;
#pragma unroll
        for (int d0 = 0; d0 < 2; ++d0)
#pragma unroll
            for (int ks = 0; ks < 4; ++ks) {
                const v4i16_t lo = __builtin_amdgcn_ds_read_tr16_b64_v4i16((LDSAS v4i16_t*)(Vb + d0 * 4096 + ks * 1024));
                const v4i16_t hh = __builtin_amdgcn_ds_read_tr16_b64_v4i16((LDSAS v4i16_t*)(Vb + d0 * 4096 + ks * 1024 + 512));
                const bf16x8 vf = (bf16x8){lo[0], lo[1], lo[2], lo[3], hh[0], hh[1], hh[2], hh[3]};
                ot[d0] = __builtin_amdgcn_mfma_f32_32x32x16_bf16(vf, pw[ks], ot[d0], 0, 0, 0);
            }
        if (j + 1 < NT) {
            const int nb = cur ^ 1;
            *(u32x4*)(smem + nb * ATT_KBUF + dK) = stK; *(u32x4*)(smem + ATT_V0 + nb * ATT_VBUF + dV) = stV; if (tid < 256) *(u32x4*)(smem + nb * ATT_KBUF + dR) = stR;
        }
        __syncthreads();
    }
    l = half_sum32(l);
    const float il = 1.f / l;
    bf16_t* orow = YC + qrow * DM + 512 + hd * 64 + 4 * hi;
#pragma unroll
    for (int d0 = 0; d0 < 2; ++d0)
#pragma unroll
        for (int g = 0; g < 4; ++g) {
            const unsigned lo = cvtpk(ot[d0][4 * g] * il, ot[d0][4 * g + 1] * il), hh = cvtpk(ot[d0][4 * g + 2] * il, ot[d0][4 * g + 3] * il);
            *(unsigned long long*)(orow + 32 * d0 + 8 * g) = (unsigned long long)lo | ((unsigned long long)hh << 32);
        }
}

__device__ void softmax_rows(const Params& p, int gw, int ngw, int lane) {
    const float* SC = (const float*)(p.ws + WS_SC); bf16_t* P = (bf16_t*)(p.ws + WS_P);
    for (int r = gw; r < 32 * SEQ; r += ngw) {
        const f32x4 v = ((const f32x4*)(SC + (long)r * 256))[lane];
        float mx = fmaxf(fmaxf(v.x, v.y), fmaxf(v.z, v.w));
        mx = wave_max(mx);
        const float e0 = __expf(v.x - mx), e1 = __expf(v.y - mx), e2 = __expf(v.z - mx), e3 = __expf(v.w - mx);
        const float inv = 1.f / wave_sum(e0 + e1 + e2 + e3);
        ((unsigned long long*)(P + (long)r * 256))[lane] = (unsigned long long)pk2(e0 * inv, e1 * inv) | ((unsigned long long)pk2(e2 * inv, e3 * inv) << 32);
    }
}

#define LAS __attribute__((address_space(3)))
#define XB_TMO      128
#define XB_XCNT(j)  (256  + 64 * (j))
#define XB_XSUB(j)  (1280 + 64 * (j))
#define XB_XGEN(j)  (2304 + 64 * (j))
#define XB_TOP      3328
#define XB_TOPGEN   3392
#define XCD_BAR_WORDS 3456
#define XB_SPIN_CAP (1u << 18)

__device__ __forceinline__ unsigned xb_ld(unsigned* p)              { return __hip_atomic_load(p, __ATOMIC_RELAXED, __HIP_MEMORY_SCOPE_AGENT); }
__device__ __forceinline__ unsigned xb_add(unsigned* p, unsigned v) { return __hip_atomic_fetch_add(p, v, __ATOMIC_RELAXED, __HIP_MEMORY_SCOPE_AGENT); }
__device__ __forceinline__ unsigned xb_xcc_id() { return (unsigned)__builtin_amdgcn_s_getreg((3 << 11) | 20) & 0xFu; }
#define XB_SPIN(cond, bar) do { unsigned _sp = 0; while (cond) { __builtin_amdgcn_s_sleep(1); \
    if ((++_sp & 255u) == 0u) { if (xb_ld(&(bar)[XB_TMO])) break; if (_sp > XB_SPIN_CAP) { atomicAdd(&(bar)[XB_TMO], 1u); break; } } } } while (0)

struct XcdBarrier {
    unsigned* bar; unsigned x;
    volatile LAS unsigned* st;
};

__device__ __forceinline__ XcdBarrier xcd_barrier_post(unsigned* bar, volatile LAS unsigned* st) {
    XcdBarrier b; b.bar = bar; b.x = xb_xcc_id(); b.st = st;
    if (threadIdx.x == 0) (void)xb_add(&bar[XB_XCNT(b.x)], 1u);
    return b;
}
__device__ __forceinline__ void xcd_barrier_complete(unsigned* bar, unsigned x, unsigned& nloc, unsigned& nx) {
    const unsigned G = gridDim.x * gridDim.y * gridDim.z;
    unsigned sum, cnt, mine, sp = 0u;
    for (;;) {
        sum = 0u; cnt = 0u; mine = 0u;
#pragma unroll
        for (unsigned j = 0; j < 16; ++j) { const unsigned c = xb_ld(&bar[XB_XCNT(j)]); sum += c; cnt += (c > 0u) ? 1u : 0u; mine = (j == x) ? c : mine; }
        if (sum == G) break;
        __builtin_amdgcn_s_sleep(1);
        if ((++sp & 255u) == 0u) { if (xb_ld(&bar[XB_TMO])) break; if (sp > XB_SPIN_CAP) { atomicAdd(&bar[XB_TMO], 1u); break; } }
    }
    nloc = mine > 0u ? mine : 1u; nx = cnt > 0u ? cnt : 1u;
}

__device__ __forceinline__ void xcd_barrier(const XcdBarrier& b) {
    asm volatile("s_waitcnt vmcnt(0)" ::: "memory");
    __syncthreads();
    if (threadIdx.x == 0) {
        unsigned* bar = b.bar;
        __builtin_amdgcn_s_waitcnt(0);
        unsigned nloc = b.st[0], nx = b.st[1];
        if (nloc == 0u) { xcd_barrier_complete(bar, b.x, nloc, nx); b.st[0] = nloc; b.st[1] = nx; }
        const unsigned old = xb_add(&bar[XB_XSUB(b.x)], 1u);
        const unsigned gen = old / nloc;
        if (old + 1u == (gen + 1u) * nloc) {
            __builtin_amdgcn_fence(__ATOMIC_RELEASE, "agent");
            asm volatile("s_waitcnt vmcnt(0)" ::: "memory");
            const unsigned og = xb_add(&bar[XB_TOP], 1u);
            const unsigned tg = og / nx;
            if (og + 1u == (tg + 1u) * nx) xb_add(&bar[XB_TOPGEN], 1u);
            else XB_SPIN(xb_ld(&bar[XB_TOPGEN]) == tg, bar);
            __builtin_amdgcn_fence(__ATOMIC_ACQUIRE, "agent");
            xb_add(&bar[XB_XGEN(b.x)], 1u);
            asm volatile("s_waitcnt vmcnt(0)" ::: "memory");
        } else {
            XB_SPIN(xb_ld(&bar[XB_XGEN(b.x)]) == gen, bar);
            __builtin_amdgcn_fence(__ATOMIC_ACQUIRE, "agent");
            asm volatile("s_waitcnt vmcnt(0)" ::: "memory");
        }
    }
    __syncthreads();
}

constexpr size_t WS_CTL = 252 * MiB;
constexpr int MISC_OFF = 140 * 1024;

constexpr int NTHREADS = 512;
constexpr int LDS_BYTES = 147456;

template <class Pol>
__device__ __forceinline__ void big_gemm(const int tid, unsigned char* smem, const bf16_t* A, int lda, const bf16_t* Bt, int ldb, int Mm, int Nn, int K, const Pol pol) {
    pg8::Gemm g{A, Bt, lda, ldb, K}; pg8::StaticOrder S; S.init(Mm, Nn, (int)gridDim.x, (int)blockIdx.x);
    pg8::EpiStore8<Pol> E{pol};
    pg8::gemm_phase<pg8::EpiStore8<Pol>, pg8::StaticOrder, true, true>((PG8_LAS unsigned char*)smem, g, S, E, tid);
}

template <class Pol>
__device__ __forceinline__ void batch_gemm(const int tid, unsigned char* smem, const bf16_t* A, int lda, long sAb, long sAh, const bf16_t* Bt, int ldb, long sBb, long sBh, int Mm, int Nn, int K, int nb, int nh, const Pol pol) {
    pg8::Gemm g{A, Bt, lda, ldb, K}; pg8::BatchOrder S{Mm / 256, Nn / 256, nb, nh, (int)gridDim.x, (int)blockIdx.x, sAb, sAh, sBb, sBh};
    pg8::EpiStore8<Pol> E{pol};
    pg8::gemm_phase<pg8::EpiStore8<Pol>, pg8::BatchOrder, true, true>((PG8_LAS unsigned char*)smem, g, S, E, tid);
}

template <int PH>
__device__ __forceinline__ void run_phase(const Params& p, unsigned char* smem, int bid, int nblk, const int wid_s) {
    const int tid = make_tid(wid_s), lane = tid & 63, wid = wid_s;
    const int gw = bid * (NTHREADS / 64) + wid, ngw = nblk * (NTHREADS / 64);
    unsigned char* ws = p.ws;
    if constexpr (PH == 0) {
        prologue_weights(p, smem, gw, ngw, wid, lane);
        norm_rows_bf16(p.x, nullptr, (bf16_t*)(ws + WS_XN), M, gw, ngw, lane);
    } else if constexpr (PH == 1) {
        big_gemm(tid, smem, (const bf16_t*)(ws + WS_XN), DM, (const bf16_t*)(ws + WS_WIN), DM, M, ZLD, DM, pg8::StBf16{(bf16_t*)(ws + WS_Z), ZLD});
    } else if constexpr (PH == 2) {
        mla_prep_rows(p, gw, ngw, lane);
    } else if constexpr (PH == 3) {
        big_gemm(tid, smem, (const bf16_t*)(ws + WS_CQ), 256, (const bf16_t*)(ws + WS_WUQ), 256, M, 768, 256, pg8::StBf16{(bf16_t*)(ws + WS_Q), 768});
        big_gemm(tid, smem, (const bf16_t*)(ws + WS_CKV), 256, (const bf16_t*)(ws + WS_WUKV), 256, M, 1024, 256, pg8::StBf16{(bf16_t*)(ws + WS_KV), 1024});
    } else if constexpr (PH == 4) {
        { const int vcu = (nblk % 8 == 0) ? (bid % 8) * (nblk / 8) + bid / 8 : bid;
          for (int u = vcu * 2; u < 512; u += nblk * 2) { mla_attn_unit(p, smem, u, tid); if (u + 1 < 512) mla_attn_unit(p, smem, u + 1, tid); } }
    } else if constexpr (PH == 5) {
        rwkv_prep_rows(p, gw, ngw, lane);
    } else if constexpr (PH == 6) {
        big_gemm(tid, smem, (const bf16_t*)(ws + WS_LIN), 256, (const bf16_t*)(ws + WS_WLG), 256, M, 2560, 256,
                 pg8::StLora{(bf16_t*)(ws + WS_LW), (bf16_t*)(ws + WS_AA), (bf16_t*)(ws + WS_G), M});
    } else if constexpr (PH == 7) {
        for (int j = bid; j < 2 * 2 * BATCH * RH; j += nblk) rwkv_scan_block(p, smem, j, tid);
    } else if constexpr (PH == 8) {
        rwkv_combine_rows(p, gw, ngw, lane);
    } else if constexpr (PH == 9) {
        big_gemm(tid, smem, (const bf16_t*)(ws + WS_YCAT), DM, (const bf16_t*)(ws + WS_WOUT), DM, M, DM, DM, pg8::StBf16{(bf16_t*)(ws + WS_Y), DM});
    } else if constexpr (PH == 10) {
        resid_norm_rows(p.x, (const bf16_t*)(ws + WS_Y), p.norm_mix_post, p.out, (bf16_t*)(ws + WS_XN), gw, ngw, lane);
        norm_rows_bf16(p.mem, nullptr, (bf16_t*)(ws + WS_MN), BATCH * MEMT, gw, ngw, lane);
    } else if constexpr (PH == 11) {
        big_gemm(tid, smem, (const bf16_t*)(ws + WS_XN), DM, (const bf16_t*)(ws + WS_WQ), DM, M, DM, DM, pg8::StBf16{(bf16_t*)(ws + WS_QM), DM});
        big_gemm(tid, smem, (const bf16_t*)(ws + WS_MN), DM, (const bf16_t*)(ws + WS_WKV), DM, BATCH * MEMT, 1024, DM, pg8::StBf16{(bf16_t*)(ws + WS_KVM), 1024});
        big_gemm(tid, smem, (const bf16_t*)(ws + WS_WKV) + (size_t)1024 * DM, DM, (const bf16_t*)(ws + WS_MN), DM, 1024, BATCH * MEMT, DM, pg8::StBf16{(bf16_t*)(ws + WS_KVM) + (size_t)2048 * 1024, 2048});
    } else if constexpr (PH == 12) {
        batch_gemm(tid, smem, (const bf16_t*)(ws + WS_QM), DM, (long)SEQ * DM, MEMD, (const bf16_t*)(ws + WS_KVM), 1024, (long)MEMT * 1024, MEMD, SEQ, MEMT, MEMD, BATCH * MEMH, MEMH,
                   pg8::StScoreF32{(float*)(ws + WS_SC), SEQ, MEMT, 0.0625f});
    } else if constexpr (PH == 13) {
        softmax_rows(p, gw, ngw, lane);
    } else if constexpr (PH == 14) {
        batch_gemm(tid, smem, (const bf16_t*)(ws + WS_P), MEMT, (long)MEMH * SEQ * MEMT, (long)SEQ * MEMT, (const bf16_t*)(ws + WS_KVM) + (size_t)2048 * 1024, 2048, (long)MEMT, (long)MEMD * 2048, SEQ, MEMD, MEMT, BATCH * MEMH, MEMH,
                   pg8::StBatchBf16{(bf16_t*)(ws + WS_OM), SEQ, MEMD, MEMH, DM});
    } else if constexpr (PH == 15) {
        big_gemm(tid, smem, (const bf16_t*)(ws + WS_OM), DM, (const bf16_t*)(ws + WS_WO), DM, M, DM, DM, pg8::StBf16{(bf16_t*)(ws + WS_Y), DM});
    } else if constexpr (PH == 16) {
        resid_norm_rows(p.out, (const bf16_t*)(ws + WS_Y), p.norm_mem_post, p.out, (bf16_t*)(ws + WS_XN), gw, ngw, lane);
    } else if constexpr (PH == 17) {
        big_gemm(tid, smem, (const bf16_t*)(ws + WS_XN), DM, (const bf16_t*)(ws + WS_W1), DM, M, DFF, DM, pg8::StRelu2{(bf16_t*)(ws + WS_HID), DFF});
    } else if constexpr (PH == 18) {
        big_gemm(tid, smem, (const bf16_t*)(ws + WS_HID), DFF, (const bf16_t*)(ws + WS_W2), DFF, M, DM, DFF, pg8::StBf16{(bf16_t*)(ws + WS_Y), DM});
    } else if constexpr (PH == 19) {
        resid_norm_rows(p.out, (const bf16_t*)(ws + WS_Y), p.norm_mlp_post, p.out, nullptr, gw, ngw, lane);
    }
}

template <int PH> __device__ __forceinline__ void run_all(const Params& p, unsigned char* smem, const XcdBarrier& bar, const int wid_s) {
    run_phase<PH>(p, smem, blockIdx.x, gridDim.x, wid_s);
    if constexpr (PH + 1 < 20) { xcd_barrier(bar); run_all<PH + 1>(p, smem, bar, wid_s); }
}
__global__ void __launch_bounds__(NTHREADS, 2) mega_kernel(Params p) {
    extern __shared__ __attribute__((aligned(16))) unsigned char smem[];
    cg::grid_group grid = cg::this_grid();
    const int wid_s = __builtin_amdgcn_readfirstlane((int)(threadIdx.x >> 6));
    unsigned* barw = (unsigned*)(p.ws + WS_CTL);
    volatile LAS unsigned* st = (volatile LAS unsigned*)((LAS unsigned char*)smem + MISC_OFF);
    if (threadIdx.x < 2) st[threadIdx.x] = 0u;
    if (blockIdx.x == 0) for (int i = threadIdx.x; i < XCD_BAR_WORDS; i += NTHREADS) barw[i] = 0u;
    run_phase<0>(p, smem, blockIdx.x, gridDim.x, wid_s);
    grid.sync();
    const XcdBarrier bar = xcd_barrier_post(barw, st);
    run_all<1>(p, smem, bar, wid_s);
}

extern "C" void kernel_launch(void* const* d_in, const int* in_sizes, int n_in, void* d_out, int out_size, void* d_ws, size_t ws_size, hipStream_t stream) {
    static int grid_blocks = 0;
    if (!grid_blocks) {
        int dev = 0, cus = 0, per_cu = 0;
        (void)hipFuncSetAttribute((const void*)mega_kernel, hipFuncAttributeMaxDynamicSharedMemorySize, LDS_BYTES);
        (void)hipGetDevice(&dev);
        (void)hipDeviceGetAttribute(&cus, hipDeviceAttributeMultiprocessorCount, dev);
        (void)hipOccupancyMaxActiveBlocksPerMultiprocessor(&per_cu, mega_kernel, NTHREADS, LDS_BYTES);
        if (per_cu < 1) per_cu = 1;
        grid_blocks = cus * per_cu;
        fprintf(stderr, "kernel_launch: cus=%d per_cu=%d grid=%d\n", cus, per_cu, grid_blocks);
    }
    Params p{};
    p.x = (const float*)d_in[0]; p.mem = (const float*)d_in[1]; p.pos = (const int*)d_in[2];
    const float** f = &p.norm_mix_pre;
    for (int i = 0; i < 29; ++i) f[i] = (const float*)d_in[3 + i];
    p.out = (float*)d_out; p.ws = (unsigned char*)d_ws;
    void* args[] = {&p};
    hipError_t e = hipLaunchCooperativeKernel((void*)mega_kernel, dim3(grid_blocks), dim3(NTHREADS), args, LDS_BYTES, stream);
    if (e != hipSuccess) fprintf(stderr, "cooperative launch failed: %s (grid %d)\n", hipGetErrorString(e), grid_blocks);
}
```
